# Optimizing an MI355X kernel written in HIP

```python
import jax
import jax.numpy as jnp
from jax import lax
import numpy as np

D_MODEL = 1024
BATCH = 8
SEQ = 4096
DEPTH = 4

CTX_LEN = 256
GRID_W = 64
EPS = 1e-6

MLA_HEADS = 8
MLA_Q_RANK = 256
MLA_KV_RANK = 128
MLA_NOPE = 64
MLA_ROPE = 32
MLA_V = 64
MLA_SCALE = (MLA_NOPE + MLA_ROPE) ** -0.5
ROPE_AXIS = MLA_ROPE // 2
ROPE_BASE = 10000.0
Q_BLOCK = 128

FNET_GROUPS = 4
FNET_GROUP_W = 128

GLA_HEADS = 4
GLA_DK = 64
GLA_DV = 128
GLA_GATE_RANK = 16
GLA_TAU = 16.0
GLA_CHUNK = 64
GLA_SCALE = GLA_DK ** -0.5

N_EXPERTS = 32
TOP_K = 4
D_EXPERT = D_MODEL
SWIGLU_ALPHA = 1.702
SWIGLU_LIMIT = 7.0
MOE_BLOCK = 256

MLA_W = MLA_HEADS * MLA_V
FNET_W = FNET_GROUPS * FNET_GROUP_W
GLA_W = GLA_HEADS * GLA_DV
N_BRANCH = 3
IN_SPLITS = (MLA_Q_RANK, MLA_KV_RANK + MLA_ROPE, FNET_W, GLA_HEADS * GLA_DK, GLA_HEADS * GLA_DK, GLA_W, GLA_W, GLA_GATE_RANK, GLA_GATE_RANK, N_BRANCH * D_MODEL)
IN_WIDTH = sum(IN_SPLITS)

kernel_name = 'hybrid_mla_fourier_gla_moe_dit'


def rms_norm(x, g):
    xf = x.astype(jnp.float32)
    y = xf * lax.rsqrt(jnp.mean(xf * xf, axis=-1, keepdims=True) + EPS)
    return (y * g.astype(jnp.float32)).astype(x.dtype)


def modulate(h, shift, scale):
    return h * (1 + scale) + shift


def split_in(u):
    idx = [int(i) for i in np.cumsum(IN_SPLITS)[:-1]]
    return jnp.split(u, idx, axis=-1)


def axial_rope_angles(rows, dtype):
    row = jnp.repeat(jnp.arange(rows, dtype=jnp.float32), GRID_W)
    col = jnp.tile(jnp.arange(GRID_W, dtype=jnp.float32), rows)
    inv_freq = ROPE_BASE ** (-jnp.arange(0, ROPE_AXIS, 2, dtype=jnp.float32) / ROPE_AXIS)
    ang_r = (row[:, None] * inv_freq)[:, None, :]
    ang_c = (col[:, None] * inv_freq)[:, None, :]
    return (jnp.cos(ang_r).astype(dtype), jnp.sin(ang_r).astype(dtype),
            jnp.cos(ang_c).astype(dtype), jnp.sin(ang_c).astype(dtype))


def rope_axis(x, cos, sin):
    x1, x2 = jnp.split(x, 2, axis=-1)
    return jnp.concatenate([x1 * cos - x2 * sin, x2 * cos + x1 * sin], axis=-1)


def rope_2d(x, rope):
    cos_r, sin_r, cos_c, sin_c = rope
    xr, xc = jnp.split(x, 2, axis=-1)
    return jnp.concatenate([rope_axis(xr, cos_r, sin_r), rope_axis(xc, cos_c, sin_c)], axis=-1)


def mla_qkv(u_q, u_kv, q_norm_g, w_uq, kv_norm_g, w_ukv, rope):
    b, t, _ = u_q.shape
    q = (rms_norm(u_q, q_norm_g) @ w_uq).reshape(b, t, MLA_HEADS, MLA_NOPE + MLA_ROPE)
    c_kv, k_rope = jnp.split(u_kv, [MLA_KV_RANK], axis=-1)
    kv = (rms_norm(c_kv, kv_norm_g) @ w_ukv).reshape(b, t, MLA_HEADS, MLA_NOPE + MLA_V)
    k_nope, v = jnp.split(kv, [MLA_NOPE], axis=-1)
    q_nope, q_rope = jnp.split(q, [MLA_NOPE], axis=-1)
    k_rope = k_rope[:, :, None, :]
    if rope is not None:
        q_rope = rope_2d(q_rope, rope)
        k_rope = rope_2d(k_rope, rope)
    q = jnp.concatenate([q_nope, q_rope], axis=-1)
    k = jnp.concatenate([k_nope, jnp.broadcast_to(k_rope, (b, t, MLA_HEADS, MLA_ROPE))], axis=-1)
    return q, k, v


def attend(q, k, v):
    s = jnp.einsum('bqhd,bkhd->bhqk', q, k).astype(jnp.float32) * MLA_SCALE
    p = jax.nn.softmax(s, axis=-1).astype(v.dtype)
    return jnp.einsum('bhqk,bkhd->bqhd', p, v)


def attend_latent_blocks(q, k, v):
    b, t, h, dk = q.shape
    nb = t // Q_BLOCK
    qb = jnp.moveaxis(q.reshape(b, nb, Q_BLOCK, h, dk), 1, 0)
    o = lax.map(lambda qq: attend(qq, k, v), qb)
    return jnp.moveaxis(o, 0, 1).reshape(b, t, h * v.shape[-1])


def fourier_mix(u):
    b, t, _ = u.shape
    uf = u.astype(jnp.float32).reshape(b, t, FNET_GROUPS, FNET_GROUP_W)
    y = jnp.fft.fft2(uf, axes=(1, 3), norm='ortho').real
    return y.reshape(b, t, FNET_W).astype(u.dtype)


def gla_prepare(u_q, u_k, u_v, u_gf, u_gb, w_gf, b_gf, w_gb, b_gb):
    b, t, _ = u_q.shape
    q = u_q.reshape(b, t, GLA_HEADS, GLA_DK) * GLA_SCALE
    k = u_k.reshape(b, t, GLA_HEADS, GLA_DK)
    v = u_v.reshape(b, t, GLA_HEADS, GLA_DV)
    lf = (jax.nn.log_sigmoid((u_gf @ w_gf + b_gf).astype(jnp.float32)) / GLA_TAU).reshape(b, t, GLA_HEADS, GLA_DK)
    lb = (jax.nn.log_sigmoid((u_gb @ w_gb + b_gb).astype(jnp.float32)) / GLA_TAU).reshape(b, t, GLA_HEADS, GLA_DK)
    return q, k, v, lf, lb


def gla_scan(q, k, v, logf, s0):
    b, t, h, _ = q.shape
    nc = t // GLA_CHUNK

    def chunks(a):
        return a.astype(jnp.float32).reshape(b, nc, GLA_CHUNK, h, a.shape[-1]).transpose(1, 0, 3, 2, 4)

    lower = jnp.tril(jnp.ones((GLA_CHUNK, GLA_CHUNK), dtype=bool))[:, :, None]

    def step(state, xs):
        qc, kc, vc, fc = xs
        g = jnp.cumsum(fc, axis=2)
        o_inter = jnp.einsum('bhld,bhde->bhle', qc * jnp.exp(g), state)
        diff = jnp.where(lower, g[:, :, :, None, :] - g[:, :, None, :, :], -jnp.inf)
        a = jnp.einsum('bhtd,bhsd,bhtsd->bhts', qc, kc, jnp.exp(diff))
        o_intra = jnp.einsum('bhts,bhse->bhte', a, vc)
        g_last = g[:, :, -1:, :]
        new_state = (jnp.exp(g_last[:, :, 0, :])[..., None] * state
                     + jnp.einsum('bhsd,bhse->bhde', kc * jnp.exp(g_last - g), vc))
        return new_state, o_inter + o_intra

    s_fin, o = lax.scan(step, s0, (chunks(q), chunks(k), chunks(v), chunks(logf)))
    o = o.transpose(1, 0, 3, 2, 4).reshape(b, t, h, v.shape[-1])
    return o, s_fin


def gla_output(o, u_og, norm_g):
    b, t = u_og.shape[:2]
    o = rms_norm(o.astype(u_og.dtype), norm_g.reshape(GLA_HEADS, GLA_DV))
    return (o * jax.nn.silu(u_og.reshape(b, t, GLA_HEADS, GLA_DV))).reshape(b, t, GLA_W)


def merge_branches(o_mla, o_fn, o_gla, gate_pre, w_br_mla, w_br_fnet, w_br_gla, w_o):
    ga, gf, gg = jnp.split(jax.nn.sigmoid(gate_pre), N_BRANCH, axis=-1)
    y = ga * (o_mla @ w_br_mla) + gf * (o_fn @ w_br_fnet) + gg * (o_gla @ w_br_gla)
    return y @ w_o


def flip(a):
    return a[:, ::-1]


def token_mixers(h_ctx, h_lat, w_in, mla_q_norm_g, mla_w_uq, mla_kv_norm_g, mla_w_ukv,
                 gla_w_gate_f, gla_b_gate_f, gla_w_gate_b, gla_b_gate_b, gla_norm_g,
                 w_br_mla, w_br_fnet, w_br_gla, w_o, rope, need_ctx):
    b, n_ctx, _ = h_ctx.shape
    lq, lkv, lfn, lgq, lgk, lgv, log_, lgf, lgb, lgate = split_in(h_lat @ w_in)
    cq, ckv, cfn, cgq, cgk, cgv, cog, cgf, cgb, cgate = split_in(h_ctx @ w_in)

    q_l, k_l, v_l = mla_qkv(lq, lkv, mla_q_norm_g, mla_w_uq, mla_kv_norm_g, mla_w_ukv, rope)
    q_c, k_c, v_c = mla_qkv(cq, ckv, mla_q_norm_g, mla_w_uq, mla_kv_norm_g, mla_w_ukv, None)
    o_mla_l = attend_latent_blocks(q_l, jnp.concatenate([k_l, k_c], axis=1), jnp.concatenate([v_l, v_c], axis=1))

    o_fn_l = fourier_mix(lfn)

    gq_l, gk_l, gv_l, lf_l, lb_l = gla_prepare(lgq, lgk, lgv, lgf, lgb, gla_w_gate_f, gla_b_gate_f, gla_w_gate_b, gla_b_gate_b)
    gq_c, gk_c, gv_c, lf_c, lb_c = gla_prepare(cgq, cgk, cgv, cgf, cgb, gla_w_gate_f, gla_b_gate_f, gla_w_gate_b, gla_b_gate_b)
    zero = jnp.zeros((b, GLA_HEADS, GLA_DK, GLA_DV), jnp.float32)
    o_cf, s_f = gla_scan(gq_c, gk_c, gv_c, lf_c, zero)
    o_cb, s_b = gla_scan(flip(gq_c), flip(gk_c), flip(gv_c), flip(lb_c), zero)
    o_lf, _ = gla_scan(gq_l, gk_l, gv_l, lf_l, s_f)
    o_lb, _ = gla_scan(flip(gq_l), flip(gk_l), flip(gv_l), flip(lb_l), s_b)
    o_gla_l = gla_output(o_lf + flip(o_lb), log_, gla_norm_g)

    y_lat = merge_branches(o_mla_l, o_fn_l, o_gla_l, lgate, w_br_mla, w_br_fnet, w_br_gla, w_o)
    y_ctx = None
    if need_ctx:
        o_mla_c = attend(q_c, k_c, v_c).reshape(b, n_ctx, MLA_W)
        o_fn_c = fourier_mix(cfn)
        o_gla_c = gla_output(o_cf + flip(o_cb), cog, gla_norm_g)
        y_ctx = merge_branches(o_mla_c, o_fn_c, o_gla_c, cgate, w_br_mla, w_br_fnet, w_br_gla, w_o)
    return y_ctx, y_lat


def moe_ffn(h, router_w, router_b, w_up, b_up, w_down, b_down):
    n, d = h.shape
    logits = (h @ router_w).astype(jnp.float32) + router_b.astype(jnp.float32)
    top_val, top_idx = lax.top_k(logits, TOP_K)
    gate = jax.nn.softmax(top_val, axis=-1)
    n_assign = n * TOP_K
    flat_e = top_idx.reshape(n_assign)
    order = jnp.argsort(flat_e)
    sorted_e = flat_e[order]
    counts = jnp.bincount(flat_e, length=N_EXPERTS)
    padded = ((counts + MOE_BLOCK - 1) // MOE_BLOCK) * MOE_BLOCK
    pad_end = jnp.cumsum(padded)
    pad_start = pad_end - padded
    grp_start = jnp.cumsum(counts) - counts
    dest = pad_start[sorted_e] + (jnp.arange(n_assign) - grp_start[sorted_e])
    n_blocks = -(-n_assign // MOE_BLOCK) + N_EXPERTS
    n_rows = n_blocks * MOE_BLOCK
    row_tok = jnp.full((n_rows,), n, jnp.int32).at[dest].set((order // TOP_K).astype(jnp.int32))
    row_gate = jnp.zeros((n_rows,), jnp.float32).at[dest].set(gate.reshape(n_assign)[order])
    blk_e = jnp.minimum(jnp.searchsorted(pad_end, jnp.arange(n_blocks) * MOE_BLOCK, side='right'), N_EXPERTS - 1)
    h_pad = jnp.concatenate([h, jnp.zeros((1, d), h.dtype)], axis=0)

    def step(acc, xs):
        tok, gw, e = xs
        xb = h_pad[tok]
        up = xb @ w_up[e] + b_up[e]
        glu, lin = jnp.split(up, 2, axis=-1)
        glu = jnp.minimum(glu, SWIGLU_LIMIT)
        lin = jnp.clip(lin, -SWIGLU_LIMIT, SWIGLU_LIMIT)
        act = glu * jax.nn.sigmoid(SWIGLU_ALPHA * glu) * (lin + 1)
        yb = act @ w_down[e] + b_down[e]
        return acc.at[tok].add(yb * gw[:, None].astype(yb.dtype)), None

    acc0 = jnp.zeros((n + 1, d), h.dtype)
    acc, _ = lax.scan(step, acc0, (row_tok.reshape(n_blocks, MOE_BLOCK), row_gate.reshape(n_blocks, MOE_BLOCK), blk_e))
    return acc[:n]


def setup_inputs(seed: int = 0) -> dict:
    key = jax.random.key(seed)
    ks = jax.random.split(key, 29)
    L, D = DEPTH, D_MODEL

    def nrm(i, shape, scale):
        return jax.random.normal(ks[i], shape, jnp.float32) * scale

    return {
        'x': nrm(0, (BATCH, SEQ, D), 1.0),
        'c': nrm(1, (BATCH, D), 1.0),
        'ctx': nrm(2, (BATCH, CTX_LEN, D), 1.0),
        'c_ctx': nrm(3, (D,), 1.0),
        'w_mod': nrm(4, (L, D, 6 * D), 0.5 * D ** -0.5),
        'b_mod': nrm(5, (L, 6 * D), 0.02),
        'norm1_g': 1.0 + nrm(6, (L, D), 0.02),
        'w_in': nrm(7, (L, D, IN_WIDTH), D ** -0.5),
        'mla_q_norm_g': 1.0 + nrm(8, (L, MLA_Q_RANK), 0.02),
        'mla_w_uq': nrm(9, (L, MLA_Q_RANK, MLA_HEADS * (MLA_NOPE + MLA_ROPE)), MLA_Q_RANK ** -0.5),
        'mla_kv_norm_g': 1.0 + nrm(10, (L, MLA_KV_RANK), 0.02),
        'mla_w_ukv': nrm(11, (L, MLA_KV_RANK, MLA_HEADS * (MLA_NOPE + MLA_V)), MLA_KV_RANK ** -0.5),
        'gla_w_gate_f': nrm(12, (L, GLA_GATE_RANK, GLA_HEADS * GLA_DK), GLA_GATE_RANK ** -0.5),
        'gla_b_gate_f': nrm(13, (L, GLA_HEADS * GLA_DK), 0.1),
        'gla_w_gate_b': nrm(14, (L, GLA_GATE_RANK, GLA_HEADS * GLA_DK), GLA_GATE_RANK ** -0.5),
        'gla_b_gate_b': nrm(15, (L, GLA_HEADS * GLA_DK), 0.1),
        'gla_norm_g': 1.0 + nrm(16, (L, GLA_W), 0.02),
        'w_br_mla': nrm(17, (L, MLA_W, D), MLA_W ** -0.5),
        'w_br_fnet': nrm(18, (L, FNET_W, D), FNET_W ** -0.5),
        'w_br_gla': nrm(19, (L, GLA_W, D), GLA_W ** -0.5),
        'w_o': nrm(20, (L, D, D), D ** -0.5),
        'norm2_g': 1.0 + nrm(21, (L, D), 0.02),
        'router_w': nrm(22, (L, D, N_EXPERTS), D ** -0.5),
        'router_b': nrm(23, (L, N_EXPERTS), 0.01),
        'exp_w_up': nrm(24, (L, N_EXPERTS, D, 2 * D_EXPERT), D ** -0.5),
        'exp_b_up': nrm(25, (L, N_EXPERTS, 2 * D_EXPERT), 0.02),
        'exp_w_down': nrm(26, (L, N_EXPERTS, D_EXPERT, D), D_EXPERT ** -0.5),
        'exp_b_down': nrm(27, (L, N_EXPERTS, D), 0.02),
        'final_norm_g': 1.0 + nrm(28, (D,), 0.02),
    }


def reference(x, c, ctx, c_ctx, w_mod, b_mod, norm1_g, w_in, mla_q_norm_g, mla_w_uq, mla_kv_norm_g, mla_w_ukv,
              gla_w_gate_f, gla_b_gate_f, gla_w_gate_b, gla_b_gate_b, gla_norm_g, w_br_mla, w_br_fnet, w_br_gla,
              w_o, norm2_g, router_w, router_b, exp_w_up, exp_b_up, exp_w_down, exp_b_down, final_norm_g):
    b, n_lat, d = x.shape
    rows = n_lat // GRID_W
    rope = axial_rope_angles(rows, x.dtype)
    xc = ctx
    silu_c = jax.nn.silu(c)
    silu_cc = jax.nn.silu(c_ctx)
    for l in range(DEPTH):
        need_ctx = l < DEPTH - 1
        mod = (silu_c @ w_mod[l] + b_mod[l])[:, None, :]
        mod_c = (silu_cc @ w_mod[l] + b_mod[l])[None, None, :]
        sh1, sc1, g1, sh2, sc2, g2 = jnp.split(mod, 6, axis=-1)
        csh1, csc1, cg1, csh2, csc2, cg2 = jnp.split(mod_c, 6, axis=-1)

        h_lat = modulate(rms_norm(x, norm1_g[l]), sh1, sc1)
        h_ctx = modulate(rms_norm(xc, norm1_g[l]), csh1, csc1)
        y_ctx, y_lat = token_mixers(h_ctx, h_lat, w_in[l], mla_q_norm_g[l], mla_w_uq[l], mla_kv_norm_g[l], mla_w_ukv[l],
                                    gla_w_gate_f[l], gla_b_gate_f[l], gla_w_gate_b[l], gla_b_gate_b[l], gla_norm_g[l],
                                    w_br_mla[l], w_br_fnet[l], w_br_gla[l], w_o[l], rope, need_ctx)
        x = x + g1 * y_lat
        h_lat = modulate(rms_norm(x, norm2_g[l]), sh2, sc2)
        moe_params = (router_w[l], router_b[l], exp_w_up[l], exp_b_up[l], exp_w_down[l], exp_b_down[l])
        if need_ctx:
            xc = xc + cg1 * y_ctx
            h_ctx = modulate(rms_norm(xc, norm2_g[l]), csh2, csc2)
            n_ctx_tok = b * xc.shape[1]
            y = moe_ffn(jnp.concatenate([h_ctx.reshape(-1, d), h_lat.reshape(-1, d)], axis=0), *moe_params)
            xc = xc + cg2 * y[:n_ctx_tok].reshape(xc.shape)
            x = x + g2 * y[n_ctx_tok:].reshape(x.shape)
        else:
            x = x + g2 * moe_ffn(h_lat.reshape(-1, d), *moe_params).reshape(x.shape)
    return rms_norm(x, final_norm_g)
```

```cpp
#include <hip/hip_runtime.h>
#include <cstdio>
#include <cstdint>

#define LAS __attribute__((address_space(3)))
typedef unsigned short bf16_t;
typedef short bf16x8 __attribute__((ext_vector_type(8)));
typedef short s16x4 __attribute__((ext_vector_type(4)));
typedef float f32x2 __attribute__((ext_vector_type(2)));
typedef float f32x4 __attribute__((ext_vector_type(4)));
typedef float f32x16 __attribute__((ext_vector_type(16)));
typedef unsigned u32x2 __attribute__((ext_vector_type(2)));
typedef unsigned u32x4 __attribute__((ext_vector_type(4)));

constexpr int D = 1024, NB = 8, SEQ = 4096, CTX = 256, DEPTH = 4;
constexpr int RPB = CTX + SEQ;
constexpr int T = NB * RPB;
constexpr int NMT = T / 256;
constexpr int NE = 32, TOPK = 4;
constexpr int NPAD = 147456;
constexpr int INW = 5568;
constexpr int G1N = 5632;
constexpr float EPS = 1e-6f;
constexpr float QSCALE = 0.10206207261596575f * 1.4426950408889634f;
constexpr int NCHUNK = 68;

constexpr int CO_Q = 0, CO_KV = 256, CO_FN = 416, CO_GQ = 928, CO_GK = 1184, CO_GV = 1440, CO_OG = 1952, CO_GF = 2464, CO_GB = 2480, CO_GATE = 2496;

constexpr size_t al256(size_t x) { return (x + 255) & ~(size_t)255; }
constexpr size_t WS_CTL   = 0;
constexpr size_t CTL_BYTES = 65536;
constexpr size_t CTL_CNT  = 16384;
constexpr size_t WS_X     = WS_CTL + CTL_BYTES;
constexpr size_t WS_H     = WS_X + (size_t)T * D * 4;
constexpr size_t WS_UQ    = WS_H + (size_t)T * D * 2;
constexpr size_t WS_UKV   = WS_UQ + (size_t)T * 256 * 2;
constexpr size_t WS_UFT   = WS_UKV + (size_t)T * 256 * 2;
constexpr size_t WS_GQ    = WS_UFT + (size_t)NB * 512 * RPB * 2;
constexpr size_t WS_GK    = WS_GQ + (size_t)T * 256 * 2;
constexpr size_t WS_GV    = WS_GK + (size_t)T * 256 * 2;
constexpr size_t WS_GOG   = WS_GV + (size_t)T * 512 * 2;
constexpr size_t WS_GATE  = WS_GOG + (size_t)T * 512 * 2;
constexpr size_t WS_SSQ   = WS_GATE + (size_t)T * 3072 * 2;
constexpr size_t WS_Q     = WS_SSQ + (size_t)T * 8 * 4;
constexpr size_t WS_KN    = WS_Q + (size_t)T * 768 * 2;
constexpr size_t WS_KR    = WS_KN + (size_t)T * 512 * 2;
constexpr size_t WS_VT    = WS_KR + (size_t)T * 32 * 2;
constexpr size_t WS_OMLA  = WS_VT + (size_t)NB * 8 * 64 * RPB * 2;
constexpr size_t WS_P     = WS_OMLA + (size_t)T * 512 * 2;
constexpr size_t WS_KVS   = WS_P + (size_t)T * D * 2;
constexpr size_t WS_DEC   = WS_KVS + (size_t)NB * 4 * 2 * NCHUNK * 128 * 64 * 2;
constexpr size_t WS_OGLA  = WS_DEC + (size_t)NB * 4 * 2 * NCHUNK * 64 * 4;
constexpr size_t WS_Y     = WS_OGLA + (size_t)T * 512 * 2;
constexpr size_t WS_TOPI  = WS_Y + (size_t)T * D * 2;
constexpr size_t WS_TOPG  = WS_TOPI + (size_t)T * 16;
constexpr size_t WS_TOPP  = WS_TOPG + (size_t)T * 16;
constexpr size_t WS_HS    = WS_TOPP + (size_t)T * 16;
constexpr size_t WS_ACT   = WS_HS + (size_t)NPAD * D * 2;
constexpr size_t WS_YM    = WS_ACT + (size_t)NPAD * D * 2;
constexpr size_t WS_MOD   = WS_YM + (size_t)NPAD * D * 2;
constexpr size_t WS_ROPE  = WS_MOD + (size_t)DEPTH * 9 * 6144 * 4;
constexpr size_t WS_DFTL  = al256(WS_ROPE + 4096);
constexpr size_t WS_DFTC  = WS_DFTL + (size_t)8192 * 4096 * 2;
constexpr size_t WS_W     = WS_DFTC + (size_t)512 * 256 * 2;
constexpr size_t WL_WIN = 0;
constexpr size_t WL_WUQ = WL_WIN + (size_t)G1N * 1024 * 2;
constexpr size_t WL_WUKV = WL_WUQ + (size_t)768 * 256 * 2;
constexpr size_t WL_WM = WL_WUKV + (size_t)1024 * 256 * 2;
constexpr size_t WL_WF = WL_WM + (size_t)1024 * 512 * 2;
constexpr size_t WL_WG = WL_WF + (size_t)1024 * 1024 * 2;
constexpr size_t WL_WO = WL_WG + (size_t)1024 * 512 * 2;
constexpr size_t WL_WUP = WL_WO + (size_t)1024 * 1024 * 2;
constexpr size_t WL_WDN = WL_WUP + (size_t)NE * 2048 * 1024 * 2;
constexpr size_t WL_BYTES = WL_WDN + (size_t)NE * 1024 * 1024 * 2;
constexpr size_t WS_END = WS_W + (size_t)DEPTH * WL_BYTES;
static_assert(WS_END < ((size_t)4 << 30), "workspace map exceeds 4 GiB");
static_assert(WS_W % 256 == 0 && WL_BYTES % 256 == 0, "alignment");

constexpr int LDS_BYTES = 160 * 1024;
constexpr int LDS_AUX = 131072;

struct Params {
    const float *x, *c, *ctx, *c_ctx, *w_mod, *b_mod, *norm1_g, *w_in, *q_norm_g, *w_uq, *kv_norm_g, *w_ukv,
                *w_gf, *b_gf, *w_gb, *b_gb, *gla_norm_g, *w_br_mla, *w_br_fnet, *w_br_gla, *w_o, *norm2_g,
                *router_w, *router_b, *w_up, *b_up, *w_down, *b_down, *final_g;
    float* out; char* ws;
};

struct PTab {
    const LAS unsigned long long* t;
    __device__ __forceinline__ unsigned long long get(int i) const { const unsigned long long v = t[i]; const unsigned lo = __builtin_amdgcn_readfirstlane((unsigned)v), hi = __builtin_amdgcn_readfirstlane((unsigned)(v >> 32)); return ((unsigned long long)hi << 32) | lo; }
    __device__ __forceinline__ const float* x() const { return (const float*)get(0); }
    __device__ __forceinline__ const float* c() const { return (const float*)get(1); }
    __device__ __forceinline__ const float* ctx() const { return (const float*)get(2); }
    __device__ __forceinline__ const float* c_ctx() const { return (const float*)get(3); }
    __device__ __forceinline__ const float* w_mod() const { return (const float*)get(4); }
    __device__ __forceinline__ const float* b_mod() const { return (const float*)get(5); }
    __device__ __forceinline__ const float* norm1_g() const { return (const float*)get(6); }
    __device__ __forceinline__ const float* w_in() const { return (const float*)get(7); }
    __device__ __forceinline__ const float* q_norm_g() const { return (const float*)get(8); }
    __device__ __forceinline__ const float* w_uq() const { return (const float*)get(9); }
    __device__ __forceinline__ const float* kv_norm_g() const { return (const float*)get(10); }
    __device__ __forceinline__ const float* w_ukv() const { return (const float*)get(11); }
    __device__ __forceinline__ const float* w_gf() const { return (const float*)get(12); }
    __device__ __forceinline__ const float* b_gf() const { return (const float*)get(13); }
    __device__ __forceinline__ const float* w_gb() const { return (const float*)get(14); }
    __device__ __forceinline__ const float* b_gb() const { return (const float*)get(15); }
    __device__ __forceinline__ const float* gla_norm_g() const { return (const float*)get(16); }
    __device__ __forceinline__ const float* w_br_mla() const { return (const float*)get(17); }
    __device__ __forceinline__ const float* w_br_fnet() const { return (const float*)get(18); }
    __device__ __forceinline__ const float* w_br_gla() const { return (const float*)get(19); }
    __device__ __forceinline__ const float* w_o() const { return (const float*)get(20); }
    __device__ __forceinline__ const float* norm2_g() const { return (const float*)get(21); }
    __device__ __forceinline__ const float* router_w() const { return (const float*)get(22); }
    __device__ __forceinline__ const float* router_b() const { return (const float*)get(23); }
    __device__ __forceinline__ const float* w_up() const { return (const float*)get(24); }
    __device__ __forceinline__ const float* b_up() const { return (const float*)get(25); }
    __device__ __forceinline__ const float* w_down() const { return (const float*)get(26); }
    __device__ __forceinline__ const float* b_down() const { return (const float*)get(27); }
    __device__ __forceinline__ const float* final_g() const { return (const float*)get(28); }
    __device__ __forceinline__ float* out() const { return (float*)get(29); }
    __device__ __forceinline__ char* ws() const { return (char*)get(30); }
};
constexpr int LDS_PTAB = LDS_AUX + 24576;

__device__ __forceinline__ int ltid() { int t = (int)threadIdx.x; asm volatile("" : "+v"(t)); return t; }
__device__ __forceinline__ int lsgpr(int v) { asm volatile("" : "+s"(v)); return v; }

typedef __bf16 bf16x2_t __attribute__((ext_vector_type(2)));
__device__ __forceinline__ unsigned cvt_pk_bf16(float lo, float hi) { const f32x2 v = {lo, hi}; const bf16x2_t b = __builtin_convertvector(v, bf16x2_t); return __builtin_bit_cast(unsigned, b); }
__device__ __forceinline__ bf16_t f2bf(float f) { return (bf16_t)(cvt_pk_bf16(f, 0.f) & 0xffffu); }
__device__ __forceinline__ float bf2f(bf16_t b) { return __uint_as_float(((unsigned)b) << 16); }
__device__ __forceinline__ float bflo(unsigned w) { return __uint_as_float(w << 16); }
__device__ __forceinline__ float bfhi(unsigned w) { return __uint_as_float(w & 0xffff0000u); }
__device__ __forceinline__ float sigmoidf_(float x) { return 1.0f / (1.0f + __expf(-x)); }
__device__ __forceinline__ float siluf_(float x) { return x / (1.0f + __expf(-x)); }

#define XB_TMO      128
#define XB_XCNT(j)  (256  + 64 * (j))
#define XB_XSUB(j)  (1280 + 64 * (j))
#define XB_XGEN(j)  (2304 + 64 * (j))
#define XB_TOP      3328
#define XB_TOPGEN   3392
#define XCD_BAR_WORDS 3456
#define XB_SPIN_CAP (1u << 18)
__device__ __forceinline__ unsigned xb_ld(unsigned* p)              { return __hip_atomic_load(p, __ATOMIC_RELAXED, __HIP_MEMORY_SCOPE_AGENT); }
__device__ __forceinline__ unsigned xb_add(unsigned* p, unsigned v) { return __hip_atomic_fetch_add(p, v, __ATOMIC_RELAXED, __HIP_MEMORY_SCOPE_AGENT); }
__device__ __forceinline__ unsigned xb_xcc_id() { return (unsigned)__builtin_amdgcn_s_getreg((3 << 11) | 20) & 0xFu; }
#define XB_SPIN(cond, bar) do { unsigned _sp = 0; while (cond) { __builtin_amdgcn_s_sleep(1); \
    if ((++_sp & 255u) == 0u) { if (xb_ld(&(bar)[XB_TMO])) break; if (_sp > XB_SPIN_CAP) { atomicAdd(&(bar)[XB_TMO], 1u); break; } } } } while (0)
struct XcdBarrier { unsigned* bar; unsigned x; volatile LAS unsigned* st; };
__device__ __forceinline__ XcdBarrier xcd_barrier_post(unsigned* bar, volatile LAS unsigned* st) {
    XcdBarrier b; b.bar = bar; b.x = xb_xcc_id(); b.st = st;
    if (threadIdx.x == 0) (void)xb_add(&bar[XB_XCNT(b.x)], 1u);
    return b;
}
__device__ __forceinline__ void xcd_barrier_complete(unsigned* bar, unsigned x, unsigned& nloc, unsigned& nx) {
    const unsigned G = gridDim.x * gridDim.y * gridDim.z;
    unsigned sum, cnt, mine, sp = 0u;
    for (;;) {
        sum = 0u; cnt = 0u; mine = 0u;
#pragma unroll
        for (unsigned j = 0; j < 16; ++j) { const unsigned c = xb_ld(&bar[XB_XCNT(j)]); sum += c; cnt += (c > 0u) ? 1u : 0u; mine = (j == x) ? c : mine; }
        if (sum == G) break;
        __builtin_amdgcn_s_sleep(1);
        if ((++sp & 255u) == 0u) { if (xb_ld(&bar[XB_TMO])) break; if (sp > XB_SPIN_CAP) { atomicAdd(&bar[XB_TMO], 1u); break; } }
    }
    nloc = mine > 0u ? mine : 1u; nx = cnt > 0u ? cnt : 1u;
}
__device__ __forceinline__ void xcd_barrier(const XcdBarrier& b) {
    asm volatile("s_waitcnt vmcnt(0)" ::: "memory");
    __syncthreads();
    if (threadIdx.x == 0) {
        unsigned* bar = b.bar;
        __builtin_amdgcn_s_waitcnt(0);
        unsigned nloc = b.st[0], nx = b.st[1];
        if (nloc == 0u) { xcd_barrier_complete(bar, b.x, nloc, nx); b.st[0] = nloc; b.st[1] = nx; }
        const unsigned old = xb_add(&bar[XB_XSUB(b.x)], 1u);
        const unsigned gen = old / nloc;
        if (old + 1u == (gen + 1u) * nloc) {
            __builtin_amdgcn_fence(__ATOMIC_RELEASE, "agent");
            asm volatile("s_waitcnt vmcnt(0)" ::: "memory");
            const unsigned og = xb_add(&bar[XB_TOP], 1u);
            const unsigned tg = og / nx;
            if (og + 1u == (tg + 1u) * nx) xb_add(&bar[XB_TOPGEN], 1u);
            else XB_SPIN(xb_ld(&bar[XB_TOPGEN]) == tg, bar);
            __builtin_amdgcn_fence(__ATOMIC_ACQUIRE, "agent");
            xb_add(&bar[XB_XGEN(b.x)], 1u);
            asm volatile("s_waitcnt vmcnt(0)" ::: "memory");
        } else {
            XB_SPIN(xb_ld(&bar[XB_XGEN(b.x)]) == gen, bar);
            __builtin_amdgcn_fence(__ATOMIC_ACQUIRE, "agent");
            asm volatile("s_waitcnt vmcnt(0)" ::: "memory");
        }
    }
    __syncthreads();
}
namespace gk {
constexpr int BM = 256, BK = 64, HALF = 128, HTB = HALF * BK * 2, STAGE_BYTES = 8 * HTB;
__device__ __forceinline__ int lds_byte(int r, int c) { const int st = (r >> 4) * 2 + (c >> 5), rr = r & 15, cc = c & 31, ob = rr * 64 + cc * 2; return st * 1024 + (ob ^ (((ob >> 9) & 1) << 5)); }
__device__ __forceinline__ void stage_rc(int b, int& R, int& C) { const int st = b / 1024, sb = b % 1024, swz = sb ^ (((sb >> 9) & 1) << 5); R = (st >> 1) * 16 + swz / 64; C = (st & 1) * 32 + (swz % 64) / 2; }
__device__ __forceinline__ int perm32(int rho) { const int n = rho >> 4, i = rho & 15; return 8 * (i >> 2) + 4 * n + (i & 3); }

struct Unit {
    const char* A; const char* B;
    unsigned lda2, ldb2;
    int nt;
    int pm;
    int info;
    __device__ __forceinline__ int pn() const { return info & 0xff; }
    __device__ __forceinline__ int aux() const { return (info >> 8) & 0xff; }
    __device__ __forceinline__ int kind() const { return (info >> 16) & 0xff; }
    __device__ __forceinline__ int keep() const { return (info >> 24) & 1; }
    __device__ __forceinline__ void set(int pm_, int pn_, int aux_, int kind_, int keep_) { pm = pm_; info = pn_ | (aux_ << 8) | (kind_ << 16) | (keep_ << 24); }
};
typedef f32x4 Acc[2][2][4][2];

template <class Epi, class Sched>
__device__ __forceinline__ void gemm_phase(LAS unsigned char* lds, const Sched& S, const Epi& E) {
    const int tid = ltid(), wid = __builtin_amdgcn_readfirstlane(tid >> 6), lane = tid & 63, wr = wid >> 2, wc = wid & 3, fr = lane & 15, fq = lane >> 4;
#define GK_OFFS(U, a0, a1, b0, b1) do { int tz_ = ltid(); int R0_, C0_, R1_, C1_; stage_rc(tz_ * 16, R0_, C0_); stage_rc(tz_ * 16 + 8192, R1_, C1_); \
        a0 = (unsigned)R0_ * (U).lda2 + (unsigned)C0_ * 2u; a1 = (unsigned)R1_ * (U).lda2 + (unsigned)C1_ * 2u; \
        b0 = (unsigned)((R0_ & ~31) + perm32(R0_ & 31)) * (U).ldb2 + (unsigned)C0_ * 2u; b1 = (unsigned)((R1_ & ~31) + perm32(R1_ & 31)) * (U).ldb2 + (unsigned)C1_ * 2u; } while (0)
    const unsigned ldsw = (unsigned)wid * 1024u;
    const int aoff = lds_byte(wr * 64 + fr, fq * 8), boff = lds_byte(wc * 32 + fr, fq * 8);
#define GK_SA(b, h) (((b) * 2 + (h)) * HTB)
#define GK_SB(b, h) ((4 + (b) * 2 + (h)) * HTB)
#define GK_STAGE(bufoff, gbase, v0, v1) do { \
        __builtin_amdgcn_global_load_lds((const unsigned*)((const char*)(gbase) + (v0)), (LAS unsigned*)(lds + (bufoff) + ldsw), 16, 0, 0); \
        __builtin_amdgcn_global_load_lds((const unsigned*)((const char*)(gbase) + (v1)), (LAS unsigned*)(lds + (bufoff) + ldsw + 8192), 16, 0, 0); } while (0)
#define GK_LDA(dst, b, h) do { _Pragma("unroll") for (int m = 0; m < 4; ++m) _Pragma("unroll") for (int k = 0; k < 2; ++k) dst[m][k] = *(const LAS bf16x8*)(lds + GK_SA(b, h) + aoff + m * 2048 + k * 1024); } while (0)
#define GK_LDB(dst, b, h) do { _Pragma("unroll") for (int n = 0; n < 2; ++n) _Pragma("unroll") for (int k = 0; k < 2; ++k) dst[n][k] = *(const LAS bf16x8*)(lds + GK_SB(b, h) + boff + n * 2048 + k * 1024); } while (0)
#define GK_MMA(ai, bj, At, Bt) do { __builtin_amdgcn_s_setprio(1); _Pragma("unroll") for (int m = 0; m < 4; ++m) _Pragma("unroll") for (int n = 0; n < 2; ++n) _Pragma("unroll") for (int k = 0; k < 2; ++k) \
        acc[ai][bj][m][n] = __builtin_amdgcn_mfma_f32_16x16x32_bf16(Bt[n][k], At[m][k], acc[ai][bj][m][n], 0, 0, 0); __builtin_amdgcn_s_setprio(0); } while (0)
#define GK_WAIT_V(n) asm volatile("s_waitcnt vmcnt(" #n ")" ::: "memory")
#define GK_WAIT_L(n) asm volatile("s_waitcnt lgkmcnt(" #n ")" ::: "memory")
#define GK_BAR __builtin_amdgcn_s_barrier()
#define GK_SCHED __builtin_amdgcn_sched_barrier(0)
    Unit cur, nxt; int ui = 0;
    if (!S.next(0, cur)) return;
    Acc acc;
#pragma unroll
    for (int a = 0; a < 2; ++a)
#pragma unroll
        for (int b = 0; b < 2; ++b)
#pragma unroll
            for (int m = 0; m < 4; ++m)
#pragma unroll
                for (int n = 0; n < 2; ++n) acc[a][b][m][n] = (f32x4){0.f, 0.f, 0.f, 0.f};
    bf16x8 At[4][2], B0[2][2], B1[2][2];
    unsigned ca0, ca1, cb0, cb1; GK_OFFS(cur, ca0, ca1, cb0, cb1);
    {
        const char* cA = cur.A; const char* cB = cur.B; const size_t hA = (size_t)HALF * cur.lda2, hB = (size_t)HALF * cur.ldb2;
        GK_STAGE(GK_SB(0, 0), cB, cb0, cb1); GK_STAGE(GK_SB(0, 1), cB + hB, cb0, cb1); GK_STAGE(GK_SA(0, 0), cA, ca0, ca1); GK_STAGE(GK_SA(0, 1), cA + hA, ca0, ca1);
        if (wr == 1) GK_BAR;
        GK_WAIT_V(2); GK_BAR;
        GK_STAGE(GK_SB(1, 0), cB + 128, cb0, cb1); GK_STAGE(GK_SA(1, 0), cA + 128, ca0, ca1); GK_STAGE(GK_SB(1, 1), cB + hB + 128, cb0, cb1);
        GK_WAIT_V(6); GK_BAR;
    }
    for (;;) {
        const bool has_next = S.next(ui + 1, nxt);
        if (!has_next) nxt = cur;
        const size_t hA = (size_t)HALF * cur.lda2, hB = (size_t)HALF * cur.ldb2, nhA = (size_t)HALF * nxt.lda2, nhB = (size_t)HALF * nxt.ldb2;
        const int nt = cur.nt;
        for (int t = 0; t < nt; t += 2) {
            const bool last = (t == nt - 2);
            const char* a1 = cur.A + (size_t)(t + 1) * 128;
            const char* a2 = last ? nxt.A : cur.A + (size_t)(t + 2) * 128; const char* b2 = last ? nxt.B : cur.B + (size_t)(t + 2) * 128;
            const char* a3 = a2 + 128; const char* b3 = b2 + 128;
            const size_t h2A = last ? nhA : hA, h2B = last ? nhB : hB;
            GK_LDB(B0, 0, 0); GK_LDB(B1, 0, 1); GK_SCHED; GK_LDA(At, 0, 0); GK_STAGE(GK_SA(1, 1), a1 + hA, ca0, ca1);
            if (last) GK_OFFS(nxt, ca0, ca1, cb0, cb1);
            GK_WAIT_V(8); GK_WAIT_L(0); GK_BAR; GK_MMA(0, 0, At, B0); GK_MMA(0, 1, At, B1); GK_BAR; GK_SCHED;
            GK_LDA(At, 0, 1); GK_STAGE(GK_SB(0, 0), b2, cb0, cb1); GK_STAGE(GK_SB(0, 1), b2 + h2B, cb0, cb1); GK_STAGE(GK_SA(0, 0), a2, ca0, ca1);
            GK_WAIT_V(8); GK_WAIT_L(0); GK_BAR; GK_MMA(1, 0, At, B0); GK_MMA(1, 1, At, B1); GK_BAR; GK_SCHED;
            GK_LDB(B0, 1, 0); GK_LDB(B1, 1, 1); GK_SCHED; GK_LDA(At, 1, 0); GK_STAGE(GK_SA(0, 1), a2 + h2A, ca0, ca1);
            GK_WAIT_V(8); GK_WAIT_L(0); GK_BAR; GK_MMA(0, 0, At, B0); GK_MMA(0, 1, At, B1); GK_BAR; GK_SCHED;
            GK_LDA(At, 1, 1); GK_STAGE(GK_SB(1, 0), b3, cb0, cb1); GK_STAGE(GK_SB(1, 1), b3 + h2B, cb0, cb1); GK_STAGE(GK_SA(1, 0), a3, ca0, ca1);
            GK_WAIT_V(8); GK_WAIT_L(0); GK_BAR; GK_MMA(1, 0, At, B0); GK_MMA(1, 1, At, B1); GK_BAR; GK_SCHED;
        }
        if (wr == 0) GK_BAR;
        E(acc, cur, wr, wc, fr, fq);
        if (!has_next) break;
        if (!cur.keep()) {
#pragma unroll
            for (int a = 0; a < 2; ++a)
#pragma unroll
                for (int b = 0; b < 2; ++b)
#pragma unroll
                    for (int m = 0; m < 4; ++m)
#pragma unroll
                        for (int n = 0; n < 2; ++n) acc[a][b][m][n] = (f32x4){0.f, 0.f, 0.f, 0.f};
        }
        cur = nxt; ++ui;
        if (wr == 1) GK_BAR;
    }
    GK_WAIT_V(0);
    GK_BAR;
#undef GK_OFFS
#undef GK_SA
#undef GK_SB
#undef GK_STAGE
#undef GK_LDA
#undef GK_LDB
#undef GK_MMA
#undef GK_WAIT_V
#undef GK_WAIT_L
#undef GK_BAR
#undef GK_SCHED
}

__device__ __forceinline__ void tile_order(int L, int nM, int nN, int& pm, int& pn) {
    const int nwg = nM * nN; int wgid = L;
    { const int q = nwg / 8, r = nwg % 8, xcd = wgid % 8, off = wgid / 8; wgid = (xcd < r ? xcd * (q + 1) : r * (q + 1) + (xcd - r) * q) + off; }
    const int nig = 8 * nN, gid = wgid / nig, fm = gid * 8, gsz = (nM - fm) < 8 ? (nM - fm) : 8;
    pm = fm + ((wgid % nig) % gsz); pn = (wgid % nig) / gsz;
}
}
template <class ColF>
__device__ __forceinline__ void cvt_tr(const float* __restrict__ src, int ld_src, int Ksrc, bf16_t* __restrict__ dst, int Kdst, int N, const ColF& colf, const float* __restrict__ kscale,
                                       LAS float* tile, unsigned& ctr, int G, int c) {
    const int nkt = Kdst / 64, nnt = N / 64, ntile = nkt * nnt, tid = ltid();
    int t0 = (int)(((unsigned)c + (unsigned)G - (ctr % (unsigned)G)) % (unsigned)G);
    for (int tt = t0; tt < ntile; tt += G) {
        const int kt = tt / nnt, nt_ = tt % nnt;
        { const int nl = tid & 63, kl0 = tid >> 6; float mul; const int sc = colf(nt_ * 64 + nl, mul);
#pragma unroll
          for (int i = 0; i < 8; ++i) { const int kl = kl0 + 8 * i, k = kt * 64 + kl; float v = 0.f;
              if (sc >= 0 && k < Ksrc) { v = src[(size_t)k * ld_src + sc] * mul; if (kscale) v *= kscale[k]; }
              tile[kl * 65 + nl] = v; } }
        __syncthreads();
        { const int kp = tid & 31, nl0 = tid >> 5;
#pragma unroll
          for (int i = 0; i < 4; ++i) { const int nl = nl0 + 16 * i;
              const unsigned w = cvt_pk_bf16(tile[(2 * kp) * 65 + nl], tile[(2 * kp + 1) * 65 + nl]);
              *(unsigned*)(dst + (size_t)(nt_ * 64 + nl) * Kdst + kt * 64 + 2 * kp) = w; } }
        __syncthreads();
    }
    ctr += (unsigned)ntile;
}

__device__ __forceinline__ int g1_col(int n, float& mul) {
    mul = 1.0f;
    if (n < 256) return CO_Q + n;
    if (n < 512) { const int r = n - 256; if (r < 160) return CO_KV + r; if (r < 176) return CO_GF + (r - 160); if (r < 192) return CO_GB + (r - 176); return -1; }
    if (n < 1024) return CO_FN + (n - 512);
    if (n < 1280) { mul = 0.125f; return CO_GQ + (n - 1024); }
    if (n < 1536) return CO_GK + (n - 1280);
    if (n < 2048) return CO_GV + (n - 1536);
    if (n < 2560) return CO_OG + (n - 2048);
    return CO_GATE + (n - 2560);
}
__device__ __forceinline__ int uq_col(int n, float& mul) {
    mul = 1.0f;
    if (n < 512) return (n >> 6) * 96 + (n & 63);
    const int r = n - 512, h = r >> 5, j = r & 31, axis = j >> 4, i = (j & 15) >> 1;
    return h * 96 + 64 + axis * 16 + i + 8 * (j & 1);
}
__device__ __forceinline__ int ukv_col(int n, float& mul) { mul = 1.0f; if (n < 512) return (n >> 6) * 128 + (n & 63); const int r = n - 512; return (r >> 6) * 128 + 64 + (r & 63); }
__device__ __forceinline__ int ident_col(int n, float& mul) { mul = 1.0f; return n; }
__device__ __forceinline__ int up_col(int n, float& mul) { mul = 1.0f; const int pn = n >> 8, r = n & 255; return r < 128 ? pn * 128 + r : 1024 + pn * 128 + (r - 128); }

struct G1ColF { __device__ int operator()(int n, float& m) const { return g1_col(n, m); } };
struct UqColF { __device__ int operator()(int n, float& m) const { return uq_col(n, m); } };
struct UkvColF { __device__ int operator()(int n, float& m) const { return ukv_col(n, m); } };
struct IdColF { __device__ int operator()(int n, float& m) const { return ident_col(n, m); } };
struct UpColF { __device__ int operator()(int n, float& m) const { return up_col(n, m); } };

__device__ __forceinline__ void prologue_phase(const PTab& p, LAS unsigned char* lds, int G, int c) {
    const int tid = ltid();
    char* ws = p.ws();
    {
        float4* X = (float4*)(ws + WS_X); const float4* pctx = (const float4*)p.ctx(); const float4* px = (const float4*)p.x();
        const size_t n4 = (size_t)T * (D / 4);
        for (size_t i = (size_t)c * 512 + tid; i < n4; i += (size_t)G * 512) {
            const int row = (int)(i >> 8), q = (int)(i & 255), b = row / RPB, r = row % RPB;
            const float4 v = (r < CTX) ? pctx[((size_t)(b * CTX + r) << 8) + q] : px[((size_t)(b * SEQ + (r - CTX)) << 8) + q];
            X[i] = v;
        }
    }
    if (c == 0) {
        float* R = (float*)(ws + WS_ROPE);
        const int pos = tid >> 3, i = tid & 7;
        const float inv = powf(10000.0f, -(float)(2 * i) / 16.0f), ang = (float)pos * inv;
        R[tid * 2] = cosf(ang); R[tid * 2 + 1] = sinf(ang);
    }
    {
        bf16_t* DL = (bf16_t*)(ws + WS_DFTL);
        const size_t n8 = (size_t)8192 * 4096 / 8;
        for (size_t i = (size_t)c * 512 + tid; i < n8; i += (size_t)G * 512) {
            const int r = (int)(i >> 9), t0 = (int)(i & 511) * 8, k = r & 4095; float v[8];
#pragma unroll
            for (int j = 0; j < 8; ++j) { const int m = (k * (t0 + j)) & 4095; float s, co; sincospif((float)m * (1.0f / 2048.0f), &s, &co); v[j] = (r < 4096 ? co : s) * (1.0f / 64.0f); }
            u32x4 w; w.x = cvt_pk_bf16(v[0], v[1]); w.y = cvt_pk_bf16(v[2], v[3]); w.z = cvt_pk_bf16(v[4], v[5]); w.w = cvt_pk_bf16(v[6], v[7]);
            *(u32x4*)(DL + i * 8) = w;
        }
        bf16_t* DC = (bf16_t*)(ws + WS_DFTC);
        for (int i = c * 512 + tid; i < 512 * 256 / 8; i += G * 512) {
            const int r = i >> 5, t0 = (i & 31) * 8, k = r & 255; float v[8];
#pragma unroll
            for (int j = 0; j < 8; ++j) { const int m = (k * (t0 + j)) & 255; float s, co; sincospif((float)m * (1.0f / 128.0f), &s, &co); v[j] = (r < 256 ? co : s) * (1.0f / 16.0f); }
            u32x4 w; w.x = cvt_pk_bf16(v[0], v[1]); w.y = cvt_pk_bf16(v[2], v[3]); w.z = cvt_pk_bf16(v[4], v[5]); w.w = cvt_pk_bf16(v[6], v[7]);
            *(u32x4*)(DC + (size_t)i * 8) = w;
        }
    }
    for (int job = c; job < DEPTH * 12; job += G) {
        LAS float* sl = (LAS float*)lds;
        { const float* cc = p.c(); const float* ccx = p.c_ctx();
          for (int i = tid; i < 9 * 1024; i += 512) { const int s = i >> 10, k = i & 1023; const float v = (s < 8) ? cc[s * 1024 + k] : ccx[k]; sl[i] = siluf_(v); } }
        __syncthreads();
        const int l = job / 12, j = (job % 12) * 512 + tid;
        const float* W = p.w_mod() + (size_t)l * 1024 * 6144 + j;
        float a[9];
#pragma unroll
        for (int s = 0; s < 9; ++s) a[s] = 0.f;
        for (int k = 0; k < 1024; ++k) { const float w = W[(size_t)k * 6144];
#pragma unroll
            for (int s = 0; s < 9; ++s) a[s] += sl[s * 1024 + k] * w; }
        const float bm = p.b_mod()[l * 6144 + j];
        float* M = (float*)(ws + WS_MOD) + (size_t)l * 9 * 6144 + j;
#pragma unroll
        for (int s = 0; s < 9; ++s) M[s * 6144] = a[s] + bm;
        __syncthreads();
    }
    {
        LAS float* tile = (LAS float*)lds;
        LAS float* trig = (LAS float*)(lds + 32768);
        if (tid < 128) { float s, co; sincospif((float)tid * (1.0f / 64.0f), &s, &co); trig[tid] = co; trig[128 + tid] = s; }
        __syncthreads();
        for (int job = c; job < DEPTH * 256; job += G) {
            const int l = job >> 8, kt = (job >> 4) & 15, jt = job & 15;
            const int jl = tid & 63, kg = tid >> 6;
            const int kidx0 = kt * 64 + kg * 8, part = kidx0 >> 9, g = (kidx0 >> 7) & 3, cc0 = kidx0 & 127;
            const float* W = p.w_br_fnet() + (size_t)l * 512 * 1024 + (size_t)(g * 128) * 1024 + jt * 64 + jl;
            float a[8];
#pragma unroll
            for (int q = 0; q < 8; ++q) a[q] = 0.f;
            for (int m = 0; m < 128; ++m) { const float w = W[(size_t)m * 1024];
#pragma unroll
                for (int q = 0; q < 8; ++q) a[q] += w * trig[part * 128 + ((m * (cc0 + q)) & 127)]; }
            const float sc = (part ? -1.0f : 1.0f) * 0.08838834764831845f;
#pragma unroll
            for (int q = 0; q < 8; ++q) tile[(kg * 8 + q) * 65 + jl] = a[q] * sc;
            __syncthreads();
            { bf16_t* dst = (bf16_t*)(ws + WS_W + (size_t)l * WL_BYTES + WL_WF);
              const int kp = tid & 31, nl0 = tid >> 5;
#pragma unroll
              for (int i = 0; i < 4; ++i) { const int nl = nl0 + 16 * i;
                  *(unsigned*)(dst + (size_t)(jt * 64 + nl) * 1024 + kt * 64 + 2 * kp) = cvt_pk_bf16(tile[(2 * kp) * 65 + nl], tile[(2 * kp + 1) * 65 + nl]); } }
            __syncthreads();
        }
    }
    {
        LAS float* tile = (LAS float*)lds; unsigned ctr = 0;
        for (int l = 0; l < DEPTH; ++l) {
            char* wl = ws + WS_W + (size_t)l * WL_BYTES;
            cvt_tr(p.w_in() + (size_t)l * 1024 * INW, INW, 1024, (bf16_t*)(wl + WL_WIN), 1024, G1N, G1ColF(), nullptr, tile, ctr, G, c);
            cvt_tr(p.w_uq() + (size_t)l * 256 * 768, 768, 256, (bf16_t*)(wl + WL_WUQ), 256, 768, UqColF(), p.q_norm_g() + l * 256, tile, ctr, G, c);
            cvt_tr(p.w_ukv() + (size_t)l * 128 * 1024, 1024, 128, (bf16_t*)(wl + WL_WUKV), 256, 1024, UkvColF(), p.kv_norm_g() + l * 128, tile, ctr, G, c);
            cvt_tr(p.w_br_mla() + (size_t)l * 512 * 1024, 1024, 512, (bf16_t*)(wl + WL_WM), 512, 1024, IdColF(), nullptr, tile, ctr, G, c);
            cvt_tr(p.w_br_gla() + (size_t)l * 512 * 1024, 1024, 512, (bf16_t*)(wl + WL_WG), 512, 1024, IdColF(), nullptr, tile, ctr, G, c);
            cvt_tr(p.w_o() + (size_t)l * 1024 * 1024, 1024, 1024, (bf16_t*)(wl + WL_WO), 1024, 1024, IdColF(), nullptr, tile, ctr, G, c);
            for (int e = 0; e < NE; ++e) {
                cvt_tr(p.w_up() + ((size_t)l * NE + e) * 1024 * 2048, 2048, 1024, (bf16_t*)(wl + WL_WUP) + (size_t)e * 2048 * 1024, 1024, 2048, UpColF(), nullptr, tile, ctr, G, c);
                cvt_tr(p.w_down() + ((size_t)l * NE + e) * 1024 * 1024, 1024, 1024, (bf16_t*)(wl + WL_WDN) + (size_t)e * 1024 * 1024, 1024, 1024, IdColF(), nullptr, tile, ctr, G, c);
            }
        }
    }
}

__device__ __forceinline__ void norm_mod_row(const float* __restrict__ xrow, const float* __restrict__ g, const float* __restrict__ shift, const float* __restrict__ scale, bf16_t* __restrict__ hrow, int lane) {
    f32x4 v[4]; float ss = 0.f;
#pragma unroll
    for (int i = 0; i < 4; ++i) { v[i] = *(const f32x4*)(xrow + i * 256 + lane * 4); ss += v[i][0] * v[i][0] + v[i][1] * v[i][1] + v[i][2] * v[i][2] + v[i][3] * v[i][3]; }
#pragma unroll
    for (int o = 32; o >= 1; o >>= 1) ss += __shfl_xor(ss, o);
    const float rs = rsqrtf(ss * (1.0f / 1024.0f) + EPS);
#pragma unroll
    for (int i = 0; i < 4; ++i) { const int col = i * 256 + lane * 4; const f32x4 gg = *(const f32x4*)(g + col), sh = *(const f32x4*)(shift + col), sc = *(const f32x4*)(scale + col);
        float o[4];
#pragma unroll
        for (int j = 0; j < 4; ++j) o[j] = v[i][j] * rs * gg[j] * (1.0f + sc[j]) + sh[j];
        u32x2 w; w.x = cvt_pk_bf16(o[0], o[1]); w.y = cvt_pk_bf16(o[2], o[3]); *(u32x2*)(hrow + col) = w; }
}
__device__ __forceinline__ void norm1_phase(const PTab& p, int l, int G, int c) {
    const int tid_ = ltid(), wid = tid_ >> 6, lane = tid_ & 63; char* ws = p.ws();
    const float* X = (const float*)(ws + WS_X); bf16_t* H = (bf16_t*)(ws + WS_H);
    const float* M = (const float*)(ws + WS_MOD) + (size_t)l * 9 * 6144; const float* n1g = p.norm1_g() + l * D;
    for (int row = c * 8 + wid; row < T; row += G * 8) {
        const int b = row / RPB, s = (row % RPB) < CTX ? 8 : b;
        norm_mod_row(X + (size_t)row * D, n1g, M + s * 6144, M + s * 6144 + 1024, H + (size_t)row * D, lane);
    }
}
using gk::Unit; using gk::Acc;
__device__ __forceinline__ u32x4 pack8(const f32x4& a, const f32x4& b) { u32x4 w; w.x = cvt_pk_bf16(a[0], a[1]); w.y = cvt_pk_bf16(a[2], a[3]); w.z = cvt_pk_bf16(b[0], b[1]); w.w = cvt_pk_bf16(b[2], b[3]); return w; }
__device__ __forceinline__ void unpack8(const u32x4& w, float (&f)[8]) { f[0] = bflo(w.x); f[1] = bfhi(w.x); f[2] = bflo(w.y); f[3] = bfhi(w.y); f[4] = bflo(w.z); f[5] = bfhi(w.z); f[6] = bflo(w.w); f[7] = bfhi(w.w); }
#define EROW(ai, m) (128 * (ai) + 64 * wr + 16 * (m) + fr)
#define ECOL(bj) (128 * (bj) + 32 * wc + 8 * fq)
#define EFENCE() asm volatile("" ::: "memory")

struct G1Sched {
    const char* H; const char* W; int G, c;
    __device__ __forceinline__ bool next(int i, Unit& u) const {
        const int L = i * G + c; if (L >= NMT * 22) return false;
        int pm, pn; gk::tile_order(L, NMT, 22, pm, pn);
        u.nt = 16; u.lda2 = 2048u; u.ldb2 = 2048u;
        const char* a = H + (size_t)pm * 256 * 2048; const char* b = W + (size_t)pn * 256 * 2048;
        if (pn == 2 || pn == 3) { u.set(pm, pn, 0, 1, 0); u.A = b; u.B = a; } else { u.set(pm, pn, 0, 0, 0); u.A = a; u.B = b; }
        return true;
    }
};
struct G1Epi {
    char* ws;
    __device__ __forceinline__ void operator()(Acc& acc, const Unit& u, int wr, int wc, int fr, int fq) const {
        const int pn = u.pn(), pm = u.pm;
        if (u.kind() == 0) {
            size_t base; int ld, coff = 0;
            if (pn == 0) { base = WS_UQ; ld = 256; } else if (pn == 1) { base = WS_UKV; ld = 256; } else if (pn == 4) { base = WS_GQ; ld = 256; } else if (pn == 5) { base = WS_GK; ld = 256; }
            else if (pn < 8) { base = WS_GV; ld = 512; coff = (pn - 6) * 256; } else if (pn < 10) { base = WS_GOG; ld = 512; coff = (pn - 8) * 256; } else { base = WS_GATE; ld = 3072; coff = (pn - 10) * 256; }
            bf16_t* dst = (bf16_t*)(ws + base);
#pragma unroll
            for (int ai = 0; ai < 2; ++ai)
#pragma unroll
                for (int m = 0; m < 4; ++m) { bf16_t* rowp = dst + (size_t)(pm * 256 + EROW(ai, m)) * ld + coff;
#pragma unroll
                    for (int bj = 0; bj < 2; ++bj) *(u32x4*)(rowp + ECOL(bj)) = pack8(acc[ai][bj][m][0], acc[ai][bj][m][1]); }
            if (pn <= 1) {
                float* ssq = (float*)(ws + WS_SSQ);
#pragma unroll
                for (int ai = 0; ai < 2; ++ai)
#pragma unroll
                    for (int m = 0; m < 4; ++m) { float s = 0.f;
#pragma unroll
                        for (int bj = 0; bj < 2; ++bj) { if (pn == 1 && bj == 1) continue;
#pragma unroll
                            for (int n = 0; n < 2; ++n) { const f32x4 x = acc[ai][bj][m][n]; s += x[0] * x[0] + x[1] * x[1] + x[2] * x[2] + x[3] * x[3]; } }
                        s += __shfl_xor(s, 16); s += __shfl_xor(s, 32);
                        if (fq == 0) ssq[(size_t)(pm * 256 + EROW(ai, m)) * 8 + pn * 4 + wc] = s; }
            }
        } else {
            bf16_t* dst = (bf16_t*)(ws + WS_UFT); const int b = pm / 17, i0 = (pm % 17) * 256;
#pragma unroll
            for (int ai = 0; ai < 2; ++ai)
#pragma unroll
                for (int m = 0; m < 4; ++m) { const int ch = (pn - 2) * 256 + EROW(ai, m); bf16_t* rowp = dst + ((size_t)(b * 512 + ch)) * RPB + i0;
#pragma unroll
                    for (int bj = 0; bj < 2; ++bj) *(u32x4*)(rowp + ECOL(bj)) = pack8(acc[ai][bj][m][0], acc[ai][bj][m][1]); }
        }
    }
};

struct DftSched {
    char* ws; int l, G, c;
    __device__ __forceinline__ bool next(int i, Unit& u) const {
        int L = i * G + c;
        if (L < 512) { const int b = L >> 6, mt = (L >> 1) & 31, nn = L & 1;
            u.set(mt, nn, b, 10, 0); u.nt = 64; u.lda2 = 8192u; u.ldb2 = (unsigned)RPB * 2u;
            u.A = ws + WS_DFTL + (size_t)mt * 256 * 8192; u.B = ws + WS_UFT + ((size_t)(b * 512 + nn * 256) * RPB + CTX) * 2; return true; }
        L -= 512;
        if (l < DEPTH - 1 && L < 32) { const int b = L >> 2, mt = (L >> 1) & 1, nn = L & 1;
            u.set(mt, nn, b, 11, 0); u.nt = 4; u.lda2 = 512u; u.ldb2 = (unsigned)RPB * 2u;
            u.A = ws + WS_DFTC + (size_t)mt * 256 * 512; u.B = ws + WS_UFT + ((size_t)(b * 512 + nn * 256) * RPB) * 2; return true; }
        return false;
    }
};
struct DftEpi {
    char* ws;
    __device__ __forceinline__ void operator()(Acc& acc, const Unit& u, int wr, int wc, int fr, int fq) const {
        bf16_t* P = (bf16_t*)(ws + WS_P); const int pm = u.pm, pn = u.pn(), b = u.aux(); const bool lat = u.kind() == 10;
        const int rbase = lat ? (b * RPB + CTX + (pm & 15) * 256) : (b * RPB);
        const int cbase = (lat ? (pm >> 4) : pm) * 512 + pn * 256;
#pragma unroll
        for (int ai = 0; ai < 2; ++ai)
#pragma unroll
            for (int m = 0; m < 4; ++m) { bf16_t* rowp = P + (size_t)(rbase + EROW(ai, m)) * 1024 + cbase;
#pragma unroll
                for (int bj = 0; bj < 2; ++bj) *(u32x4*)(rowp + ECOL(bj)) = pack8(acc[ai][bj][m][0], acc[ai][bj][m][1]); }
    }
};
__device__ __forceinline__ float ssq_scale(const float* ssq, int row, int which, float inv_n) { const f32x4 s = *(const f32x4*)(ssq + (size_t)row * 8 + which * 4); return rsqrtf((s[0] + s[1] + s[2] + s[3]) * inv_n + EPS); }
struct QSched {
    char* ws; const char* wl; int G, c;
    __device__ __forceinline__ bool next(int i, Unit& u) const {
        const int L = i * G + c; if (L >= NMT * 3) return false; const int pm = L / 3, pn = L % 3;
        u.set(pm, pn, 0, 12, 0); u.nt = 4; u.lda2 = 512u; u.ldb2 = 512u;
        u.A = ws + WS_UQ + (size_t)pm * 256 * 512; u.B = wl + WL_WUQ + (size_t)pn * 256 * 512; return true;
    }
};
struct QEpi {
    char* ws;
    __device__ __forceinline__ void operator()(Acc& acc, const Unit& u, int wr, int wc, int fr, int fq) const {
        const int pm = u.pm, pn = u.pn();
        const float* ssq = (const float*)(ws + WS_SSQ); bf16_t* Q = (bf16_t*)(ws + WS_Q); const f32x2* rope = (const f32x2*)(ws + WS_ROPE);
#pragma unroll
        for (int ai = 0; ai < 2; ++ai)
#pragma unroll
            for (int m = 0; m < 4; ++m) { const int row = pm * 256 + EROW(ai, m); const float sc = ssq_scale(ssq, row, 0, 1.0f / 256.0f) * QSCALE;
                const int ib = row % RPB, tl = ib - CTX;
#pragma unroll
                for (int bj = 0; bj < 2; ++bj) { f32x4 v0 = acc[ai][bj][m][0] * sc, v1 = acc[ai][bj][m][1] * sc;
                    const int cc = ECOL(bj);
                    if (pn < 2) { const int col = pn * 256 + cc, h = col >> 6, d = col & 63; *(u32x4*)(Q + (size_t)row * 768 + h * 96 + d) = pack8(v0, v1); }
                    else { const int h = cc >> 5, axis = fq >> 1, i0 = 4 * (fq & 1);
                        if (tl >= 0) { const int pos = axis ? (tl & 63) : (tl >> 6);
                            const f32x2 r0 = rope[pos * 8 + i0], r1 = rope[pos * 8 + i0 + 1], r2 = rope[pos * 8 + i0 + 2], r3 = rope[pos * 8 + i0 + 3];
                            f32x4 o0, o1;
                            o0[0] = v0[0] * r0.x - v0[1] * r0.y; o0[1] = v0[1] * r0.x + v0[0] * r0.y; o0[2] = v0[2] * r1.x - v0[3] * r1.y; o0[3] = v0[3] * r1.x + v0[2] * r1.y;
                            o1[0] = v1[0] * r2.x - v1[1] * r2.y; o1[1] = v1[1] * r2.x + v1[0] * r2.y; o1[2] = v1[2] * r3.x - v1[3] * r3.y; o1[3] = v1[3] * r3.x + v1[2] * r3.y;
                            v0 = o0; v1 = o1; }
                        *(u32x4*)(Q + (size_t)row * 768 + h * 96 + 64 + 8 * fq) = pack8(v0, v1); } }
                EFENCE(); }
    }
};
struct KnSched {
    char* ws; const char* wl; int G, c;
    __device__ __forceinline__ bool next(int i, Unit& u) const {
        const int L = i * G + c; if (L >= NMT * 2) return false; const int pm = L >> 1, pn = L & 1;
        u.set(pm, pn, 0, 13, 0); u.nt = 4; u.lda2 = 512u; u.ldb2 = 512u;
        u.A = ws + WS_UKV + (size_t)pm * 256 * 512; u.B = wl + WL_WUKV + (size_t)pn * 256 * 512; return true;
    }
};
struct KnEpi {
    char* ws;
    __device__ __forceinline__ void operator()(Acc& acc, const Unit& u, int wr, int wc, int fr, int fq) const {
        const float* ssq = (const float*)(ws + WS_SSQ); bf16_t* KN = (bf16_t*)(ws + WS_KN); const int pm = u.pm, pn = u.pn();
#pragma unroll
        for (int ai = 0; ai < 2; ++ai)
#pragma unroll
            for (int m = 0; m < 4; ++m) { const int row = pm * 256 + EROW(ai, m); const float sc = ssq_scale(ssq, row, 1, 1.0f / 128.0f);
#pragma unroll
                for (int bj = 0; bj < 2; ++bj) *(u32x4*)(KN + (size_t)row * 512 + pn * 256 + ECOL(bj)) = pack8(acc[ai][bj][m][0] * sc, acc[ai][bj][m][1] * sc); }
    }
};
struct VtSched {
    char* ws; const char* wl; int G, c;
    __device__ __forceinline__ bool next(int i, Unit& u) const {
        const int L = i * G + c; if (L >= NMT * 2) return false; const int pm = L >> 1, pn = L & 1;
        u.set(pm, pn, 0, 14, 0); u.nt = 4; u.lda2 = 512u; u.ldb2 = 512u;
        u.A = wl + WL_WUKV + (size_t)(2 + pn) * 256 * 512; u.B = ws + WS_UKV + (size_t)pm * 256 * 512; return true;
    }
};
struct VtEpi {
    char* ws;
    __device__ __forceinline__ void operator()(Acc& acc, const Unit& u, int wr, int wc, int fr, int fq) const {
        const float* ssq = (const float*)(ws + WS_SSQ); bf16_t* VT = (bf16_t*)(ws + WS_VT); const int pm = u.pm, pn = u.pn(), b = pm / 17, i0 = (pm % 17) * 256;
#pragma unroll
        for (int bj = 0; bj < 2; ++bj) { float sc[8];
#pragma unroll
            for (int j = 0; j < 8; ++j) sc[j] = ssq_scale(ssq, pm * 256 + ECOL(bj) + j, 1, 1.0f / 128.0f);
#pragma unroll
            for (int ai = 0; ai < 2; ++ai)
#pragma unroll
                for (int m = 0; m < 4; ++m) { const int vc = pn * 256 + EROW(ai, m);
                    f32x4 v0 = acc[ai][bj][m][0], v1 = acc[ai][bj][m][1];
#pragma unroll
                    for (int j = 0; j < 4; ++j) { v0[j] *= sc[j]; v1[j] *= sc[4 + j]; }
                    *(u32x4*)(VT + ((size_t)(b * 512 + vc)) * RPB + i0 + ECOL(bj)) = pack8(v0, v1); }
            EFENCE(); }
    }
};

__device__ __forceinline__ int act_tile(int l, int at) { return (l < DEPTH - 1) ? at : at + at / 16 + 1; }
__device__ __forceinline__ int n_act_tiles(int l) { return (l < DEPTH - 1) ? NMT : NMT - NB; }
struct MergeSched {
    char* ws; const char* wl; int l, G, c;
    __device__ __forceinline__ bool next(int i, Unit& u) const {
        const int it = (i / 3) * G + c, seg = i % 3; if (it >= n_act_tiles(l) * 4) return false;
        const int pm = act_tile(l, it >> 2), pn = it & 3;
        u.set(pm, pn, seg, 20, seg < 2 ? 1 : 0);
        if (seg == 0) { u.A = ws + WS_OMLA + (size_t)pm * 256 * 1024; u.B = wl + WL_WM + (size_t)pn * 256 * 1024; u.lda2 = 1024u; u.ldb2 = 1024u; u.nt = 8; }
        else if (seg == 1) { u.A = ws + WS_P + (size_t)pm * 256 * 2048; u.B = wl + WL_WF + (size_t)pn * 256 * 2048; u.lda2 = 2048u; u.ldb2 = 2048u; u.nt = 16; }
        else { u.A = ws + WS_OGLA + (size_t)pm * 256 * 1024; u.B = wl + WL_WG + (size_t)pn * 256 * 1024; u.lda2 = 1024u; u.ldb2 = 1024u; u.nt = 8; }
        return true;
    }
};
struct MergeEpi {
    char* ws;
    __device__ __forceinline__ void operator()(Acc& acc, const Unit& u, int wr, int wc, int fr, int fq) const {
        const bf16_t* GT = (const bf16_t*)(ws + WS_GATE); bf16_t* Y = (bf16_t*)(ws + WS_Y); const int seg = u.aux(), pn = u.pn();
        const int oa = (seg < 2) ? seg * 1024 : 2048, ob = (seg < 2) ? (seg + 1) * 1024 : 2048;
#pragma unroll
        for (int ai = 0; ai < 2; ++ai)
#pragma unroll
            for (int m = 0; m < 4; ++m) { const int row = u.pm * 256 + EROW(ai, m);
#pragma unroll
                for (int bj = 0; bj < 2; ++bj) { const int col = pn * 256 + ECOL(bj); const bf16_t* gp = GT + (size_t)row * 3072 + col;
                    float a[8], b[8]; unpack8(*(const u32x4*)(gp + oa), a); unpack8(*(const u32x4*)(gp + ob), b);
                    f32x4& v0 = acc[ai][bj][m][0]; f32x4& v1 = acc[ai][bj][m][1];
#pragma unroll
                    for (int j = 0; j < 8; ++j) { const float ea = __expf(-fminf(fmaxf(a[j], -30.f), 30.f)), eb = __expf(-fminf(fmaxf(b[j], -30.f), 30.f));
                        const float f = ((seg < 2) ? (1.0f + eb) : 1.0f) / (1.0f + ea);
                        if (j < 4) v0[j] *= f; else v1[j - 4] *= f; }
                    if (seg == 2) *(u32x4*)(Y + (size_t)row * 1024 + col) = pack8(v0, v1); }
                EFENCE(); }
    }
};

struct WoSched {
    char* ws; const char* wl; int l, G, c;
    __device__ __forceinline__ bool next(int i, Unit& u) const {
        const int it = i * G + c; if (it >= n_act_tiles(l) * 4) return false;
        const int pm = act_tile(l, it >> 2), pn = it & 3;
        u.set(pm, pn, 0, 30, 0); u.nt = 16; u.lda2 = 2048u; u.ldb2 = 2048u;
        u.A = ws + WS_Y + (size_t)pm * 256 * 2048; u.B = wl + WL_WO + (size_t)pn * 256 * 2048; return true;
    }
};
struct WoEpi {
    char* ws; int l;
    __device__ __forceinline__ void operator()(Acc& acc, const Unit& u, int wr, int wc, int fr, int fq) const {
        float* X = (float*)(ws + WS_X); const int pn = u.pn(), s = (u.pm % 17 == 0) ? 8 : u.pm / 17;
        const float* g1 = (const float*)(ws + WS_MOD) + ((size_t)l * 9 + s) * 6144 + 2048;
        f32x4 gv[2][2];
#pragma unroll
        for (int bj = 0; bj < 2; ++bj) { const int col = pn * 256 + ECOL(bj); gv[bj][0] = *(const f32x4*)(g1 + col); gv[bj][1] = *(const f32x4*)(g1 + col + 4); }
#pragma unroll
        for (int ai = 0; ai < 2; ++ai)
#pragma unroll
            for (int m = 0; m < 4; ++m) { float* rowp = X + (size_t)(u.pm * 256 + EROW(ai, m)) * 1024 + pn * 256;
#pragma unroll
                for (int bj = 0; bj < 2; ++bj) { float* q = rowp + ECOL(bj);
                    const f32x4 x0 = *(const f32x4*)q, x1 = *(const f32x4*)(q + 4);
                    *(f32x4*)q = x0 + gv[bj][0] * acc[ai][bj][m][0]; *(f32x4*)(q + 4) = x1 + gv[bj][1] * acc[ai][bj][m][1]; }
                EFENCE(); }
    }
};

struct MoeSched {
    const char* A; const char* W; const LAS int* tb; int npn, G, c; size_t wstride;
    __device__ __forceinline__ bool next(int i, Unit& u) const {
        const int L = i * G + c, total = __builtin_amdgcn_readfirstlane(tb[32]); if (L >= total * npn) return false;
        const int tg = L / npn, pn = L % npn; int e = 0;
#pragma unroll
        for (int k = 16; k >= 1; k >>= 1) { const int v = __builtin_amdgcn_readfirstlane(tb[e + k]); if (v <= tg) e += k; }
        u.set(tg, pn, e, 40, 0); u.nt = 16; u.lda2 = 2048u; u.ldb2 = 2048u;
        u.A = A + (size_t)tg * 256 * 2048; u.B = W + (size_t)e * wstride + (size_t)pn * 256 * 2048; return true;
    }
};
struct UpEpi {
    char* ws; const float* b_up;
    __device__ __forceinline__ void operator()(Acc& acc, const Unit& u, int wr, int wc, int fr, int fq) const {
        bf16_t* ACT = (bf16_t*)(ws + WS_ACT); const float* bu = b_up + (size_t)u.aux() * 2048;
        const int cg = u.pn() * 128 + 32 * wc + 8 * fq;
        const f32x4 bg0 = *(const f32x4*)(bu + cg), bg1 = *(const f32x4*)(bu + cg + 4), bl0 = *(const f32x4*)(bu + 1024 + cg), bl1 = *(const f32x4*)(bu + 1024 + cg + 4);
#pragma unroll
        for (int ai = 0; ai < 2; ++ai)
#pragma unroll
            for (int m = 0; m < 4; ++m) { f32x4 o[2];
#pragma unroll
                for (int n = 0; n < 2; ++n)
#pragma unroll
                    for (int j = 0; j < 4; ++j) { float gl = acc[ai][0][m][n][j] + (n ? bg1[j] : bg0[j]), li = acc[ai][1][m][n][j] + (n ? bl1[j] : bl0[j]);
                        gl = fminf(gl, 7.0f); li = fminf(fmaxf(li, -7.0f), 7.0f);
                        o[n][j] = gl / (1.0f + __expf(-1.702f * gl)) * (li + 1.0f); }
                *(u32x4*)(ACT + (size_t)(u.pm * 256 + EROW(ai, m)) * 1024 + cg) = pack8(o[0], o[1]); }
    }
};
struct DownEpi {
    char* ws; const float* b_down;
    __device__ __forceinline__ void operator()(Acc& acc, const Unit& u, int wr, int wc, int fr, int fq) const {
        bf16_t* YM = (bf16_t*)(ws + WS_YM); const float* bd = b_down + (size_t)u.aux() * 1024; const int pn = u.pn();
        f32x4 bv[2][2];
#pragma unroll
        for (int bj = 0; bj < 2; ++bj) { const int col = pn * 256 + ECOL(bj); bv[bj][0] = *(const f32x4*)(bd + col); bv[bj][1] = *(const f32x4*)(bd + col + 4); }
#pragma unroll
        for (int ai = 0; ai < 2; ++ai)
#pragma unroll
            for (int m = 0; m < 4; ++m) { bf16_t* rowp = YM + (size_t)(u.pm * 256 + EROW(ai, m)) * 1024 + pn * 256;
#pragma unroll
                for (int bj = 0; bj < 2; ++bj) *(u32x4*)(rowp + ECOL(bj)) = pack8(acc[ai][bj][m][0] + bv[bj][0], acc[ai][bj][m][1] + bv[bj][1]); }
    }
};
namespace at {
constexpr int KSLOT = 12288, VSLOT = 8192, OFF_V = 2 * KSLOT, OFF_WS = OFF_V + 2 * VSLOT, OFF_OST = OFF_WS + 8 * 256, LDS_NEED = OFF_OST + 8 * 4096;
__device__ __forceinline__ int crow(int r, int hi) { return (r & 3) + 8 * (r >> 2) + 4 * hi; }

__device__ __forceinline__ void attn_unit(char* ws, LAS unsigned char* lds, int b, int h, int qrow0, int nkt) {
    const int tid = ltid(), lane = tid & 63, r32 = lane & 31, hi = lane >> 5, wid = __builtin_amdgcn_readfirstlane(tid >> 6);
    const bf16_t* Q = (const bf16_t*)(ws + WS_Q); bf16_t* O = (bf16_t*)(ws + WS_OMLA);
    const size_t rowb = (size_t)b * RPB;
    const char* src[3]; unsigned inc[3], dsto[3];
#pragma unroll
    for (int j = 0; j < 3; ++j) {
        int pc = wid + 8 * j; if (pc >= 20) pc -= 8;
        if (pc < 8) { src[j] = ws + WS_KN + ((rowb + lane) * 512 + h * 64 + pc * 8) * 2; inc[j] = 64u * 1024u; dsto[j] = (unsigned)pc * 1024u; }
        else if (pc < 12) { src[j] = ws + WS_KR + ((rowb + lane) * 32 + (pc - 8) * 8) * 2; inc[j] = 64u * 64u; dsto[j] = (unsigned)pc * 1024u; }
        else { const int v = pc - 12, d = 8 * v + (lane >> 3), cl = lane & 7, lc = cl ^ ((d >> 1) & 7);
            src[j] = ws + WS_VT + (((size_t)(b * 8 + h) * 64 + d) * RPB + lc * 8) * 2; inc[j] = 128u; dsto[j] = (unsigned)(OFF_V + v * 1024); }
    }
#define AT_ISSUE(t, slot) do { _Pragma("unroll") for (int j = 0; j < 3; ++j) { \
        const unsigned so = (dsto[j] >= (unsigned)OFF_V) ? (unsigned)(slot) * VSLOT : (unsigned)(slot) * KSLOT; \
        __builtin_amdgcn_global_load_lds((const unsigned*)(src[j] + (size_t)(t) * inc[j]), (LAS unsigned*)(lds + dsto[j] + so), 16, 0, 0); } } while (0)
    const bf16_t* Qp = Q + (rowb + qrow0 + wid * 32 + r32) * 768 + h * 96 + hi * 8;
    bf16x8 qr[6];
#pragma unroll
    for (int d0 = 0; d0 < 6; ++d0) qr[d0] = *(const bf16x8*)(Qp + d0 * 16);
    f32x16 o0, o1;
#pragma unroll
    for (int r = 0; r < 16; ++r) { o0[r] = 0.f; o1[r] = 0.f; }
    float m_run = -1e30f, l_run = 0.f;
    LAS float* wsf = (LAS float*)(lds + OFF_WS + wid * 256);
    AT_ISSUE(0, 0);
    for (int t = 0; t < nkt; ++t) {
        const int sl = t & 1;
        if (t + 1 < nkt) { AT_ISSUE(t + 1, sl ^ 1); asm volatile("s_waitcnt vmcnt(3)" ::: "memory"); } else { asm volatile("s_waitcnt vmcnt(0)" ::: "memory"); }
        __builtin_amdgcn_s_barrier(); asm volatile("" ::: "memory");
        f32x16 p0, p1;
#pragma unroll
        for (int r = 0; r < 16; ++r) { p0[r] = 0.f; p1[r] = 0.f; }
        const LAS unsigned char* ks = lds + sl * KSLOT + hi * 1024 + r32 * 16;
#pragma unroll
        for (int d0 = 0; d0 < 6; ++d0) {
            const bf16x8 k0 = *(const LAS bf16x8*)(ks + d0 * 2048), k1 = *(const LAS bf16x8*)(ks + d0 * 2048 + 512);
            p0 = __builtin_amdgcn_mfma_f32_32x32x16_bf16(k0, qr[d0], p0, 0, 0, 0);
            p1 = __builtin_amdgcn_mfma_f32_32x32x16_bf16(k1, qr[d0], p1, 0, 0, 0);
        }
        float rm = fmaxf(p0[0], p1[0]);
#pragma unroll
        for (int r = 1; r < 16; ++r) rm = fmaxf(rm, fmaxf(p0[r], p1[r]));
        rm = fmaxf(rm, __shfl_xor(rm, 32));
        if (__any(rm > m_run)) {
            const float m_new = fmaxf(m_run, rm), alpha = __builtin_amdgcn_exp2f(m_run - m_new);
            m_run = m_new; l_run *= alpha;
            if (hi == 0) wsf[r32] = alpha;
            asm volatile("s_waitcnt lgkmcnt(0)" ::: "memory");
#pragma unroll
            for (int r = 0; r < 16; ++r) { const float a = wsf[crow(r, hi)]; o0[r] *= a; o1[r] *= a; }
            asm volatile("s_waitcnt lgkmcnt(0)" ::: "memory");
        }
        float sacc = 0.f;
#pragma unroll
        for (int r = 0; r < 16; ++r) { p0[r] = __builtin_amdgcn_exp2f(p0[r] - m_run); p1[r] = __builtin_amdgcn_exp2f(p1[r] - m_run); sacc += p0[r] + p1[r]; }
        l_run += sacc;
        u32x4 pw[4];
#pragma unroll
        for (int k = 0; k < 4; ++k) { const f32x16& P = (k < 2) ? p0 : p1; const int b0 = (k & 1) * 8;
            pw[k].x = cvt_pk_bf16(P[b0], P[b0 + 1]); pw[k].y = cvt_pk_bf16(P[b0 + 2], P[b0 + 3]); pw[k].z = cvt_pk_bf16(P[b0 + 4], P[b0 + 5]); pw[k].w = cvt_pk_bf16(P[b0 + 6], P[b0 + 7]); }
#pragma unroll
        for (int d0 = 0; d0 < 2; ++d0) {
            const int d = 32 * d0 + r32, swz = (d >> 1) & 7;
            const LAS unsigned char* vrow = lds + OFF_V + sl * VSLOT + d * 128 + 8 * hi;
#pragma unroll
            for (int k = 0; k < 4; ++k) {
                const u32x2 lo = *(const LAS u32x2*)(vrow + (((2 * k) ^ swz) * 16)), hh = *(const LAS u32x2*)(vrow + (((2 * k + 1) ^ swz) * 16));
                const u32x4 vw = (u32x4){lo.x, lo.y, hh.x, hh.y};
                if (d0 == 0) o0 = __builtin_amdgcn_mfma_f32_32x32x16_bf16(__builtin_bit_cast(bf16x8, pw[k]), __builtin_bit_cast(bf16x8, vw), o0, 0, 0, 0);
                else         o1 = __builtin_amdgcn_mfma_f32_32x32x16_bf16(__builtin_bit_cast(bf16x8, pw[k]), __builtin_bit_cast(bf16x8, vw), o1, 0, 0, 0);
            }
        }
        asm volatile("s_waitcnt lgkmcnt(0)" ::: "memory");
        __builtin_amdgcn_s_barrier(); asm volatile("" ::: "memory");
    }
    const float l_tot = l_run + __shfl_xor(l_run, 32);
    if (hi == 0) wsf[32 + r32] = 1.0f / l_tot;
    asm volatile("s_waitcnt lgkmcnt(0)" ::: "memory");
    LAS bf16_t* stg = (LAS bf16_t*)(lds + OFF_OST + wid * 4096);
#pragma unroll
    for (int r = 0; r < 16; ++r) { const int q = crow(r, hi); const float rl = wsf[32 + q];
        stg[q * 64 + r32] = f2bf(o0[r] * rl); stg[q * 64 + 32 + r32] = f2bf(o1[r] * rl); }
    asm volatile("s_waitcnt lgkmcnt(0)" ::: "memory");
    bf16_t* Ow = O + (rowb + qrow0 + wid * 32) * 512 + h * 64;
#pragma unroll
    for (int i = 0; i < 4; ++i) { const int row = i * 8 + (lane >> 3), ch = lane & 7; const u32x4 v = *(const LAS u32x4*)(stg + row * 64 + ch * 8); *(u32x4*)(Ow + (size_t)row * 512 + ch * 8) = v; }
    asm volatile("s_waitcnt lgkmcnt(0)" ::: "memory");
#undef AT_ISSUE
}

__device__ __forceinline__ void attn_phase(char* ws, LAS unsigned char* lds, int l, int G, int c) {
    for (int i = 0; ; ++i) {
        int bh, qb;
        if (G == 256) { if (i >= 4) break; const int x = c & 7, s = c >> 3; bh = 16 * i + 2 * x + (s >> 4); qb = s & 15; }
        else { const int L = i * G + c; if (L >= 1024) break; bh = L >> 4; qb = L & 15; }
        attn_unit(ws, lds, bh >> 3, bh & 7, CTX + qb * 256, NCHUNK);
    }
    if (l < DEPTH - 1) for (int u = c; u < 64; u += G) attn_unit(ws, lds, u >> 3, u & 7, 0, 4);
}
}
namespace gla {
constexpr int LD = 72;
constexpr int O_LF = 0, O_UG = 32768, O_WGT = 40960, O_B = 49152, O_KST = 49664, O_QG = 49664, O_KG = 58880, O_VTL = 68096, O_STL = 86528, O_AM = 104960, O_EGM = 114176, OF_LD = 132;
typedef float LAS* lfp; typedef bf16_t LAS* lbp;

__device__ __forceinline__ void gates(const PTab& p, int l, int b, int h, int blk, LAS unsigned char* lds) {
    const int tid = ltid(); const char* ws = p.ws();
    lfp LF = (lfp)(lds + O_LF); lfp UG = (lfp)(lds + O_UG); lfp WGT = (lfp)(lds + O_WGT); lfp BS = (lfp)(lds + O_B);
    const size_t row0 = (size_t)b * RPB + blk * 64;
    if (tid < 256) { const int s = tid >> 2, q = tid & 3, dir = q >> 1, r0 = (q & 1) * 8; float f[8];
        unpack8(*(const u32x4*)((const bf16_t*)(ws + WS_UKV) + (row0 + s) * 256 + 160 + q * 8), f);
#pragma unroll
        for (int j = 0; j < 8; ++j) UG[(dir * 64 + s) * 16 + r0 + j] = f[j]; }
    { const float* wgf = p.w_gf(); const float* wgb = p.w_gb(); const float* bgf = p.b_gf(); const float* bgb = p.b_gb();
      for (int i = tid; i < 2048; i += 512) { const int dir = i >> 10, r = (i >> 6) & 15, d = i & 63; WGT[i] = (dir ? wgb : wgf)[((size_t)l * 16 + r) * 256 + h * 64 + d]; }
      if (tid < 128) { const int dir = tid >> 6, d = tid & 63; BS[tid] = (dir ? bgb : bgf)[l * 256 + h * 64 + d]; } }
    __syncthreads();
    { const int d = tid & 63, sg = tid >> 6;
#pragma unroll
      for (int dir = 0; dir < 2; ++dir) {
          float w[16];
#pragma unroll
          for (int r = 0; r < 16; ++r) w[r] = WGT[(dir * 16 + r) * 64 + d];
          const float bias = BS[dir * 64 + d];
          for (int s = sg * 8; s < sg * 8 + 8; ++s) { float z = bias;
#pragma unroll
              for (int r = 0; r < 16; ++r) z += UG[(dir * 64 + s) * 16 + r] * w[r];
              const float ls = fminf(z, 0.f) - log1pf(expf(-fabsf(z)));
              LF[(dir * 64 + s) * 64 + d] = ls * (1.0f / 16.0f); } } }
    __syncthreads();
    if (tid < 128) { const int dir = tid >> 6, d = tid & 63; float run = 0.f;
        if (dir == 0) { for (int s = 0; s < 64; ++s) { run += LF[s * 64 + d]; LF[s * 64 + d] = run; } }
        else { for (int s = 63; s >= 0; --s) { run += LF[(64 + s) * 64 + d]; LF[(64 + s) * 64 + d] = run; } } }
    __syncthreads();
}
__device__ __forceinline__ void load_vt(const char* ws, int h, size_t row0, LAS unsigned char* lds) {
    const int tid = ltid(), s = tid >> 3, eg = tid & 7; lbp VTL = (lbp)(lds + O_VTL);
    const bf16_t* vp = (const bf16_t*)(ws + WS_GV) + (row0 + s) * 512 + h * 128 + eg * 16;
    const u32x4 a = *(const u32x4*)vp, c = *(const u32x4*)(vp + 8);
    const unsigned w[8] = {a.x, a.y, a.z, a.w, c.x, c.y, c.z, c.w};
#pragma unroll
    for (int j = 0; j < 8; ++j) { VTL[(eg * 16 + 2 * j) * LD + s] = (bf16_t)(w[j] & 0xffffu); VTL[(eg * 16 + 2 * j + 1) * LD + s] = (bf16_t)(w[j] >> 16); }
}

__device__ __forceinline__ void g1_item(const PTab& p, int l, int b, int h, int blk, LAS unsigned char* lds) {
    const int tid = ltid(), lane = tid & 63, wid = tid >> 6, fr = lane & 15, fq = lane >> 4; char* ws = p.ws();
    gates(p, l, b, h, blk, lds);
    lfp LF = (lfp)(lds + O_LF); lbp KST = (lbp)(lds + O_KST); lbp VTL = (lbp)(lds + O_VTL);
    const size_t row0 = (size_t)b * RPB + blk * 64;
    { const int s = tid >> 3, dg = tid & 7; float kf[8];
      unpack8(*(const u32x4*)((const bf16_t*)(ws + WS_GK) + (row0 + s) * 256 + h * 64 + dg * 8), kf);
#pragma unroll
      for (int dir = 0; dir < 2; ++dir) { const int sl = dir ? 0 : 63;
#pragma unroll
          for (int j = 0; j < 8; ++j) { const int d = dg * 8 + j; const float e = __expf(LF[(dir * 64 + sl) * 64 + d] - LF[(dir * 64 + s) * 64 + d]);
              KST[(dir * 64 + d) * LD + s] = f2bf(kf[j] * e); } } }
    load_vt(ws, h, row0, lds);
    const size_t item = ((size_t)(b * 4 + h) * 2) * NCHUNK;
    if (tid < 128) { const int dir = tid >> 6, d = tid & 63; ((float*)(ws + WS_DEC))[(item + dir * NCHUNK + blk) * 64 + d] = __expf(LF[(dir * 64 + (dir ? 0 : 63)) * 64 + d]); }
    __syncthreads();
#pragma unroll
    for (int dir = 0; dir < 2; ++dir) {
        bf16_t* kv = (bf16_t*)(ws + WS_KVS) + (item + dir * NCHUNK + blk) * 8192;
#pragma unroll
        for (int db = 0; db < 4; ++db) { f32x4 acc = {0.f, 0.f, 0.f, 0.f};
#pragma unroll
            for (int ks = 0; ks < 2; ++ks) { const bf16x8 a = *(const LAS bf16x8*)(KST + (dir * 64 + db * 16 + fr) * LD + ks * 32 + 8 * fq), bb = *(const LAS bf16x8*)(VTL + (wid * 16 + fr) * LD + ks * 32 + 8 * fq);
                acc = __builtin_amdgcn_mfma_f32_16x16x32_bf16(a, bb, acc, 0, 0, 0); }
            u32x2 w; w.x = cvt_pk_bf16(acc[0], acc[1]); w.y = cvt_pk_bf16(acc[2], acc[3]);
            *(u32x2*)(kv + (wid * 16 + fr) * 64 + db * 16 + 4 * fq) = w; } }
    __syncthreads();
}

__device__ __forceinline__ void g2_item(char* ws, int ch, int sl) {
    const int tid = ltid(), e = sl * 32 + (tid >> 4), d4 = (tid & 15) * 4, dir = ch & 1;
    bf16_t* KV = (bf16_t*)(ws + WS_KVS) + (size_t)ch * NCHUNK * 8192 + e * 64 + d4; const float* DEC = (const float*)(ws + WS_DEC) + (size_t)ch * NCHUNK * 64 + d4;
    f32x4 S = {0.f, 0.f, 0.f, 0.f};
#pragma unroll 4
    for (int cp = 0; cp < NCHUNK; ++cp) { const int blk = dir ? (cp < 4 ? 3 - cp : 71 - cp) : cp;
        u32x2* ptr = (u32x2*)(KV + (size_t)blk * 8192); const u32x2 kvw = *ptr; const f32x4 dec = *(const f32x4*)(DEC + blk * 64);
        u32x2 sw; sw.x = cvt_pk_bf16(S[0], S[1]); sw.y = cvt_pk_bf16(S[2], S[3]); *ptr = sw;
        S[0] = dec[0] * S[0] + bflo(kvw.x); S[1] = dec[1] * S[1] + bfhi(kvw.x); S[2] = dec[2] * S[2] + bflo(kvw.y); S[3] = dec[3] * S[3] + bfhi(kvw.y); }
}

__device__ __forceinline__ void g3_item(const PTab& p, int l, int b, int h, int blk, LAS unsigned char* lds) {
    const int tid = ltid(), lane = tid & 63, wid = tid >> 6, fr = lane & 15, fq = lane >> 4; char* ws = p.ws();
    gates(p, l, b, h, blk, lds);
    lfp LF = (lfp)(lds + O_LF); lbp QG = (lbp)(lds + O_QG); lbp KG = (lbp)(lds + O_KG); lbp VTL = (lbp)(lds + O_VTL); lbp STL = (lbp)(lds + O_STL); lbp AM = (lbp)(lds + O_AM); lfp EGM = (lfp)(lds + O_EGM);
    const size_t row0 = (size_t)b * RPB + blk * 64; const size_t item = ((size_t)(b * 4 + h) * 2) * NCHUNK;
    load_vt(ws, h, row0, lds);
    f32x4 acc[4];
#pragma unroll
    for (int i = 0; i < 4; ++i) acc[i] = (f32x4){0.f, 0.f, 0.f, 0.f};
#pragma unroll 1
    for (int dir = 0; dir < 2; ++dir) {
        if (tid < 64) EGM[tid] = __expf(LF[(dir * 64 + 32) * 64 + tid]);
        { const int s = tid >> 3, dg = tid & 7; float qf[8], kf[8], qo[8], ko[8];
          unpack8(*(const u32x4*)((const bf16_t*)(ws + WS_GQ) + (row0 + s) * 256 + h * 64 + dg * 8), qf);
          unpack8(*(const u32x4*)((const bf16_t*)(ws + WS_GK) + (row0 + s) * 256 + h * 64 + dg * 8), kf);
#pragma unroll
          for (int j = 0; j < 8; ++j) { const int d = dg * 8 + j; const float dl = LF[(dir * 64 + s) * 64 + d] - LF[(dir * 64 + 32) * 64 + d]; qo[j] = qf[j] * __expf(dl); ko[j] = kf[j] * __expf(-dl); }
          u32x4 w; w.x = cvt_pk_bf16(qo[0], qo[1]); w.y = cvt_pk_bf16(qo[2], qo[3]); w.z = cvt_pk_bf16(qo[4], qo[5]); w.w = cvt_pk_bf16(qo[6], qo[7]); *(LAS u32x4*)(QG + s * LD + dg * 8) = w;
          w.x = cvt_pk_bf16(ko[0], ko[1]); w.y = cvt_pk_bf16(ko[2], ko[3]); w.z = cvt_pk_bf16(ko[4], ko[5]); w.w = cvt_pk_bf16(ko[6], ko[7]); *(LAS u32x4*)(KG + s * LD + dg * 8) = w; }
        __syncthreads();
        { const int e = tid >> 2, dq = tid & 3; const bf16_t* sp = (const bf16_t*)(ws + WS_KVS) + (item + dir * NCHUNK + blk) * 8192 + e * 64 + dq * 16;
#pragma unroll
          for (int hh = 0; hh < 2; ++hh) { float f[8]; unpack8(*(const u32x4*)(sp + hh * 8), f);
#pragma unroll
              for (int j = 0; j < 8; ++j) f[j] *= EGM[dq * 16 + hh * 8 + j];
              u32x4 w; w.x = cvt_pk_bf16(f[0], f[1]); w.y = cvt_pk_bf16(f[2], f[3]); w.z = cvt_pk_bf16(f[4], f[5]); w.w = cvt_pk_bf16(f[6], f[7]); *(LAS u32x4*)(STL + e * LD + dq * 16 + hh * 8) = w; } }
        __syncthreads();
        { const int tb = wid >> 1;
#pragma unroll
          for (int q = 0; q < 2; ++q) { const int sb = (wid & 1) * 2 + q; f32x4 a4 = {0.f, 0.f, 0.f, 0.f};
              const bool live = dir ? (sb >= tb) : (sb <= tb);
              if (live) {
#pragma unroll
                  for (int ks = 0; ks < 2; ++ks) { const bf16x8 a = *(const LAS bf16x8*)(KG + (sb * 16 + fr) * LD + ks * 32 + 8 * fq), bb = *(const LAS bf16x8*)(QG + (tb * 16 + fr) * LD + ks * 32 + 8 * fq);
                      a4 = __builtin_amdgcn_mfma_f32_16x16x32_bf16(a, bb, a4, 0, 0, 0); } }
              const int t = tb * 16 + fr, s0 = sb * 16 + 4 * fq;
#pragma unroll
              for (int j = 0; j < 4; ++j) { const int s = s0 + j; const bool keep = dir ? (s >= t) : (s <= t); if (!keep) a4[j] = 0.f; }
              u32x2 w; w.x = cvt_pk_bf16(a4[0], a4[1]); w.y = cvt_pk_bf16(a4[2], a4[3]); *(LAS u32x2*)(AM + t * LD + s0) = w; } }
        __syncthreads();
#pragma unroll
        for (int tb = 0; tb < 4; ++tb) {
#pragma unroll
            for (int ks = 0; ks < 2; ++ks) { const bf16x8 a = *(const LAS bf16x8*)(VTL + (wid * 16 + fr) * LD + ks * 32 + 8 * fq), bb = *(const LAS bf16x8*)(AM + (tb * 16 + fr) * LD + ks * 32 + 8 * fq);
                acc[tb] = __builtin_amdgcn_mfma_f32_16x16x32_bf16(a, bb, acc[tb], 0, 0, 0); }
#pragma unroll
            for (int ks = 0; ks < 2; ++ks) { const bf16x8 a = *(const LAS bf16x8*)(STL + (wid * 16 + fr) * LD + ks * 32 + 8 * fq), bb = *(const LAS bf16x8*)(QG + (tb * 16 + fr) * LD + ks * 32 + 8 * fq);
                acc[tb] = __builtin_amdgcn_mfma_f32_16x16x32_bf16(a, bb, acc[tb], 0, 0, 0); } }
        __syncthreads();
    }
    lfp OF = (lfp)(lds + O_LF);
#pragma unroll
    for (int tb = 0; tb < 4; ++tb) *(LAS f32x4*)(OF + (tb * 16 + fr) * OF_LD + wid * 16 + 4 * fq) = acc[tb];
    __syncthreads();
    { const int t = tid >> 3, part = tid & 7; float o[16]; float ss = 0.f;
#pragma unroll
      for (int j = 0; j < 4; ++j) { const f32x4 v = *(const LAS f32x4*)(OF + t * OF_LD + part * 16 + j * 4); o[4 * j] = v[0]; o[4 * j + 1] = v[1]; o[4 * j + 2] = v[2]; o[4 * j + 3] = v[3]; ss += v[0] * v[0] + v[1] * v[1] + v[2] * v[2] + v[3] * v[3]; }
      ss += __shfl_xor(ss, 1); ss += __shfl_xor(ss, 2); ss += __shfl_xor(ss, 4);
      const float rs = rsqrtf(ss * (1.0f / 128.0f) + EPS);
      const float* ng = p.gla_norm_g() + l * 512 + h * 128 + part * 16; const bf16_t* og = (const bf16_t*)(ws + WS_GOG) + (row0 + t) * 512 + h * 128 + part * 16;
      bf16_t* dst = (bf16_t*)(ws + WS_OGLA) + (row0 + t) * 512 + h * 128 + part * 16;
#pragma unroll
      for (int hh = 0; hh < 2; ++hh) { float g[8]; unpack8(*(const u32x4*)(og + hh * 8), g); float r[8];
#pragma unroll
          for (int j = 0; j < 8; ++j) r[j] = o[hh * 8 + j] * rs * ng[hh * 8 + j] * siluf_(g[j]);
          u32x4 w; w.x = cvt_pk_bf16(r[0], r[1]); w.y = cvt_pk_bf16(r[2], r[3]); w.z = cvt_pk_bf16(r[4], r[5]); w.w = cvt_pk_bf16(r[6], r[7]); *(u32x4*)(dst + hh * 8) = w; } }
    __syncthreads();
}
}
namespace moe {
constexpr int A_LG = LDS_AUX, A_HIST = LDS_AUX + 1024, A_BASE = LDS_AUX + 1152, A_TB = LDS_AUX + 1280, A_CN = LDS_AUX + 1536, A_RANK = LDS_AUX + 2048;
__device__ __forceinline__ int n_act_rows(int l) { return (l < DEPTH - 1) ? T : NB * SEQ; }
__device__ __forceinline__ int act_row(int l, int r) { return (l < DEPTH - 1) ? r : (r >> 12) * RPB + CTX + (r & 4095); }

__device__ __forceinline__ void tables(char* ws, int l, LAS unsigned char* lds) {
    LAS int* tb = (LAS int*)(lds + A_TB); LAS int* cn = (LAS int*)(lds + A_CN);
    if (ltid() == 0) { unsigned* cnt = (unsigned*)(ws + WS_CTL + CTL_CNT) + l * 32; int run = 0;
        for (int e = 0; e < NE; ++e) { const int n = (int)__hip_atomic_load(cnt + e, __ATOMIC_RELAXED, __HIP_MEMORY_SCOPE_AGENT); tb[e] = run; cn[e] = n; run += (n + 255) >> 8; }
        tb[NE] = run; }
    __syncthreads();
}

__device__ __forceinline__ void route_phase(const PTab& p, int l, LAS unsigned char* lds, int G, int c) {
    const int tid = ltid(), lane = tid & 63, wid = tid >> 6; char* ws = p.ws();
    LAS float* RW = (LAS float*)lds;
    LAS float* LG = (LAS float*)(lds + A_LG) + wid * 32; LAS int* hist = (LAS int*)(lds + A_HIST); LAS int* base = (LAS int*)(lds + A_BASE); LAS int* rank = (LAS int*)(lds + A_RANK);
    { const float* rw = p.router_w() + (size_t)l * 1024 * 32;
      for (int i = tid; i < 32768; i += 512) { const int k = i >> 5, e = i & 31; RW[e * 1024 + k] = rw[i]; } }
    if (tid < 32) hist[tid] = 0;
    __syncthreads();
    const int nact = n_act_rows(l), chunk = (nact + G - 1) / G, r0 = c * chunk, r1 = (r0 + chunk < nact) ? r0 + chunk : nact;
    const float* X = (const float*)(ws + WS_X); bf16_t* H = (bf16_t*)(ws + WS_H);
    const float* M = (const float*)(ws + WS_MOD) + (size_t)l * 9 * 6144; const float* g2n = p.norm2_g() + l * D; const float* rb = p.router_b() + l * 32;
    for (int r = r0 + wid; r < r1; r += 8) {
        const int row = act_row(l, r), b = row / RPB, s = (row % RPB) < CTX ? 8 : b;
        const float* xrow = X + (size_t)row * D; const float* sh = M + s * 6144 + 3072; const float* sc = M + s * 6144 + 4096;
        f32x4 hv[4]; float ss = 0.f;
#pragma unroll
        for (int i = 0; i < 4; ++i) { hv[i] = *(const f32x4*)(xrow + i * 256 + lane * 4); ss += hv[i][0] * hv[i][0] + hv[i][1] * hv[i][1] + hv[i][2] * hv[i][2] + hv[i][3] * hv[i][3]; }
#pragma unroll
        for (int o = 32; o >= 1; o >>= 1) ss += __shfl_xor(ss, o);
        const float rs = rsqrtf(ss * (1.0f / 1024.0f) + EPS);
#pragma unroll
        for (int i = 0; i < 4; ++i) { const int col = i * 256 + lane * 4; const f32x4 gg = *(const f32x4*)(g2n + col), sv = *(const f32x4*)(sh + col), cv = *(const f32x4*)(sc + col);
#pragma unroll
            for (int j = 0; j < 4; ++j) hv[i][j] = hv[i][j] * rs * gg[j] * (1.0f + cv[j]) + sv[j];
            u32x2 w; w.x = cvt_pk_bf16(hv[i][0], hv[i][1]); w.y = cvt_pk_bf16(hv[i][2], hv[i][3]); *(u32x2*)(H + (size_t)row * D + col) = w; }
        float a[32];
#pragma unroll
        for (int e = 0; e < 32; ++e) { float t = 0.f;
#pragma unroll
            for (int i = 0; i < 4; ++i) { const f32x4 w = *(const LAS f32x4*)(RW + e * 1024 + i * 256 + lane * 4); t += hv[i][0] * w[0] + hv[i][1] * w[1] + hv[i][2] * w[2] + hv[i][3] * w[3]; }
            a[e] = t; }
        { const bool b5 = lane & 32;
#pragma unroll
          for (int i = 0; i < 16; ++i) { const float keep = b5 ? a[i + 16] : a[i], send = b5 ? a[i] : a[i + 16]; a[i] = keep + __shfl_xor(send, 32); }
          const bool b4 = lane & 16;
#pragma unroll
          for (int i = 0; i < 8; ++i) { const float keep = b4 ? a[i + 8] : a[i], send = b4 ? a[i] : a[i + 8]; a[i] = keep + __shfl_xor(send, 16); }
          const bool b3 = lane & 8;
#pragma unroll
          for (int i = 0; i < 4; ++i) { const float keep = b3 ? a[i + 4] : a[i], send = b3 ? a[i] : a[i + 4]; a[i] = keep + __shfl_xor(send, 8); }
          const bool b2 = lane & 4;
#pragma unroll
          for (int i = 0; i < 2; ++i) { const float keep = b2 ? a[i + 2] : a[i], send = b2 ? a[i] : a[i + 2]; a[i] = keep + __shfl_xor(send, 4); }
          const bool b1 = lane & 2;
          { const float keep = b1 ? a[1] : a[0], send = b1 ? a[0] : a[1]; a[0] = keep + __shfl_xor(send, 2); }
          a[0] += __shfl_xor(a[0], 1); }
        { const int e = ((lane >> 5) & 1) * 16 + ((lane >> 4) & 1) * 8 + ((lane >> 3) & 1) * 4 + ((lane >> 2) & 1) * 2 + ((lane >> 1) & 1);
          if ((lane & 1) == 0) LG[e] = a[0] + rb[e]; }
        asm volatile("s_waitcnt lgkmcnt(0)" ::: "memory");
        float v[32];
#pragma unroll
        for (int q = 0; q < 8; ++q) { const f32x4 t = *(const LAS f32x4*)(LG + q * 4); v[4 * q] = t[0]; v[4 * q + 1] = t[1]; v[4 * q + 2] = t[2]; v[4 * q + 3] = t[3]; }
        asm volatile("s_waitcnt lgkmcnt(0)" ::: "memory");
        float tv[4]; int ti[4];
#pragma unroll
        for (int k = 0; k < 4; ++k) { float best = v[0]; int bi = 0;
#pragma unroll
            for (int e = 1; e < 32; ++e) { if (v[e] > best) { best = v[e]; bi = e; } }
            tv[k] = best; ti[k] = bi;
#pragma unroll
            for (int e = 0; e < 32; ++e) v[e] = (e == bi) ? -INFINITY : v[e]; }
        const float e1 = __expf(tv[1] - tv[0]), e2 = __expf(tv[2] - tv[0]), e3 = __expf(tv[3] - tv[0]), inv = 1.0f / (1.0f + e1 + e2 + e3);
        if (lane < 4) { const int ek = lane == 0 ? ti[0] : lane == 1 ? ti[1] : lane == 2 ? ti[2] : ti[3]; const float gk = (lane == 0 ? 1.0f : lane == 1 ? e1 : lane == 2 ? e2 : e3) * inv;
            ((int*)(ws + WS_TOPI))[(size_t)row * 4 + lane] = ek; ((float*)(ws + WS_TOPG))[(size_t)row * 4 + lane] = gk;
            const int rk = atomicAdd((int*)(hist + ek), 1);
            rank[(r - r0) * 4 + lane] = rk | (ek << 24); }
    }
    __syncthreads();
    if (tid < 32) base[tid] = (int)__hip_atomic_fetch_add((unsigned*)(ws + WS_CTL + CTL_CNT) + l * 32 + tid, (unsigned)hist[tid], __ATOMIC_RELAXED, __HIP_MEMORY_SCOPE_AGENT);
    __syncthreads();
    for (int i = tid; i < (r1 - r0) * 4; i += 512) { const int v = rank[i], e = v >> 24, rk = v & 0xffffff; ((int*)(ws + WS_TOPP))[(size_t)act_row(l, r0 + (i >> 2)) * 4 + (i & 3)] = base[e] + rk; }
    __syncthreads();
}

__device__ __forceinline__ void permute_phase(const PTab& p, int l, LAS unsigned char* lds, int G, int c) {
    const int tid_ = ltid(), lane = tid_ & 63, wid = tid_ >> 6; char* ws = p.ws();
    tables(ws, l, lds);
    const LAS int* tb = (const LAS int*)(lds + A_TB); const LAS int* cn = (const LAS int*)(lds + A_CN);
    const bf16_t* H = (const bf16_t*)(ws + WS_H); bf16_t* HS = (bf16_t*)(ws + WS_HS);
    const int nact = n_act_rows(l);
    for (int r = c * 8 + wid; r < nact; r += G * 8) { const int row = act_row(l, r);
        const u32x4 a = *(const u32x4*)(H + (size_t)row * D + lane * 16), b = *(const u32x4*)(H + (size_t)row * D + lane * 16 + 8);
        const int* ti = (const int*)(ws + WS_TOPI) + (size_t)row * 4; const int* tp = (const int*)(ws + WS_TOPP) + (size_t)row * 4;
#pragma unroll
        for (int k = 0; k < 4; ++k) { const int e = ti[k], pos = tp[k]; bf16_t* d = HS + ((size_t)tb[e] * 256 + pos) * D + lane * 16; *(u32x4*)d = a; *(u32x4*)(d + 8) = b; } }
    for (int e = 0; e < NE; ++e) { const int n = cn[e], end = ((n + 255) >> 8) << 8;
        for (int pr = n + c * 8 + wid; pr < end; pr += G * 8) { bf16_t* d = HS + ((size_t)tb[e] * 256 + pr) * D + lane * 16; const u32x4 z = {0u, 0u, 0u, 0u}; *(u32x4*)d = z; *(u32x4*)(d + 8) = z; } }
}

__device__ __forceinline__ void combine_phase(const PTab& p, int l, LAS unsigned char* lds, int G, int c) {
    const int tid_ = ltid(), lane = tid_ & 63, wid = tid_ >> 6; char* ws = p.ws();
    tables(ws, l, lds);
    const LAS int* tb = (const LAS int*)(lds + A_TB);
    float* X = (float*)(ws + WS_X); bf16_t* H = (bf16_t*)(ws + WS_H); const bf16_t* YM = (const bf16_t*)(ws + WS_YM);
    const float* M = (const float*)(ws + WS_MOD) + (size_t)l * 9 * 6144; const float* Mn = M + 9 * 6144;
    const int nact = n_act_rows(l); const float* n1g = p.norm1_g(); const float* fing = p.final_g(); float* outp = p.out();
    for (int r = c * 8 + wid; r < nact; r += G * 8) { const int row = act_row(l, r), b = row / RPB, s = (row % RPB) < CTX ? 8 : b;
        const int* ti = (const int*)(ws + WS_TOPI) + (size_t)row * 4; const int* tp = (const int*)(ws + WS_TOPP) + (size_t)row * 4; const float* tg = (const float*)(ws + WS_TOPG) + (size_t)row * 4;
        f32x4 acc[4];
#pragma unroll
        for (int i = 0; i < 4; ++i) acc[i] = (f32x4){0.f, 0.f, 0.f, 0.f};
#pragma unroll
        for (int k = 0; k < 4; ++k) { const int e = ti[k], pos = tp[k]; const float gk = tg[k]; const bf16_t* y = YM + ((size_t)tb[e] * 256 + pos) * D + lane * 4;
#pragma unroll
            for (int i = 0; i < 4; ++i) { const u32x2 w = *(const u32x2*)(y + i * 256); acc[i][0] += gk * bflo(w.x); acc[i][1] += gk * bfhi(w.x); acc[i][2] += gk * bflo(w.y); acc[i][3] += gk * bfhi(w.y); } }
        float* xrow = X + (size_t)row * D; const float* g2 = M + s * 6144 + 5120; f32x4 xv[4]; float ss = 0.f;
#pragma unroll
        for (int i = 0; i < 4; ++i) { const int col = i * 256 + lane * 4; xv[i] = *(const f32x4*)(xrow + col) + *(const f32x4*)(g2 + col) * acc[i]; *(f32x4*)(xrow + col) = xv[i];
            ss += xv[i][0] * xv[i][0] + xv[i][1] * xv[i][1] + xv[i][2] * xv[i][2] + xv[i][3] * xv[i][3]; }
#pragma unroll
        for (int o = 32; o >= 1; o >>= 1) ss += __shfl_xor(ss, o);
        const float rs = rsqrtf(ss * (1.0f / 1024.0f) + EPS);
        if (l < DEPTH - 1) { const float* gn = n1g + (l + 1) * D; const float* sh = Mn + s * 6144; const float* sc = Mn + s * 6144 + 1024;
#pragma unroll
            for (int i = 0; i < 4; ++i) { const int col = i * 256 + lane * 4; const f32x4 gg = *(const f32x4*)(gn + col), sv = *(const f32x4*)(sh + col), cv = *(const f32x4*)(sc + col); float o[4];
#pragma unroll
                for (int j = 0; j < 4; ++j) o[j] = xv[i][j] * rs * gg[j] * (1.0f + cv[j]) + sv[j];
                u32x2 w; w.x = cvt_pk_bf16(o[0], o[1]); w.y = cvt_pk_bf16(o[2], o[3]); *(u32x2*)(H + (size_t)row * D + col) = w; } }
        else { float* orow = outp + (size_t)r * D;
#pragma unroll
            for (int i = 0; i < 4; ++i) { const int col = i * 256 + lane * 4; const f32x4 gg = *(const f32x4*)(fing + col); *(f32x4*)(orow + col) = xv[i] * rs * gg; } }
    }
}
__device__ __forceinline__ void krope_job(char* ws, int G, int c) {
    const bf16_t* U = (const bf16_t*)(ws + WS_UKV); bf16_t* KR = (bf16_t*)(ws + WS_KR); const f32x2* rope = (const f32x2*)(ws + WS_ROPE);
    for (int i = c * 512 + ltid(); i < T * 16; i += G * 512) { const int row = i >> 4, pr = i & 15, axis = pr >> 3, f = pr & 7, tl = (row % RPB) - CTX;
        const float x1 = bf2f(U[(size_t)row * 256 + 128 + axis * 16 + f]), x2 = bf2f(U[(size_t)row * 256 + 128 + axis * 16 + 8 + f]); float o1 = x1, o2 = x2;
        if (tl >= 0) { const int pos = axis ? (tl & 63) : (tl >> 6); const f32x2 cs = rope[pos * 8 + f]; o1 = x1 * cs.x - x2 * cs.y; o2 = x2 * cs.x + x1 * cs.y; }
        *(unsigned*)(KR + (size_t)row * 32 + axis * 16 + 2 * f) = cvt_pk_bf16(o1, o2); }
}
}
constexpr int N_PHASES = 2 + 11 * DEPTH;
#ifndef MK_PER_PHASE
#define MK_PER_PHASE 0
#endif

__global__ void __launch_bounds__(512, 2) mega(Params p, int ph_lo, int ph_hi) {
    extern __shared__ __attribute__((aligned(16))) unsigned char smem_raw[];
    LAS unsigned char* lds = (LAS unsigned char*)smem_raw;
    const int G0 = (int)gridDim.x, c0 = (int)blockIdx.x;
    volatile LAS unsigned* st = (volatile LAS unsigned*)(lds + LDS_BYTES - 16);
    if (threadIdx.x == 0) { st[0] = 0u; st[1] = 0u; st[2] = 0u; st[3] = 0u;
        LAS unsigned long long* t = (LAS unsigned long long*)(lds + LDS_PTAB);
        t[0] = (unsigned long long)p.x; t[1] = (unsigned long long)p.c; t[2] = (unsigned long long)p.ctx; t[3] = (unsigned long long)p.c_ctx; t[4] = (unsigned long long)p.w_mod; t[5] = (unsigned long long)p.b_mod;
        t[6] = (unsigned long long)p.norm1_g; t[7] = (unsigned long long)p.w_in; t[8] = (unsigned long long)p.q_norm_g; t[9] = (unsigned long long)p.w_uq; t[10] = (unsigned long long)p.kv_norm_g; t[11] = (unsigned long long)p.w_ukv;
        t[12] = (unsigned long long)p.w_gf; t[13] = (unsigned long long)p.b_gf; t[14] = (unsigned long long)p.w_gb; t[15] = (unsigned long long)p.b_gb; t[16] = (unsigned long long)p.gla_norm_g; t[17] = (unsigned long long)p.w_br_mla;
        t[18] = (unsigned long long)p.w_br_fnet; t[19] = (unsigned long long)p.w_br_gla; t[20] = (unsigned long long)p.w_o; t[21] = (unsigned long long)p.norm2_g; t[22] = (unsigned long long)p.router_w; t[23] = (unsigned long long)p.router_b;
        t[24] = (unsigned long long)p.w_up; t[25] = (unsigned long long)p.b_up; t[26] = (unsigned long long)p.w_down; t[27] = (unsigned long long)p.b_down; t[28] = (unsigned long long)p.final_g; t[29] = (unsigned long long)p.out; t[30] = (unsigned long long)p.ws; }
    __syncthreads();
    const PTab pt{(const LAS unsigned long long*)(lds + LDS_PTAB)};
    XcdBarrier bar = xcd_barrier_post((unsigned*)(pt.ws() + WS_CTL), st);
#define WS_GET() const int G = lsgpr(G0), c = lsgpr(c0); char* ws = pt.ws(); const char* wl = ws + WS_W + (size_t)l * WL_BYTES; (void)wl
#ifndef PH_MASK
#define PH_MASK 0x1fff
#endif
#define PH_ON(n) (ph_lo <= (n) && (n) < ph_hi)
#define PHC(k) ((PH_MASK >> (k)) & 1)
#define PH_END(n) do { if ((n) + 1 < ph_hi) xcd_barrier(bar); } while (0)
    if (PHC(0) && PH_ON(0)) { prologue_phase(pt, lds, G0, c0); __syncthreads(); PH_END(0); }
    if (PHC(1) && PH_ON(1)) { norm1_phase(pt, 0, G0, c0); PH_END(1); }
    for (int l = 0; l < DEPTH; ++l) {
        const int pb = 2 + 11 * l;
        if (PHC(2) && PH_ON(pb + 0)) { WS_GET(); G1Sched S{ws + WS_H, wl + WL_WIN, G, c}; G1Epi E{ws}; gk::gemm_phase(lds, S, E); PH_END(pb + 0); }
        if (PHC(3) && PH_ON(pb + 1)) { WS_GET();
            { DftSched S{ws, l, G, c}; DftEpi E{ws}; gk::gemm_phase(lds, S, E); }
            { QSched S{ws, wl, G, (c + 32) % G}; QEpi E{ws}; gk::gemm_phase(lds, S, E); }
            { KnSched S{ws, wl, G, (c + 184) % G}; KnEpi E{ws}; gk::gemm_phase(lds, S, E); }
            { VtSched S{ws, wl, G, (c + 200) % G}; VtEpi E{ws}; gk::gemm_phase(lds, S, E); }
            moe::krope_job(ws, G, c);
            __syncthreads();
            for (int it = c; it < NB * 4 * NCHUNK; it += G) gla::g1_item(pt, l, it / (4 * NCHUNK), (it / NCHUNK) & 3, it % NCHUNK, lds);
            PH_END(pb + 1);
        }
        if (PHC(4) && PH_ON(pb + 2)) { WS_GET();
            for (int it = c; it < 256; it += G) gla::g2_item(ws, it >> 2, it & 3);
            at::attn_phase(ws, lds, l, G, c);
            PH_END(pb + 2);
        }
        if (PHC(5) && PH_ON(pb + 3)) { WS_GET();
            for (int it = c; it < NB * 4 * NCHUNK; it += G) { const int b = it / (4 * NCHUNK), h = (it / NCHUNK) & 3, blk = it % NCHUNK;
                if (l == DEPTH - 1 && blk < 4) continue;
                gla::g3_item(pt, l, b, h, blk, lds); }
            PH_END(pb + 3);
        }
        if (PHC(6) && PH_ON(pb + 4)) { WS_GET(); MergeSched S{ws, wl, l, G, c}; MergeEpi E{ws}; gk::gemm_phase(lds, S, E); PH_END(pb + 4); }
        if (PHC(7) && PH_ON(pb + 5)) { WS_GET(); WoSched S{ws, wl, l, G, c}; WoEpi E{ws, l}; gk::gemm_phase(lds, S, E); PH_END(pb + 5); }
        if (PHC(8) && PH_ON(pb + 6)) { WS_GET(); moe::route_phase(pt, l, lds, G, c); PH_END(pb + 6); }
        if (PHC(9) && PH_ON(pb + 7)) { WS_GET(); moe::permute_phase(pt, l, lds, G, c); PH_END(pb + 7); }
        if (PHC(10) && PH_ON(pb + 8)) { WS_GET(); moe::tables(ws, l, lds);
            MoeSched S{ws + WS_HS, wl + WL_WUP, (const LAS int*)(lds + moe::A_TB), 8, G, c, (size_t)2048 * 2048};
            UpEpi E{ws, pt.b_up() + (size_t)l * NE * 2048}; gk::gemm_phase(lds, S, E); PH_END(pb + 8); }
        if (PHC(11) && PH_ON(pb + 9)) { WS_GET(); moe::tables(ws, l, lds);
            MoeSched S{ws + WS_ACT, wl + WL_WDN, (const LAS int*)(lds + moe::A_TB), 4, G, c, (size_t)1024 * 2048};
            DownEpi E{ws, pt.b_down() + (size_t)l * NE * 1024}; gk::gemm_phase(lds, S, E); PH_END(pb + 9); }
        if (PHC(12) && PH_ON(pb + 10)) { WS_GET(); moe::combine_phase(pt, l, lds, G, c); PH_END(pb + 10); }
    }
#undef PH_ON
#undef PH_END
}

#ifdef DBG_STOP
struct DbgEnt { size_t off; size_t n; int f32; };
__global__ void dbg_dump(const char* ws, float* out, int n) {
    const DbgEnt L[] = { DBG_LIST };
    for (size_t i = (size_t)blockIdx.x * blockDim.x + threadIdx.x; i < (size_t)n; i += (size_t)gridDim.x * blockDim.x) {
        float s = 0.f;
        for (int k = 0; k < (int)(sizeof(L) / sizeof(L[0])); ++k) { const size_t j = i % L[k].n; const float v = L[k].f32 ? ((const float*)(ws + L[k].off))[j] : bf2f(((const bf16_t*)(ws + L[k].off))[j]); s += v; }
        out[i] = s;
    }
}
#endif
extern "C" void kernel_launch(void* const* d_in, const int* in_sizes, int n_in, void* d_out, int out_size, void* d_ws, size_t ws_size, hipStream_t stream) {
    static int grid = 0;
    if (!grid) {
        if (n_in != 29 || ws_size < WS_END) { fprintf(stderr, "kernel_launch: unexpected inputs (%d) or workspace (%zu < %zu)\n", n_in, ws_size, (size_t)WS_END); grid = -1; return; }
        int dev = 0, cus = 0, per_cu = 0;
        hipGetDevice(&dev); hipDeviceGetAttribute(&cus, hipDeviceAttributeMultiprocessorCount, dev);
        if (hipFuncSetAttribute((const void*)mega, hipFuncAttributeMaxDynamicSharedMemorySize, LDS_BYTES) != hipSuccess) { fprintf(stderr, "kernel_launch: hipFuncSetAttribute failed\n"); grid = -1; return; }
        hipOccupancyMaxActiveBlocksPerMultiprocessor(&per_cu, (const void*)mega, 512, LDS_BYTES);
        if (per_cu < 1 || cus < 1) { fprintf(stderr, "kernel_launch: kernel is not resident (occupancy %d, CUs %d)\n", per_cu, cus); grid = -1; return; }
        grid = cus;
    }
    if (grid < 0) return;
    hipMemsetAsync((char*)d_ws + WS_CTL, 0, CTL_BYTES, stream);
    Params p{};
    const float** f = (const float**)&p;
    for (int i = 0; i < 29; ++i) f[i] = (const float*)d_in[i];
    p.out = (float*)d_out; p.ws = (char*)d_ws;
#ifdef DBG_STOP
    for (int ph = 0; ph < DBG_STOP; ++ph) hipLaunchKernelGGL(mega, dim3(grid), dim3(512), LDS_BYTES, stream, p, ph, ph + 1);
    hipLaunchKernelGGL(dbg_dump, dim3(2048), dim3(256), 0, stream, (const char*)d_ws, (float*)d_out, out_size);
#elif MK_PER_PHASE
    for (int ph = 0; ph < N_PHASES; ++ph) hipLaunchKernelGGL(mega, dim3(grid), dim3(512), LDS_BYTES, stream, p, ph, ph + 1);
#else
    hipLaunchKernelGGL(mega, dim3(grid), dim3(512), LDS_BYTES, stream, p, 0, N_PHASES);
#endif
}
```

```cpp
#include <hip/hip_runtime.h>
#include <cstdio>
#include <cstdint>

#define LAS __attribute__((address_space(3)))
typedef unsigned short bf16_t;
typedef short bf16x8 __attribute__((ext_vector_type(8)));
typedef short s16x4 __attribute__((ext_vector_type(4)));
typedef float f32x2 __attribute__((ext_vector_type(2)));
typedef float f32x4 __attribute__((ext_vector_type(4)));
typedef float f32x16 __attribute__((ext_vector_type(16)));
typedef unsigned u32x2 __attribute__((ext_vector_type(2)));
typedef unsigned u32x4 __attribute__((ext_vector_type(4)));

constexpr int D = 1024, NB = 8, SEQ = 4096, CTX = 256, DEPTH = 4;
constexpr int RPB = CTX + SEQ;
constexpr int T = NB * RPB;
constexpr int NMT = T / 256;
constexpr int NE = 32, TOPK = 4;
constexpr int NPAD = 147456;
constexpr int INW = 5568;
constexpr int G1N = 5632;
constexpr float EPS = 1e-6f;
constexpr float QSCALE = 0.10206207261596575f * 1.4426950408889634f;
constexpr int NCHUNK = 68;

constexpr int CO_Q = 0, CO_KV = 256, CO_FN = 416, CO_GQ = 928, CO_GK = 1184, CO_GV = 1440, CO_OG = 1952, CO_GF = 2464, CO_GB = 2480, CO_GATE = 2496;

constexpr size_t al256(size_t x) { return (x + 255) & ~(size_t)255; }
constexpr size_t WS_CTL   = 0;
constexpr size_t CTL_BYTES = 65536;
constexpr size_t CTL_CNT  = 16384;
constexpr size_t WS_X     = WS_CTL + CTL_BYTES;
constexpr size_t WS_H     = WS_X + (size_t)T * D * 4;
constexpr size_t WS_UQ    = WS_H + (size_t)T * D * 2;
constexpr size_t WS_UKV   = WS_UQ + (size_t)T * 256 * 2;
constexpr size_t WS_UFT   = WS_UKV + (size_t)T * 256 * 2;
constexpr size_t WS_GQ    = WS_UFT + (size_t)NB * 512 * RPB * 2;
constexpr size_t WS_GK    = WS_GQ + (size_t)T * 256 * 2;
constexpr size_t WS_GV    = WS_GK + (size_t)T * 256 * 2;
constexpr size_t WS_GOG   = WS_GV + (size_t)T * 512 * 2;
constexpr size_t WS_GATE  = WS_GOG + (size_t)T * 512 * 2;
constexpr size_t WS_SSQ   = WS_GATE + (size_t)T * 3072 * 2;
constexpr size_t WS_Q     = WS_SSQ + (size_t)T * 8 * 4;
constexpr size_t WS_KN    = WS_Q + (size_t)T * 768 * 2;
constexpr size_t WS_KR    = WS_KN + (size_t)T * 512 * 2;
constexpr size_t WS_VT    = WS_KR + (size_t)T * 32 * 2;
constexpr size_t WS_OMLA  = WS_VT + (size_t)NB * 8 * 64 * RPB * 2;
constexpr size_t WS_P     = WS_OMLA + (size_t)T * 512 * 2;
constexpr size_t WS_KVS   = WS_P + (size_t)T * D * 2;
constexpr size_t WS_DEC   = WS_KVS + (size_t)NB * 4 * 2 * NCHUNK * 128 * 64 * 2;
constexpr size_t WS_OGLA  = WS_DEC + (size_t)NB * 4 * 2 * NCHUNK * 64 * 4;
constexpr size_t WS_Y     = WS_OGLA + (size_t)T * 512 * 2;
constexpr size_t WS_TOPI  = WS_Y + (size_t)T * D * 2;
constexpr size_t WS_TOPG  = WS_TOPI + (size_t)T * 16;
constexpr size_t WS_TOPP  = WS_TOPG + (size_t)T * 16;
constexpr size_t WS_HS    = WS_TOPP + (size_t)T * 16;
constexpr size_t WS_ACT   = WS_HS + (size_t)NPAD * D * 2;
constexpr size_t WS_YM    = WS_ACT + (size_t)NPAD * D * 2;
constexpr size_t WS_GG    = WS_YM + (size_t)NPAD * D * 2;
constexpr size_t WS_RT2   = WS_GG + (size_t)T * 512 * 4;
constexpr size_t WS_H8    = WS_RT2 + (size_t)NE * T * 4;
constexpr size_t WS_HA8   = WS_H8 + (size_t)T * D;
constexpr size_t WS_MOD   = WS_HA8 + (size_t)T * D;
constexpr size_t WS_ROPE  = WS_MOD + (size_t)DEPTH * 9 * 6144 * 4;
constexpr size_t WS_DFTL  = al256(WS_ROPE + 4096);
constexpr size_t WS_DFTC  = WS_DFTL + (size_t)8192 * 4096 * 2;
constexpr size_t WS_DB    = WS_DFTC + (size_t)512 * 256 * 2;
constexpr size_t WS_TW    = WS_DB + (size_t)512 * 512 * 2;
constexpr size_t WS_W     = WS_TW + (size_t)16 * 256 * 8;
constexpr size_t WL_WIN = 0;
constexpr size_t WL_WUQ = WL_WIN + (size_t)G1N * 1024 * 2;
constexpr size_t WL_WUKV = WL_WUQ + (size_t)768 * 256 * 2;
constexpr size_t WL_WM = WL_WUKV + (size_t)1024 * 256 * 2;
constexpr size_t WL_WF = WL_WM + (size_t)1024 * 512 * 2;
constexpr size_t WL_WG = WL_WF + (size_t)1024 * 1024 * 2;
constexpr size_t WL_WO = WL_WG + (size_t)1024 * 512 * 2;
constexpr size_t WL_WUP = WL_WO + (size_t)1024 * 1024 * 2;
constexpr size_t WL_WDN = WL_WUP + (size_t)NE * 2048 * 1024;
constexpr size_t WL_WIN8 = WL_WDN + (size_t)NE * 1024 * 1024;
constexpr size_t WL_BYTES = WL_WIN8 + (size_t)G1N * 1024;
constexpr size_t WS_END = WS_W + (size_t)DEPTH * WL_BYTES;
static_assert(WS_END < ((size_t)4 << 30), "workspace map exceeds 4 GiB");
static_assert(WS_W % 256 == 0 && WL_BYTES % 256 == 0, "alignment");

constexpr int LDS_BYTES = 160 * 1024;
constexpr int LDS_AUX = 131072;

struct Params {
    const float *x, *c, *ctx, *c_ctx, *w_mod, *b_mod, *norm1_g, *w_in, *q_norm_g, *w_uq, *kv_norm_g, *w_ukv,
                *w_gf, *b_gf, *w_gb, *b_gb, *gla_norm_g, *w_br_mla, *w_br_fnet, *w_br_gla, *w_o, *norm2_g,
                *router_w, *router_b, *w_up, *b_up, *w_down, *b_down, *final_g;
    float* out; char* ws;
};

struct PTab {
    const LAS unsigned long long* t;
    __device__ __forceinline__ unsigned long long get(int i) const { const unsigned long long v = t[i]; const unsigned lo = __builtin_amdgcn_readfirstlane((unsigned)v), hi = __builtin_amdgcn_readfirstlane((unsigned)(v >> 32)); return ((unsigned long long)hi << 32) | lo; }
    __device__ __forceinline__ const float* x() const { return (const float*)(const __attribute__((address_space(1))) float*)get(0); }
    __device__ __forceinline__ const float* c() const { return (const float*)(const __attribute__((address_space(1))) float*)get(1); }
    __device__ __forceinline__ const float* ctx() const { return (const float*)(const __attribute__((address_space(1))) float*)get(2); }
    __device__ __forceinline__ const float* c_ctx() const { return (const float*)(const __attribute__((address_space(1))) float*)get(3); }
    __device__ __forceinline__ const float* w_mod() const { return (const float*)(const __attribute__((address_space(1))) float*)get(4); }
    __device__ __forceinline__ const float* b_mod() const { return (const float*)(const __attribute__((address_space(1))) float*)get(5); }
    __device__ __forceinline__ const float* norm1_g() const { return (const float*)(const __attribute__((address_space(1))) float*)get(6); }
    __device__ __forceinline__ const float* w_in() const { return (const float*)(const __attribute__((address_space(1))) float*)get(7); }
    __device__ __forceinline__ const float* q_norm_g() const { return (const float*)(const __attribute__((address_space(1))) float*)get(8); }
    __device__ __forceinline__ const float* w_uq() const { return (const float*)(const __attribute__((address_space(1))) float*)get(9); }
    __device__ __forceinline__ const float* kv_norm_g() const { return (const float*)(const __attribute__((address_space(1))) float*)get(10); }
    __device__ __forceinline__ const float* w_ukv() const { return (const float*)(const __attribute__((address_space(1))) float*)get(11); }
    __device__ __forceinline__ const float* w_gf() const { return (const float*)(const __attribute__((address_space(1))) float*)get(12); }
    __device__ __forceinline__ const float* b_gf() const { return (const float*)(const __attribute__((address_space(1))) float*)get(13); }
    __device__ __forceinline__ const float* w_gb() const { return (const float*)(const __attribute__((address_space(1))) float*)get(14); }
    __device__ __forceinline__ const float* b_gb() const { return (const float*)(const __attribute__((address_space(1))) float*)get(15); }
    __device__ __forceinline__ const float* gla_norm_g() const { return (const float*)(const __attribute__((address_space(1))) float*)get(16); }
    __device__ __forceinline__ const float* w_br_mla() const { return (const float*)(const __attribute__((address_space(1))) float*)get(17); }
    __device__ __forceinline__ const float* w_br_fnet() const { return (const float*)(const __attribute__((address_space(1))) float*)get(18); }
    __device__ __forceinline__ const float* w_br_gla() const { return (const float*)(const __attribute__((address_space(1))) float*)get(19); }
    __device__ __forceinline__ const float* w_o() const { return (const float*)(const __attribute__((address_space(1))) float*)get(20); }
    __device__ __forceinline__ const float* norm2_g() const { return (const float*)(const __attribute__((address_space(1))) float*)get(21); }
    __device__ __forceinline__ const float* router_w() const { return (const float*)(const __attribute__((address_space(1))) float*)get(22); }
    __device__ __forceinline__ const float* router_b() const { return (const float*)(const __attribute__((address_space(1))) float*)get(23); }
    __device__ __forceinline__ const float* w_up() const { return (const float*)(const __attribute__((address_space(1))) float*)get(24); }
    __device__ __forceinline__ const float* b_up() const { return (const float*)(const __attribute__((address_space(1))) float*)get(25); }
    __device__ __forceinline__ const float* w_down() const { return (const float*)(const __attribute__((address_space(1))) float*)get(26); }
    __device__ __forceinline__ const float* b_down() const { return (const float*)(const __attribute__((address_space(1))) float*)get(27); }
    __device__ __forceinline__ const float* final_g() const { return (const float*)(const __attribute__((address_space(1))) float*)get(28); }
    __device__ __forceinline__ float* out() const { return (float*)(__attribute__((address_space(1))) float*)get(29); }
    __device__ __forceinline__ char* ws() const { return (char*)(__attribute__((address_space(1))) char*)get(30); }
};
constexpr int LDS_PTAB = LDS_AUX + 24576;

__device__ __forceinline__ int ltid() { int t = (int)threadIdx.x; asm volatile("" : "+v"(t)); return t; }
__device__ __forceinline__ int lsgpr(int v) { asm volatile("" : "+s"(v)); return v; }
__device__ __forceinline__ LAS unsigned char* lds_launder(LAS unsigned char* p) { unsigned a = (unsigned)(unsigned long long)p; asm volatile("" : "+s"(a)); return (LAS unsigned char*)(unsigned long long)a; }

typedef __bf16 bf16x2_t __attribute__((ext_vector_type(2)));
template <int K> __device__ __forceinline__ float lane_xor(float v, int lane) {
    if constexpr (K == 32) { const auto rr = __builtin_amdgcn_permlane32_swap(__float_as_uint(v), __float_as_uint(v), false, false); return __uint_as_float((lane & 32) ? rr[0] : rr[1]); }
    else return __int_as_float(__builtin_amdgcn_ds_swizzle(__float_as_int(v), (K << 10) | 0x1f));
}
__device__ __forceinline__ float half_sum32(float v) { const auto rr = __builtin_amdgcn_permlane32_swap(__float_as_uint(v), __float_as_uint(v), false, false); return __uint_as_float(rr[0]) + __uint_as_float(rr[1]); }
__device__ __forceinline__ float half_max32(float v) { const auto rr = __builtin_amdgcn_permlane32_swap(__float_as_uint(v), __float_as_uint(v), false, false); return fmaxf(__uint_as_float(rr[0]), __uint_as_float(rr[1])); }
__device__ __forceinline__ float wave_sum(float v) { v += lane_xor<1>(v, 0); v += lane_xor<2>(v, 0); v += lane_xor<4>(v, 0); v += lane_xor<8>(v, 0); v += lane_xor<16>(v, 0); return half_sum32(v); }

__device__ __forceinline__ unsigned cvt_pk_bf16(float lo, float hi) { const f32x2 v = {lo, hi}; const bf16x2_t b = __builtin_convertvector(v, bf16x2_t); return __builtin_bit_cast(unsigned, b); }
__device__ __forceinline__ unsigned cvt4_fp8(float a, float b, float c, float d) { int w = 0; w = __builtin_amdgcn_cvt_pk_fp8_f32(a, b, w, false); w = __builtin_amdgcn_cvt_pk_fp8_f32(c, d, w, true); return (unsigned)w; }
__device__ __forceinline__ float sat8(float x) { x = __builtin_fmaxf(x, -448.0f); asm volatile("" : "+v"(x)); return __builtin_fminf(x, 448.0f); }
__device__ __forceinline__ unsigned cvt4_fp8s(float a, float b, float c, float d) { return cvt4_fp8(sat8(a), sat8(b), sat8(c), sat8(d)); }
constexpr float YM_SCALE = 16.0f;
constexpr float W8_SCALE = 128.0f;
constexpr int W8_E8M0 = 0x78787878, ONE_E8M0 = 0x7f7f7f7f;
__device__ __forceinline__ void cvt_fp8x4(unsigned w, float& a, float& b, float& c, float& d) { const f32x2 lo = __builtin_amdgcn_cvt_pk_f32_fp8((int)w, false), hi = __builtin_amdgcn_cvt_pk_f32_fp8((int)w, true); a = lo.x; b = lo.y; c = hi.x; d = hi.y; }
__device__ __forceinline__ bf16_t f2bf(float f) { return (bf16_t)(cvt_pk_bf16(f, 0.f) & 0xffffu); }
__device__ __forceinline__ float bf2f(bf16_t b) { return __uint_as_float(((unsigned)b) << 16); }
typedef _Float16 f16x2_t __attribute__((ext_vector_type(2)));
__device__ __forceinline__ unsigned pk_f16(float a, float b) { const f16x2_t v = {(_Float16)a, (_Float16)b}; return __builtin_bit_cast(unsigned, v); }
__device__ __forceinline__ void un_f16(unsigned w, float& a, float& b) { const f16x2_t v = __builtin_bit_cast(f16x2_t, w); a = (float)v[0]; b = (float)v[1]; }
__device__ __forceinline__ float bflo(unsigned w) { return __uint_as_float(w << 16); }
__device__ __forceinline__ float bfhi(unsigned w) { return __uint_as_float(w & 0xffff0000u); }
__device__ __forceinline__ float sigmoidf_(float x) { return __builtin_amdgcn_rcpf(1.0f + __expf(-x)); }
__device__ __forceinline__ float siluf_(float x) { return x * __builtin_amdgcn_rcpf(1.0f + __expf(-x)); }

#define XB_TMO      128
#define XB_XCNT(j)  (256  + 64 * (j))
#define XB_XSUB(j)  (1280 + 64 * (j))
#define XB_XGEN(j)  (2304 + 64 * (j))
#define XB_TOP      3328
#define XB_TOPGEN   3392
#define XCD_BAR_WORDS 3456
#define XB_SPIN_CAP (1u << 18)
__device__ __forceinline__ unsigned xb_ld(unsigned* p)              { return __hip_atomic_load(p, __ATOMIC_RELAXED, __HIP_MEMORY_SCOPE_AGENT); }
__device__ __forceinline__ unsigned xb_add(unsigned* p, unsigned v) { return __hip_atomic_fetch_add(p, v, __ATOMIC_RELAXED, __HIP_MEMORY_SCOPE_AGENT); }
__device__ __forceinline__ unsigned xb_xcc_id() { return (unsigned)__builtin_amdgcn_s_getreg((3 << 11) | 20) & 0xFu; }
#define XB_SPIN(cond, bar) do { unsigned _sp = 0; while (cond) { __builtin_amdgcn_s_sleep(1); \
    if ((++_sp & 255u) == 0u) { if (xb_ld(&(bar)[XB_TMO])) break; if (_sp > XB_SPIN_CAP) { atomicAdd(&(bar)[XB_TMO], 1u); break; } } } } while (0)
struct XcdBarrier { unsigned* bar; unsigned x; volatile LAS unsigned* st; };
__device__ __forceinline__ XcdBarrier xcd_barrier_post(unsigned* bar, volatile LAS unsigned* st) {
    XcdBarrier b; b.bar = bar; b.x = xb_xcc_id(); b.st = st;
    if (threadIdx.x == 0) (void)xb_add(&bar[XB_XCNT(b.x)], 1u);
    return b;
}
__device__ __forceinline__ void xcd_barrier_complete(unsigned* bar, unsigned x, unsigned& nloc, unsigned& nx) {
    const unsigned G = gridDim.x * gridDim.y * gridDim.z;
    unsigned sum, cnt, mine, sp = 0u;
    for (;;) {
        sum = 0u; cnt = 0u; mine = 0u;
#pragma unroll
        for (unsigned j = 0; j < 16; ++j) { const unsigned c = xb_ld(&bar[XB_XCNT(j)]); sum += c; cnt += (c > 0u) ? 1u : 0u; mine = (j == x) ? c : mine; }
        if (sum == G) break;
        __builtin_amdgcn_s_sleep(1);
        if ((++sp & 255u) == 0u) { if (xb_ld(&bar[XB_TMO])) break; if (sp > XB_SPIN_CAP) { atomicAdd(&bar[XB_TMO], 1u); break; } }
    }
    nloc = mine > 0u ? mine : 1u; nx = cnt > 0u ? cnt : 1u;
}
__device__ __forceinline__ void xcd_barrier(const XcdBarrier& b) {
    asm volatile("s_waitcnt vmcnt(0)" ::: "memory");
    __syncthreads();
    if (threadIdx.x == 0) {
        unsigned* bar = b.bar;
        __builtin_amdgcn_s_waitcnt(0);
        unsigned nloc = b.st[0], nx = b.st[1];
        if (nloc == 0u) { xcd_barrier_complete(bar, b.x, nloc, nx); b.st[0] = nloc; b.st[1] = nx; }
        const unsigned old = xb_add(&bar[XB_XSUB(b.x)], 1u);
        const unsigned gen = old / nloc;
        if (old + 1u == (gen + 1u) * nloc) {
            __builtin_amdgcn_fence(__ATOMIC_RELEASE, "agent");
            asm volatile("s_waitcnt vmcnt(0)" ::: "memory");
            const unsigned og = xb_add(&bar[XB_TOP], 1u);
            const unsigned tg = og / nx;
            if (og + 1u == (tg + 1u) * nx) xb_add(&bar[XB_TOPGEN], 1u);
            else XB_SPIN(xb_ld(&bar[XB_TOPGEN]) == tg, bar);
            __builtin_amdgcn_fence(__ATOMIC_ACQUIRE, "agent");
            xb_add(&bar[XB_XGEN(b.x)], 1u);
            asm volatile("s_waitcnt vmcnt(0)" ::: "memory");
        } else {
            XB_SPIN(xb_ld(&bar[XB_XGEN(b.x)]) == gen, bar);
            __builtin_amdgcn_fence(__ATOMIC_ACQUIRE, "agent");
            asm volatile("s_waitcnt vmcnt(0)" ::: "memory");
        }
    }
    __syncthreads();
}

__device__ __forceinline__ void grid_sync(const XcdBarrier& b) {
    XcdBarrier c = b; unsigned long long p = (unsigned long long)c.bar; unsigned x = c.x, st = (unsigned)(unsigned long long)c.st;
    asm volatile("" : "+s"(p), "+s"(x), "+s"(st));
    c.bar = (unsigned*)(__attribute__((address_space(1))) unsigned*)p; c.x = x; c.st = (volatile LAS unsigned*)(unsigned long long)st;
    xcd_barrier(c);
}
#ifndef GK_ALIGN_EPI
#define GK_ALIGN_EPI 1
#endif
typedef int i32x8 __attribute__((ext_vector_type(8)));
namespace gk {
constexpr int BM = 256, BK = 64, HALF = 128, HTB = HALF * BK * 2, STAGE_BYTES = 8 * HTB;
__device__ __forceinline__ int lds_byte(int r, int c) { const int st = (r >> 4) * 2 + (c >> 5), rr = r & 15, cc = c & 31, ob = rr * 64 + cc * 2; return st * 1024 + (ob ^ (((ob >> 9) & 1) << 5)); }
__device__ __forceinline__ void stage_rc(int b, int& R, int& C) { const int st = b / 1024, sb = b % 1024, swz = sb ^ (((sb >> 9) & 1) << 5); R = (st >> 1) * 16 + swz / 64; C = (st & 1) * 32 + (swz % 64) / 2; }
__device__ __forceinline__ int perm32(int rho) { const int n = rho >> 4, i = rho & 15; return 8 * (i >> 2) + 4 * n + (i & 3); }

struct Unit {
    const char* A; const char* B;
    unsigned lda2, ldb2;
    int nt;
    int pm;
    int info;
    __device__ __forceinline__ int pn() const { return info & 0xff; }
    __device__ __forceinline__ int aux() const { return (info >> 8) & 0xff; }
    __device__ __forceinline__ int kind() const { return (info >> 16) & 0xff; }
    __device__ __forceinline__ int keep() const { return (info >> 24) & 1; }
    __device__ __forceinline__ void set(int pm_, int pn_, int aux_, int kind_, int keep_) { pm = pm_; info = pn_ | (aux_ << 8) | (kind_ << 16) | (keep_ << 24); }
};
typedef f32x4 Acc[2][2][4][2];

template <bool F8> struct FragT { typedef bf16x8 A4[4][2]; typedef bf16x8 B2[2][2]; };
template <> struct FragT<true> { typedef i32x8 A4[4]; typedef i32x8 B2[2]; };
__device__ __forceinline__ void frag_ld(bf16x8 (&d)[2], const LAS unsigned char* p) { d[0] = *(const LAS bf16x8*)p; d[1] = *(const LAS bf16x8*)(p + 1024); }
__device__ __forceinline__ void frag_ld(i32x8& d, const LAS unsigned char* p) { const u32x4 lo = *(const LAS u32x4*)p, hi = *(const LAS u32x4*)(p + 1024);
    d = (i32x8){(int)lo.x, (int)lo.y, (int)lo.z, (int)lo.w, (int)hi.x, (int)hi.y, (int)hi.z, (int)hi.w}; }
__device__ __forceinline__ f32x4 frag_mma(const bf16x8 (&b)[2], const bf16x8 (&a)[2], f32x4 c, int) { c = __builtin_amdgcn_mfma_f32_16x16x32_bf16(b[0], a[0], c, 0, 0, 0); return __builtin_amdgcn_mfma_f32_16x16x32_bf16(b[1], a[1], c, 0, 0, 0); }
__device__ __forceinline__ f32x4 frag_mma(const i32x8& b, const i32x8& a, f32x4 c, int sc) { return __builtin_amdgcn_mfma_scale_f32_16x16x128_f8f6f4(b, a, c, 0, 0, 0, sc, 1, sc); }
template <class Sched> __device__ __forceinline__ const char* a_base(const Sched& S, const Unit& u) { if constexpr (Sched::GATHER) return S.gbase; else return u.A; }
template <class Epi, class Sched>
__device__ __forceinline__ void gemm_phase(LAS unsigned char* lds, const Sched& S, const Epi& E) {
    const int tid = ltid(), wid = __builtin_amdgcn_readfirstlane(tid >> 6), lane = tid & 63, wr = wid >> 2, wc = wid & 3, fr = lane & 15, fq = lane >> 4;
#define GK_OFFS(U, a0, a1, b0, b1) do { int tz_ = ltid(); int R0_, C0_, R1_, C1_; stage_rc(tz_ * 16, R0_, C0_); stage_rc(tz_ * 16 + 8192, R1_, C1_); \
        a0 = (unsigned)R0_ * (U).lda2 + (unsigned)C0_ * 2u; a1 = (unsigned)R1_ * (U).lda2 + (unsigned)C1_ * 2u; \
        b0 = (unsigned)((R0_ & ~31) + perm32(R0_ & 31)) * (U).ldb2 + (unsigned)C0_ * 2u; b1 = (unsigned)((R1_ & ~31) + perm32(R1_ & 31)) * (U).ldb2 + (unsigned)C1_ * 2u; } while (0)
#define GK_GLOAD(U, g0, g1, g2, g3) do { int tz_ = ltid(); int R0_, C0_, R1_, C1_; stage_rc(tz_ * 16, R0_, C0_); stage_rc(tz_ * 16 + 8192, R1_, C1_); const int* lst_ = (const int*)(U).A; const int cnt_ = (int)(U).lda2; \
        g0 = (R0_ < cnt_) ? lst_[R0_] : 0; g1 = (R1_ < cnt_) ? lst_[R1_] : 0; g2 = (R0_ + 128 < cnt_) ? lst_[R0_ + 128] : 0; g3 = (R1_ + 128 < cnt_) ? lst_[R1_ + 128] : 0; } while (0)
#define GK_GOFFS(U, g0, g1, g2, g3, a0, a1, ah0, ah1, b0, b1) do { int tz_ = ltid(); int R0_, C0_, R1_, C1_; stage_rc(tz_ * 16, R0_, C0_); stage_rc(tz_ * 16 + 8192, R1_, C1_); \
        a0 = (unsigned)(g0) * (unsigned)Sched::GPITCH + (unsigned)C0_ * 2u; a1 = (unsigned)(g1) * (unsigned)Sched::GPITCH + (unsigned)C1_ * 2u; ah0 = (unsigned)(g2) * (unsigned)Sched::GPITCH + (unsigned)C0_ * 2u; ah1 = (unsigned)(g3) * (unsigned)Sched::GPITCH + (unsigned)C1_ * 2u; \
        b0 = (unsigned)((R0_ & ~31) + perm32(R0_ & 31)) * (U).ldb2 + (unsigned)C0_ * 2u; b1 = (unsigned)((R1_ & ~31) + perm32(R1_ & 31)) * (U).ldb2 + (unsigned)C1_ * 2u; } while (0)
#define GK_STAGE_AH(bufoff, base, hstep) do { if constexpr (Sched::GATHER) GK_STAGE(bufoff, base, cah0, cah1); else GK_STAGE(bufoff, (base) + (hstep), ca0, ca1); } while (0)
#define GK_AB(U) a_base(S, (U))
    const unsigned ldsw = (unsigned)wid * 1024u;
    const int aoff = lds_byte(wr * 64 + fr, fq * 8), boff = lds_byte(wc * 32 + fr, fq * 8);
#define GK_SA(b, h) (((b) * 2 + (h)) * HTB)
#define GK_SB(b, h) ((4 + (b) * 2 + (h)) * HTB)
#define GK_STAGE(bufoff, gbase, v0, v1) do { \
        __builtin_amdgcn_global_load_lds((const unsigned*)((const char*)(gbase) + (v0)), (LAS unsigned*)(lds + (bufoff) + ldsw), 16, 0, 0); \
        __builtin_amdgcn_global_load_lds((const unsigned*)((const char*)(gbase) + (v1)), (LAS unsigned*)(lds + (bufoff) + ldsw + 8192), 16, 0, 0); } while (0)
#define GK_LDA(dst, b, h) do { _Pragma("unroll") for (int m = 0; m < 4; ++m) frag_ld(dst[m], lds + GK_SA(b, h) + aoff + m * 2048); } while (0)
#define GK_LDB(dst, b, h) do { _Pragma("unroll") for (int n = 0; n < 2; ++n) frag_ld(dst[n], lds + GK_SB(b, h) + boff + n * 2048); } while (0)
#define GK_MMA(ai, bj, At, Bt) do { __builtin_amdgcn_s_setprio(1); _Pragma("unroll") for (int m = 0; m < 4; ++m) _Pragma("unroll") for (int n = 0; n < 2; ++n) \
        acc[ai][bj][m][n] = frag_mma(Bt[n], At[m], acc[ai][bj][m][n], sc_w); __builtin_amdgcn_s_setprio(0); } while (0)
#define GK_WAIT_V(n) asm volatile("s_waitcnt vmcnt(" #n ")" ::: "memory")
#define GK_WAIT_L(n) asm volatile("s_waitcnt lgkmcnt(" #n ")" ::: "memory")
#define GK_BAR __builtin_amdgcn_s_barrier()
#define GK_SCHED __builtin_amdgcn_sched_barrier(0)
    Unit cur, nxt; int ui = 0;
    if (!S.next(0, cur)) return;
    int sc_w = (int)((ONE_E8M0 & 0xffffff00u) | (W8_E8M0 & 0xffu)); asm volatile("" : "+v"(sc_w));
    Acc acc;
#pragma unroll
    for (int a = 0; a < 2; ++a)
#pragma unroll
        for (int b = 0; b < 2; ++b)
#pragma unroll
            for (int m = 0; m < 4; ++m)
#pragma unroll
                for (int n = 0; n < 2; ++n) acc[a][b][m][n] = (f32x4){0.f, 0.f, 0.f, 0.f};
    typedef typename FragT<Sched::FP8>::A4 FragA; typedef typename FragT<Sched::FP8>::B2 FragB;
    FragA At; FragB B0, B1;
    unsigned ca0, ca1, cb0, cb1; [[maybe_unused]] unsigned cah0 = 0, cah1 = 0; [[maybe_unused]] int gi0 = 0, gi1 = 0, gi2 = 0, gi3 = 0;
    if constexpr (Sched::GATHER) { GK_GLOAD(cur, gi0, gi1, gi2, gi3); GK_GOFFS(cur, gi0, gi1, gi2, gi3, ca0, ca1, cah0, cah1, cb0, cb1); } else { GK_OFFS(cur, ca0, ca1, cb0, cb1); }
    {
        const char* cA = GK_AB(cur); const char* cB = cur.B; const size_t hA = (size_t)HALF * cur.lda2, hB = (size_t)HALF * cur.ldb2;
        GK_STAGE(GK_SB(0, 0), cB, cb0, cb1); GK_STAGE(GK_SB(0, 1), cB + hB, cb0, cb1); GK_STAGE(GK_SA(0, 0), cA, ca0, ca1); GK_STAGE_AH(GK_SA(0, 1), cA, hA);
        if (wr == 1) GK_BAR;
        GK_WAIT_V(2); GK_BAR;
        GK_STAGE(GK_SB(1, 0), cB + 128, cb0, cb1); GK_STAGE(GK_SA(1, 0), cA + 128, ca0, ca1); GK_STAGE(GK_SB(1, 1), cB + hB + 128, cb0, cb1);
        GK_WAIT_V(6); GK_BAR;
    }
    for (;;) {
        const bool has_next = S.next(ui + 1, nxt);
        if (!has_next) nxt = cur;
        if constexpr (Sched::GATHER) GK_GLOAD(nxt, gi0, gi1, gi2, gi3);
        const size_t hA = (size_t)HALF * cur.lda2, hB = (size_t)HALF * cur.ldb2, nhA = (size_t)HALF * nxt.lda2, nhB = (size_t)HALF * nxt.ldb2;
        const int nt = cur.nt;
        for (int t = 0; t < nt; t += 2) {
            const bool last = (t == nt - 2);
            const char* a1 = GK_AB(cur) + (size_t)(t + 1) * 128;
            const char* a2 = last ? GK_AB(nxt) : GK_AB(cur) + (size_t)(t + 2) * 128; const char* b2 = last ? nxt.B : cur.B + (size_t)(t + 2) * 128;
            const char* a3 = a2 + 128; const char* b3 = b2 + 128;
            const size_t h2A = last ? nhA : hA, h2B = last ? nhB : hB;
            GK_LDB(B0, 0, 0); GK_LDB(B1, 0, 1); GK_SCHED; GK_LDA(At, 0, 0); GK_STAGE_AH(GK_SA(1, 1), a1, hA);
            if (last) { if constexpr (Sched::GATHER) GK_GOFFS(nxt, gi0, gi1, gi2, gi3, ca0, ca1, cah0, cah1, cb0, cb1); else GK_OFFS(nxt, ca0, ca1, cb0, cb1); }
            GK_WAIT_V(8); GK_WAIT_L(0); GK_BAR; GK_MMA(0, 0, At, B0); GK_MMA(0, 1, At, B1); GK_BAR; GK_SCHED;
            GK_LDA(At, 0, 1); GK_STAGE(GK_SB(0, 0), b2, cb0, cb1); GK_STAGE(GK_SB(0, 1), b2 + h2B, cb0, cb1); GK_STAGE(GK_SA(0, 0), a2, ca0, ca1);
            GK_WAIT_V(8); GK_WAIT_L(0); GK_BAR; GK_MMA(1, 0, At, B0); GK_MMA(1, 1, At, B1); GK_BAR; GK_SCHED;
            GK_LDB(B0, 1, 0); GK_LDB(B1, 1, 1); GK_SCHED; GK_LDA(At, 1, 0); GK_STAGE_AH(GK_SA(0, 1), a2, h2A);
            GK_WAIT_V(8); GK_WAIT_L(0); GK_BAR; GK_MMA(0, 0, At, B0); GK_MMA(0, 1, At, B1); GK_BAR; GK_SCHED;
            GK_LDA(At, 1, 1); GK_STAGE(GK_SB(1, 0), b3, cb0, cb1); GK_STAGE(GK_SB(1, 1), b3 + h2B, cb0, cb1); GK_STAGE(GK_SA(1, 0), a3, ca0, ca1);
            GK_WAIT_V(8); GK_WAIT_L(0); GK_BAR; GK_MMA(1, 0, At, B0); GK_MMA(1, 1, At, B1); GK_BAR; GK_SCHED;
        }
        if (GK_ALIGN_EPI && wr == 0) GK_BAR;
        { const int tz_ = ltid(), wz_ = __builtin_amdgcn_readfirstlane(tz_ >> 6), lz_ = tz_ & 63;
          E(acc, cur, wz_ >> 2, wz_ & 3, lz_ & 15, lz_ >> 4); }
        if (!has_next) break;
        if (!cur.keep()) {
#pragma unroll
            for (int a = 0; a < 2; ++a)
#pragma unroll
                for (int b = 0; b < 2; ++b)
#pragma unroll
                    for (int m = 0; m < 4; ++m)
#pragma unroll
                        for (int n = 0; n < 2; ++n) acc[a][b][m][n] = (f32x4){0.f, 0.f, 0.f, 0.f};
        }
        cur = nxt; ++ui;
        if (GK_ALIGN_EPI && wr == 1) GK_BAR;
    }
    GK_WAIT_V(0);
    if (!GK_ALIGN_EPI && wr == 0) GK_BAR;
    GK_BAR;
#undef GK_OFFS
#undef GK_GLOAD
#undef GK_GOFFS
#undef GK_STAGE_AH
#undef GK_AB
#undef GK_SA
#undef GK_SB
#undef GK_STAGE
#undef GK_LDA
#undef GK_LDB
#undef GK_MMA
#undef GK_WAIT_V
#undef GK_WAIT_L
#undef GK_BAR
#undef GK_SCHED
}

__device__ __forceinline__ void tile_order(int L, int nM, int nN, int& pm, int& pn) {
    const int nwg = nM * nN; int wgid = L;
    { const int q = nwg / 8, r = nwg % 8, xcd = wgid % 8, off = wgid / 8; wgid = (xcd < r ? xcd * (q + 1) : r * (q + 1) + (xcd - r) * q) + off; }
    const int nig = 8 * nN, gid = wgid / nig, fm = gid * 8, gsz = (nM - fm) < 8 ? (nM - fm) : 8;
    pm = fm + ((wgid % nig) % gsz); pn = (wgid % nig) / gsz;
}
}
template <class ColF>
__device__ __forceinline__ void cvt_tr(const float* __restrict__ src, int ld_src, int Ksrc, bf16_t* __restrict__ dst, int Kdst, int N, const ColF& colf, const float* __restrict__ kscale,
                                       unsigned& ctr, int G, int c) {
    const int tid = ltid(), lane = tid & 63, wid = __builtin_amdgcn_readfirstlane(tid >> 6);
    const int nkt = Kdst / 256, nnt = N / 64, ntile = nkt * nnt;
    const int t0 = (int)(((unsigned)c + (unsigned)G - (ctr % (unsigned)G)) % (unsigned)G);
    for (int tt = t0; tt < ntile; tt += G) {
        const int kt = tt / nnt, nt_ = tt % nnt, n = nt_ * 64 + lane, kb = kt * 256 + wid * 32;
        float mul; const int sc = colf(n, mul);
        const float* sp = src + (size_t)kb * ld_src + (sc >= 0 ? sc : 0);
        float v[32];
#pragma unroll
        for (int j = 0; j < 32; ++j) v[j] = (kb + j < Ksrc) ? sp[(size_t)j * ld_src] : 0.f;
        if (sc < 0) mul = 0.f;
#pragma unroll
        for (int j = 0; j < 32; ++j) { float m2 = mul; if (kscale) m2 *= (kb + j < Ksrc) ? kscale[kb + j] : 0.f; v[j] *= m2; }
        bf16_t* dp = dst + (size_t)n * Kdst + kb;
#pragma unroll
        for (int q = 0; q < 4; ++q) { u32x4 w; w.x = cvt_pk_bf16(v[8 * q], v[8 * q + 1]); w.y = cvt_pk_bf16(v[8 * q + 2], v[8 * q + 3]); w.z = cvt_pk_bf16(v[8 * q + 4], v[8 * q + 5]); w.w = cvt_pk_bf16(v[8 * q + 6], v[8 * q + 7]);
            *(u32x4*)(dp + 8 * q) = w; }
    }
    ctr += (unsigned)ntile;
}

template <class ColF>
__device__ __forceinline__ void cvt_tr8(const float* __restrict__ src, int ld_src, unsigned char* __restrict__ dst, int Kdst, int N, const ColF& colf, float mul0, unsigned& ctr, int G, int c) {
    const int tid = ltid(), lane = tid & 63, wid = __builtin_amdgcn_readfirstlane(tid >> 6);
    const int nkt = Kdst / 256, nnt = N / 64, ntile = nkt * nnt;
    const int t0 = (int)(((unsigned)c + (unsigned)G - (ctr % (unsigned)G)) % (unsigned)G);
    for (int tt = t0; tt < ntile; tt += G) {
        const int kt = tt / nnt, nt_ = tt % nnt, n = nt_ * 64 + lane, kb = kt * 256 + wid * 32;
        float mul; const int sc = colf(n, mul); mul *= mul0; if (sc < 0) mul = 0.f;
        const float* sp = src + (size_t)kb * ld_src + (sc >= 0 ? sc : 0);
        float v[32];
#pragma unroll
        for (int j = 0; j < 32; ++j) v[j] = sp[(size_t)j * ld_src] * mul;
        unsigned char* dp = dst + (size_t)n * Kdst + kb;
#pragma unroll
        for (int q = 0; q < 2; ++q) { u32x4 w; w.x = cvt4_fp8s(v[16 * q], v[16 * q + 1], v[16 * q + 2], v[16 * q + 3]); w.y = cvt4_fp8s(v[16 * q + 4], v[16 * q + 5], v[16 * q + 6], v[16 * q + 7]);
            w.z = cvt4_fp8s(v[16 * q + 8], v[16 * q + 9], v[16 * q + 10], v[16 * q + 11]); w.w = cvt4_fp8s(v[16 * q + 12], v[16 * q + 13], v[16 * q + 14], v[16 * q + 15]);
            *(u32x4*)(dp + 16 * q) = w; }
    }
    ctr += (unsigned)ntile;
}

__device__ __forceinline__ int g1_col(int n, float& mul) {
    mul = 1.0f;
    if (n < 256) return CO_Q + n;
    if (n < 512) { const int r = n - 256; if (r < 160) return CO_KV + r; if (r < 176) return CO_GF + (r - 160); if (r < 192) return CO_GB + (r - 176); return -1; }
    if (n < 1024) return CO_FN + (n - 512);
    if (n < 1280) { mul = 0.125f; return CO_GQ + (n - 1024); }
    if (n < 1536) return CO_GK + (n - 1280);
    if (n < 2048) return CO_GV + (n - 1536);
    if (n < 2560) return CO_OG + (n - 2048);
    return CO_GATE + (n - 2560);
}
__device__ __forceinline__ int uq_col(int n, float& mul) {
    mul = 1.0f;
    if (n < 512) return (n >> 6) * 96 + (n & 63);
    const int r = n - 512, h = r >> 5, j = r & 31, axis = j >> 4, i = (j & 15) >> 1;
    return h * 96 + 64 + axis * 16 + i + 8 * (j & 1);
}
__device__ __forceinline__ int ukv_col(int n, float& mul) { mul = 1.0f; if (n < 512) return (n >> 6) * 128 + (n & 63); const int r = n - 512; return (r >> 6) * 128 + 64 + (r & 63); }
__device__ __forceinline__ int ident_col(int n, float& mul) { mul = 1.0f; return n; }
__device__ __forceinline__ int up_col(int n, float& mul) { mul = 1.0f; const int pn = n >> 8, r = n & 255; return r < 128 ? pn * 128 + r : 1024 + pn * 128 + (r - 128); }

struct G1ColF { __device__ int operator()(int n, float& m) const { return g1_col(n, m); } };
struct UqColF { __device__ int operator()(int n, float& m) const { return uq_col(n, m); } };
struct UkvColF { __device__ int operator()(int n, float& m) const { return ukv_col(n, m); } };
struct IdColF { __device__ int operator()(int n, float& m) const { return ident_col(n, m); } };
struct G1ColF8 { __device__ int operator()(int n, float& m) const { return g1_col(n + 2560, m); } };
struct UpColF { __device__ int operator()(int n, float& m) const { return up_col(n, m); } };

__device__ __forceinline__ void cvt_experts(const PTab& p, char* ws, int G, int c) {
    const int tid = ltid(), lane = tid & 63, wid = __builtin_amdgcn_readfirstlane(tid >> 6);
    constexpr int NUP = 128 * 32, NIT = NUP + 128 * 16;
    for (int it = c; it < NIT; it += G) {
        const float* sp; unsigned char* dp; int ld;
        if (it < NUP) { const int mat = it >> 5, kt = it & 7, n = ((it >> 3) & 3) * 512 + wid * 64 + lane; float mul; const int sc = up_col(n, mul);
            sp = p.w_up() + ((size_t)mat * 1024 + kt * 128) * 2048 + sc; ld = 2048;
            dp = (unsigned char*)(ws + WS_W + (size_t)(mat >> 5) * WL_BYTES + WL_WUP) + (size_t)(mat & 31) * 2048 * 1024 + (size_t)n * 1024 + kt * 128; }
        else { const int i2 = it - NUP, mat = i2 >> 4, kt = i2 & 7, n = ((i2 >> 3) & 1) * 512 + wid * 64 + lane;
            sp = p.w_down() + ((size_t)mat * 1024 + kt * 128) * 1024 + n; ld = 1024;
            dp = (unsigned char*)(ws + WS_W + (size_t)(mat >> 5) * WL_BYTES + WL_WDN) + (size_t)(mat & 31) * 1024 * 1024 + (size_t)n * 1024 + kt * 128; }
        float v[128];
#pragma unroll
        for (int j = 0; j < 128; ++j) v[j] = sp[(size_t)j * ld];
#pragma unroll
        for (int q = 0; q < 8; ++q) { u32x4 w;
            w.x = cvt4_fp8s(v[16 * q] * W8_SCALE, v[16 * q + 1] * W8_SCALE, v[16 * q + 2] * W8_SCALE, v[16 * q + 3] * W8_SCALE);
            w.y = cvt4_fp8s(v[16 * q + 4] * W8_SCALE, v[16 * q + 5] * W8_SCALE, v[16 * q + 6] * W8_SCALE, v[16 * q + 7] * W8_SCALE);
            w.z = cvt4_fp8s(v[16 * q + 8] * W8_SCALE, v[16 * q + 9] * W8_SCALE, v[16 * q + 10] * W8_SCALE, v[16 * q + 11] * W8_SCALE);
            w.w = cvt4_fp8s(v[16 * q + 12] * W8_SCALE, v[16 * q + 13] * W8_SCALE, v[16 * q + 14] * W8_SCALE, v[16 * q + 15] * W8_SCALE);
            *(u32x4*)(dp + 16 * q) = w; }
    }
}

__device__ __forceinline__ void prologue_phase(const PTab& p, LAS unsigned char* lds, int G, int c) {
    const int tid = ltid();
    char* ws = p.ws();
    if (c == 0) {
        float* R = (float*)(ws + WS_ROPE);
        const int pos = tid >> 3, i = tid & 7;
        const float inv = powf(10000.0f, -(float)(2 * i) / 16.0f), ang = (float)pos * inv;
        R[tid * 2] = cosf(ang); R[tid * 2 + 1] = sinf(ang);
    }
    {
        bf16_t* DB = (bf16_t*)(ws + WS_DB);
        for (int i = c * 512 + tid; i < 512 * 512 / 8; i += G * 512) {
            const int r = i >> 6, q0 = (i & 63) * 8, k1 = r & 255; float v[8];
#pragma unroll
            for (int j = 0; j < 8; ++j) { const int q = q0 + j, t1 = q & 255; const int m = (k1 * t1) & 255; float s, co; sincospif((float)m * (1.0f / 128.0f), &s, &co);
                const float val = (r < 256) ? ((q < 256) ? co : s) : ((q < 256) ? s : -co); v[j] = val * (1.0f / 64.0f); }
            u32x4 w; w.x = cvt_pk_bf16(v[0], v[1]); w.y = cvt_pk_bf16(v[2], v[3]); w.z = cvt_pk_bf16(v[4], v[5]); w.w = cvt_pk_bf16(v[6], v[7]);
            *(u32x4*)(DB + (size_t)i * 8) = w;
        }
        float* TW = (float*)(ws + WS_TW);
        for (int i = c * 512 + tid; i < 16 * 256; i += G * 512) { const int k2 = i >> 8, t1 = i & 255; float s, co; sincospif((float)(k2 * t1) * (1.0f / 2048.0f), &s, &co); TW[2 * i] = co; TW[2 * i + 1] = s; }
        bf16_t* DC = (bf16_t*)(ws + WS_DFTC);
        for (int i = c * 512 + tid; i < 512 * 256 / 8; i += G * 512) {
            const int r = i >> 5, t0 = (i & 31) * 8, k = r & 255; float v[8];
#pragma unroll
            for (int j = 0; j < 8; ++j) { const int m = (k * (t0 + j)) & 255; float s, co; sincospif((float)m * (1.0f / 128.0f), &s, &co); v[j] = (r < 256 ? co : s) * (1.0f / 16.0f); }
            u32x4 w; w.x = cvt_pk_bf16(v[0], v[1]); w.y = cvt_pk_bf16(v[2], v[3]); w.z = cvt_pk_bf16(v[4], v[5]); w.w = cvt_pk_bf16(v[6], v[7]);
            *(u32x4*)(DC + (size_t)i * 8) = w;
        }
    }
#ifndef PRO_REP_D
#define PRO_REP_D 1
#endif
#ifndef PRO_REP_E
#define PRO_REP_E 1
#endif
    {
        for (int rep_ = 0; rep_ < PRO_REP_D; ++rep_) {
        LAS float* sl = (LAS float*)lds;
        LAS float* red = (LAS float*)(lds + 40960);
        { const float* cc = p.c(); const float* ccx = p.c_ctx();
          for (int i = tid; i < 9 * 1024; i += 512) { const int s = i >> 10, k = i & 1023; const float v = (s < 8) ? cc[s * 1024 + k] : ccx[k]; sl[i] = siluf_(v); } }
        __syncthreads();
        const float* wm = p.w_mod(); const float* bmod = p.b_mod();
        for (int job = c; job < DEPTH * 48; job += G) {
            const int l = job / 48, jl = tid & 127, kq = tid >> 7, j = (job % 48) * 128 + jl;
            const float* W = wm + (size_t)l * 1024 * 6144 + (size_t)(kq * 256) * 6144 + j;
            float a[9];
#pragma unroll
            for (int s = 0; s < 9; ++s) a[s] = 0.f;
            for (int k0 = 0; k0 < 256; k0 += 32) { float w[32];
#pragma unroll
                for (int q = 0; q < 32; ++q) w[q] = W[(size_t)(k0 + q) * 6144];
#pragma unroll
                for (int q4 = 0; q4 < 8; ++q4)
#pragma unroll
                    for (int s = 0; s < 9; ++s) { const f32x4 t = *(const LAS f32x4*)(sl + s * 1024 + kq * 256 + k0 + 4 * q4);
                        a[s] += t[0] * w[4 * q4] + t[1] * w[4 * q4 + 1] + t[2] * w[4 * q4 + 2] + t[3] * w[4 * q4 + 3]; } }
#pragma unroll
            for (int s = 0; s < 9; ++s) red[(kq * 9 + s) * 128 + jl] = a[s];
            __syncthreads();
            for (int i = tid; i < 9 * 128; i += 512) { const int s = i >> 7, jj = i & 127, col = (job % 48) * 128 + jj;
                ((float*)(ws + WS_MOD))[((size_t)l * 9 + s) * 6144 + col] = red[(0 * 9 + s) * 128 + jj] + red[(1 * 9 + s) * 128 + jj] + red[(2 * 9 + s) * 128 + jj] + red[(3 * 9 + s) * 128 + jj] + bmod[l * 6144 + col]; }
            __syncthreads();
        }
        }
    }
    {
        for (int rep_ = 0; rep_ < PRO_REP_E; ++rep_) {
        LAS float* TT = (LAS float*)lds;
        LAS float* tile = (LAS float*)(lds + 65536);
        const int kt = (c >> 4) & 15, jt = c & 15, part = kt >> 3;
        if (G % 256 == 0) {
            for (int i = tid; i < 128 * 128; i += 512) { const int m = i >> 7, cc = i & 127; float sn, co; sincospif((float)((m * cc) & 127) * (1.0f / 64.0f), &sn, &co); TT[i] = part ? sn : co; }
        }
        __syncthreads();
        for (int job = c; job < DEPTH * 256; job += G) {
            const int l = job >> 8;
            int kt_ = kt, jt_ = jt;
            if (G % 256 != 0) {
                kt_ = (job >> 4) & 15; jt_ = job & 15; const int pj = kt_ >> 3;
                __syncthreads();
                for (int i = tid; i < 128 * 128; i += 512) { const int m = i >> 7, cc = i & 127; float sn, co; sincospif((float)((m * cc) & 127) * (1.0f / 64.0f), &sn, &co); TT[i] = pj ? sn : co; }
                __syncthreads();
            }
            const int jl = tid & 63, kg = __builtin_amdgcn_readfirstlane(tid >> 6);
            const int kidx0 = kt_ * 64 + kg * 8, pj = kidx0 >> 9, g = (kidx0 >> 7) & 3, cc0 = kidx0 & 127;
            const float* W = p.w_br_fnet() + (size_t)l * 512 * 1024 + (size_t)(g * 128) * 1024 + jt_ * 64 + jl;
            float a[8];
#pragma unroll
            for (int q = 0; q < 8; ++q) a[q] = 0.f;
#pragma unroll
            for (int mh = 0; mh < 2; ++mh) {
                float w[64];
#pragma unroll
                for (int m = 0; m < 64; ++m) w[m] = W[(size_t)(mh * 64 + m) * 1024];
#pragma unroll
                for (int m = 0; m < 64; ++m) { const f32x4 t0 = *(const LAS f32x4*)(TT + (mh * 64 + m) * 128 + cc0), t1 = *(const LAS f32x4*)(TT + (mh * 64 + m) * 128 + cc0 + 4);
                    a[0] += w[m] * t0[0]; a[1] += w[m] * t0[1]; a[2] += w[m] * t0[2]; a[3] += w[m] * t0[3]; a[4] += w[m] * t1[0]; a[5] += w[m] * t1[1]; a[6] += w[m] * t1[2]; a[7] += w[m] * t1[3]; }
            }
            const float sc = (pj ? -1.0f : 1.0f) * 0.08838834764831845f;
#pragma unroll
            for (int q = 0; q < 8; ++q) tile[(kg * 8 + q) * 65 + jl] = a[q] * sc;
            __syncthreads();
            { unsigned char* dst = (unsigned char*)(ws + WS_W + (size_t)l * WL_BYTES + WL_WF);
              const int kp = tid & 15, nl0 = tid >> 4;
#pragma unroll
              for (int i = 0; i < 2; ++i) { const int nl = nl0 + 32 * i;
                  *(unsigned*)(dst + (size_t)(jt_ * 64 + nl) * 1024 + kt_ * 64 + 4 * kp) = cvt4_fp8s(tile[(4 * kp) * 65 + nl] * W8_SCALE, tile[(4 * kp + 1) * 65 + nl] * W8_SCALE, tile[(4 * kp + 2) * 65 + nl] * W8_SCALE, tile[(4 * kp + 3) * 65 + nl] * W8_SCALE); } }
            __syncthreads();
        }
        __syncthreads(); }
    }
    {
        unsigned ctr = 0;
        for (int l = 0; l < DEPTH; ++l) {
            char* wl = ws + WS_W + (size_t)l * WL_BYTES;
            cvt_tr(p.w_in() + (size_t)l * 1024 * INW, INW, 1024, (bf16_t*)(wl + WL_WIN), 1024, 2560, G1ColF(), nullptr, ctr, G, c);
            cvt_tr8(p.w_in() + (size_t)l * 1024 * INW, INW, (unsigned char*)(wl + WL_WIN8) + (size_t)2560 * 1024, 1024, G1N - 2560, G1ColF8(), W8_SCALE, ctr, G, c);
            cvt_tr(p.w_uq() + (size_t)l * 256 * 768, 768, 256, (bf16_t*)(wl + WL_WUQ), 256, 768, UqColF(), p.q_norm_g() + l * 256, ctr, G, c);
            cvt_tr(p.w_ukv() + (size_t)l * 128 * 1024, 1024, 128, (bf16_t*)(wl + WL_WUKV), 256, 1024, UkvColF(), p.kv_norm_g() + l * 128, ctr, G, c);
            cvt_tr8(p.w_br_mla() + (size_t)l * 512 * 1024, 1024, (unsigned char*)(wl + WL_WM), 512, 1024, IdColF(), W8_SCALE, ctr, G, c);
            cvt_tr8(p.w_br_gla() + (size_t)l * 512 * 1024, 1024, (unsigned char*)(wl + WL_WG), 512, 1024, IdColF(), W8_SCALE, ctr, G, c);
            cvt_tr8(p.w_o() + (size_t)l * 1024 * 1024, 1024, (unsigned char*)(wl + WL_WO), 1024, 1024, IdColF(), W8_SCALE, ctr, G, c);
        }
#ifndef PRO_REP_F
#define PRO_REP_F 1
#endif
        for (int rf_ = 0; rf_ < PRO_REP_F; ++rf_) cvt_experts(p, ws, G, c);
    }
}

__device__ __forceinline__ void norm_mod_row(const float* __restrict__ xrow, const float* __restrict__ g, const float* __restrict__ shift, const float* __restrict__ scale, bf16_t* __restrict__ hrow, unsigned char* __restrict__ h8row, int lane) {
    f32x4 v[4]; float ss = 0.f;
#pragma unroll
    for (int i = 0; i < 4; ++i) { v[i] = *(const f32x4*)(xrow + i * 256 + lane * 4); ss += v[i][0] * v[i][0] + v[i][1] * v[i][1] + v[i][2] * v[i][2] + v[i][3] * v[i][3]; }
    ss = wave_sum(ss);
    const float rs = rsqrtf(ss * (1.0f / 1024.0f) + EPS);
#pragma unroll
    for (int i = 0; i < 4; ++i) { const int col = i * 256 + lane * 4; const f32x4 gg = *(const f32x4*)(g + col), sh = *(const f32x4*)(shift + col), sc = *(const f32x4*)(scale + col);
        float o[4];
#pragma unroll
        for (int j = 0; j < 4; ++j) o[j] = v[i][j] * rs * gg[j] * (1.0f + sc[j]) + sh[j];
        u32x2 w; w.x = cvt_pk_bf16(o[0], o[1]); w.y = cvt_pk_bf16(o[2], o[3]); *(u32x2*)(hrow + col) = w; *(unsigned*)(h8row + col) = cvt4_fp8s(o[0], o[1], o[2], o[3]); }
}
__device__ __forceinline__ void norm1_phase(const PTab& p, int l, int G, int c) {
    const int tid_ = ltid(), wid = tid_ >> 6, lane = tid_ & 63; char* ws = p.ws();
    const float* px = p.x(); const float* pctx = p.ctx(); bf16_t* H = (bf16_t*)(ws + WS_H);
    const float* M = (const float*)(ws + WS_MOD) + (size_t)l * 9 * 6144; const float* n1g = p.norm1_g() + l * D;
    for (int row = c * 8 + wid; row < T; row += G * 8) {
        const int b = row / RPB, r = row % RPB, s = r < CTX ? 8 : b;
        const float* xrow = (r < CTX) ? pctx + (size_t)(b * CTX + r) * D : px + (size_t)(b * SEQ + (r - CTX)) * D;
        norm_mod_row(xrow, n1g, M + s * 6144, M + s * 6144 + 1024, H + (size_t)row * D, (unsigned char*)(ws + WS_HA8) + (size_t)row * D, lane);
    }
}

__device__ __forceinline__ void dft_stage_a(char* ws, int G, int c) {
    const int tid = ltid(), t1 = tid & 255, cc = tid >> 8;
    const bf16_t* UFT = (const bf16_t*)(ws + WS_UFT); bf16_t* HB = (bf16_t*)(ws + WS_DFTL); const f32x2* TW = (const f32x2*)(ws + WS_TW);
    constexpr float C16[9] = {1.0f, 0.9238795325f, 0.7071067812f, 0.3826834324f, 0.0f, -0.3826834324f, -0.7071067812f, -0.9238795325f, -1.0f};
    constexpr float S16[9] = {0.0f, 0.3826834324f, 0.7071067812f, 0.9238795325f, 1.0f, 0.9238795325f, 0.7071067812f, 0.3826834324f, 0.0f};
    f32x2 tw[16];
#pragma unroll
    for (int k2 = 0; k2 < 16; ++k2) tw[k2] = TW[k2 * 256 + t1];
    int it = c; if (it >= NB * 256) return;
    unsigned short ur[16];
    { const bf16_t* up = UFT + ((size_t)((it >> 8) * 512 + (it & 255) * 2 + cc)) * RPB + CTX + t1;
#pragma unroll
      for (int j = 0; j < 16; ++j) ur[j] = up[j * 256]; }
    for (;;) {
        const int nx = it + G; unsigned short un[16];
#pragma unroll
        for (int j = 0; j < 16; ++j) un[j] = ur[j];
        if (nx < NB * 256) { const bf16_t* up = UFT + ((size_t)((nx >> 8) * 512 + (nx & 255) * 2 + cc)) * RPB + CTX + t1;
#pragma unroll
            for (int j = 0; j < 16; ++j) un[j] = up[j * 256]; }
        const int b = it >> 8, ch = (it & 255) * 2 + cc;
        float u[16];
#pragma unroll
        for (int j = 0; j < 16; ++j) u[j] = bf2f(ur[j]);
        float sa[8], sb[8];
#pragma unroll
        for (int j = 1; j < 8; ++j) { sa[j] = u[j] + u[16 - j]; sb[j] = u[j] - u[16 - j]; }
        float re[9], im[9];
#pragma unroll
        for (int k2 = 0; k2 <= 8; ++k2) { float r = u[0] + ((k2 & 1) ? -u[8] : u[8]), m = 0.f;
#pragma unroll
            for (int j = 1; j < 8; ++j) { const int q = (k2 * j) & 15;
                const float cq = (q <= 8) ? C16[q] : C16[16 - q], sq = (q <= 8) ? S16[q] : -S16[16 - q];
                r += sa[j] * cq; m -= sb[j] * sq; }
            re[k2] = r; im[k2] = m; }
        bf16_t* hp = HB + ((size_t)b * 8192 + ch) * 512 + t1;
#pragma unroll
        for (int k2 = 0; k2 < 16; ++k2) { const float r = (k2 <= 8) ? re[k2] : re[16 - k2], m = (k2 <= 8) ? im[k2] : -im[16 - k2];
            const float r2 = r * tw[k2].x + m * tw[k2].y, i2 = m * tw[k2].x - r * tw[k2].y;
            hp[(size_t)k2 * 512 * 512] = f2bf(r2); hp[(size_t)k2 * 512 * 512 + 256] = f2bf(i2); }
        if (nx >= NB * 256) break;
#pragma unroll
        for (int j = 0; j < 16; ++j) ur[j] = un[j];
        it = nx;
    }
}
using gk::Unit; using gk::Acc;
__device__ __forceinline__ u32x4 pack8(const f32x4& a, const f32x4& b) { u32x4 w; w.x = cvt_pk_bf16(a[0], a[1]); w.y = cvt_pk_bf16(a[2], a[3]); w.z = cvt_pk_bf16(b[0], b[1]); w.w = cvt_pk_bf16(b[2], b[3]); return w; }
__device__ __forceinline__ u32x2 pack8f(const f32x4& a, const f32x4& b) { u32x2 w; w.x = cvt4_fp8(a[0], a[1], a[2], a[3]); w.y = cvt4_fp8(b[0], b[1], b[2], b[3]); return w; }
__device__ __forceinline__ u32x2 pack8fs(const f32x4& a, const f32x4& b) { u32x2 w; w.x = cvt4_fp8s(a[0], a[1], a[2], a[3]); w.y = cvt4_fp8s(b[0], b[1], b[2], b[3]); return w; }
__device__ __forceinline__ void unpack8(const u32x4& w, float (&f)[8]) { f[0] = bflo(w.x); f[1] = bfhi(w.x); f[2] = bflo(w.y); f[3] = bfhi(w.y); f[4] = bflo(w.z); f[5] = bfhi(w.z); f[6] = bflo(w.w); f[7] = bfhi(w.w); }
#define EROW(ai, m) (128 * (ai) + 64 * wr + 16 * (m) + fr)
#define ECOL(bj) (128 * (bj) + 32 * wc + 8 * fq)
#define EFENCE() asm volatile("" ::: "memory")
#ifndef EPI_GAP_N
#define EPI_GAP_N 0
#endif
#define EPI_GAP(ai, m) do { if ((ai) == 1 && (m) == 0 && EPI_GAP_N) { asm volatile("" ::: "memory"); __builtin_amdgcn_s_sleep(EPI_GAP_N); asm volatile("" ::: "memory"); } } while (0)
#ifndef EPI_NT
#define EPI_NT 0
#endif
#if EPI_NT
#define ST16(p, v) __builtin_nontemporal_store((v), (u32x4*)(p))
#else
#define ST16(p, v) (*(u32x4*)(p) = (v))
#endif

struct G1Sched {
    static constexpr bool GATHER = false, FP8 = false, COUNTED = false;
    const char* H; const char* W; int G, c;
    __device__ __forceinline__ bool next(int i, Unit& u) const {
        const int L = i * G + c; if (L >= NMT * 10) return false;
        int pm, pn; gk::tile_order(L, NMT, 10, pm, pn);
        u.nt = 16; u.lda2 = 2048u; u.ldb2 = 2048u;
        const char* a = H + (size_t)pm * 256 * 2048; const char* b = W + (size_t)pn * 256 * 2048;
        if (pn == 2 || pn == 3) { u.set(pm, pn, 0, 1, 0); u.A = b; u.B = a; } else { u.set(pm, pn, 0, 0, 0); u.A = a; u.B = b; }
        return true;
    }
};
struct G1Sched8 {
    static constexpr bool GATHER = false, FP8 = true, COUNTED = false;
    const char* H; const char* W; int G, c;
    __device__ __forceinline__ bool next(int i, Unit& u) const {
        const int L = i * G + c; if (L >= NMT * 12) return false;
        int pm, pn; gk::tile_order(L, NMT, 12, pm, pn); pn += 10;
        u.nt = 8; u.lda2 = 1024u; u.ldb2 = 1024u; u.set(pm, pn, 0, 0, 0);
        u.A = H + (size_t)pm * 256 * 1024; u.B = W + (size_t)pn * 256 * 1024; return true;
    }
};
struct G1EpiA {
    char* ws;
    __device__ __forceinline__ void operator()(Acc& acc, const Unit& u, int wr, int wc, int fr, int fq) const {
        const int pn = u.pn(), pm = u.pm;
        if (pn <= 1) {
            bf16_t* dst = (bf16_t*)(ws + (pn == 0 ? WS_UQ : WS_UKV)); float* ssq = (float*)(ws + WS_SSQ);
#pragma unroll
            for (int ai = 0; ai < 2; ++ai)
#pragma unroll
                for (int m = 0; m < 4; ++m) { const int row = pm * 256 + EROW(ai, m); bf16_t* rowp = dst + (size_t)row * 256; float s = 0.f;
#pragma unroll
                    for (int bj = 0; bj < 2; ++bj) { *(u32x4*)(rowp + ECOL(bj)) = pack8(acc[ai][bj][m][0], acc[ai][bj][m][1]);
                        if (pn == 1 && bj == 1) continue;
#pragma unroll
                        for (int n = 0; n < 2; ++n) { const f32x4 x = acc[ai][bj][m][n]; s += x[0] * x[0] + x[1] * x[1] + x[2] * x[2] + x[3] * x[3]; } }
                    s += lane_xor<16>(s, 0); s = half_sum32(s);
                    if (fq == 0) ssq[(size_t)row * 8 + pn * 4 + wc] = s; }
        } else if (pn >= 4) {
            size_t base; int ld, coff = 0;
            if (pn == 4) { base = WS_GQ; ld = 256; } else if (pn == 5) { base = WS_GK; ld = 256; } else if (pn < 8) { base = WS_GV; ld = 512; coff = (pn - 6) * 256; } else { base = WS_GOG; ld = 512; coff = (pn - 8) * 256; }
            bf16_t* dst = (bf16_t*)(ws + base);
#pragma unroll
            for (int ai = 0; ai < 2; ++ai)
#pragma unroll
                for (int m = 0; m < 4; ++m) { bf16_t* rowp = dst + (size_t)(pm * 256 + EROW(ai, m)) * ld + coff;
#pragma unroll
                    for (int bj = 0; bj < 2; ++bj) *(u32x4*)(rowp + ECOL(bj)) = pack8(acc[ai][bj][m][0], acc[ai][bj][m][1]); }
        } else {
            bf16_t* dst = (bf16_t*)(ws + WS_UFT); const int b = pm / 17, i0 = (pm % 17) * 256;
#pragma unroll
            for (int ai = 0; ai < 2; ++ai)
#pragma unroll
                for (int m = 0; m < 4; ++m) { const int ch = (pn - 2) * 256 + EROW(ai, m); bf16_t* rowp = dst + ((size_t)(b * 512 + ch)) * RPB + i0;
#pragma unroll
                    for (int bj = 0; bj < 2; ++bj) *(u32x4*)(rowp + ECOL(bj)) = pack8(acc[ai][bj][m][0], acc[ai][bj][m][1]); }
        }
    }
};
struct G1EpiB {
    char* ws;
    __device__ __forceinline__ void operator()(Acc& acc, const Unit& u, int wr, int wc, int fr, int fq) const {
        const int pn = u.pn(), pm = u.pm;
        unsigned char* g8 = (unsigned char*)(ws + WS_GATE); const int coff = (pn - 10) * 256;
#pragma unroll
        for (int ai = 0; ai < 2; ++ai)
#pragma unroll
            for (int m = 0; m < 4; ++m) { unsigned char* rowp = g8 + (size_t)(pm * 256 + EROW(ai, m)) * 3072 + coff;
#pragma unroll
                for (int bj = 0; bj < 2; ++bj) { f32x4 v0 = acc[ai][bj][m][0], v1 = acc[ai][bj][m][1];
#pragma unroll
                    for (int j = 0; j < 4; ++j) { v0[j] = fminf(__expf(-v0[j]), 448.0f); v1[j] = fminf(__expf(-v1[j]), 448.0f); }
                    u32x2 w8; w8.x = cvt4_fp8(v0[0], v0[1], v0[2], v0[3]); w8.y = cvt4_fp8(v1[0], v1[1], v1[2], v1[3]);
                    *(u32x2*)(rowp + ECOL(bj)) = w8; } }
    }
};

struct DftBSched {
    static constexpr bool GATHER = false, FP8 = false;
    char* ws; int G, c;
    __device__ __forceinline__ bool next(int i, Unit& u) const {
        const int L = i * G + c; if (L >= 512) return false;
        const int b = L >> 6, pm = (L >> 5) & 1, pn = L & 31;
        u.set(pm, pn, b, 10, 0); u.nt = 8; u.lda2 = 1024u; u.ldb2 = 1024u;
        u.A = ws + WS_DB + (size_t)pm * 256 * 1024; u.B = ws + WS_DFTL + ((size_t)b * 8192 + pn * 256) * 1024; return true;
    }
};
struct DftCSched {
    static constexpr bool GATHER = false, FP8 = false;
    char* ws; int G, c;
    __device__ __forceinline__ bool next(int i, Unit& u) const {
        const int L = i * G + c; if (L >= 32) return false;
        const int b = L >> 2, mt = (L >> 1) & 1, nn = L & 1;
        u.set(mt, nn, b, 11, 0); u.nt = 4; u.lda2 = 512u; u.ldb2 = (unsigned)RPB * 2u;
        u.A = ws + WS_DFTC + (size_t)mt * 256 * 512; u.B = ws + WS_UFT + ((size_t)(b * 512 + nn * 256) * RPB) * 2; return true;
    }
};
struct DftEpi {
    char* ws;
    __device__ __forceinline__ void operator()(Acc& acc, const Unit& u, int wr, int wc, int fr, int fq) const {
        unsigned char* P = (unsigned char*)(ws + WS_P); const int pm = u.pm, pn = u.pn(), b = u.aux();
#pragma unroll
        for (int ai = 0; ai < 2; ++ai)
#pragma unroll
            for (int bj = 0; bj < 2; ++bj)
#pragma unroll
                for (int m = 0; m < 4; ++m)
#pragma unroll
                    for (int j = 0; j < 4; ++j) { acc[ai][bj][m][0][j] = sat8(acc[ai][bj][m][0][j]); acc[ai][bj][m][1][j] = sat8(acc[ai][bj][m][1][j]); }
        if (u.kind() == 10) {
            const int k2 = pn >> 1, cb = (pn & 1) * 256;
#pragma unroll
            for (int ai = 0; ai < 2; ++ai)
#pragma unroll
                for (int m = 0; m < 4; ++m) { EPI_GAP(ai, m); unsigned char* rowp = P + (size_t)(b * RPB + CTX + 16 * EROW(ai, m) + k2) * 1024 + pm * 512 + cb;
#pragma unroll
                    for (int bj = 0; bj < 2; ++bj) *(u32x2*)(rowp + ECOL(bj)) = pack8f(acc[ai][bj][m][0], acc[ai][bj][m][1]); }
        } else {
#pragma unroll
            for (int ai = 0; ai < 2; ++ai)
#pragma unroll
                for (int m = 0; m < 4; ++m) { EPI_GAP(ai, m); unsigned char* rowp = P + (size_t)(b * RPB + EROW(ai, m)) * 1024 + pm * 512 + pn * 256;
#pragma unroll
                    for (int bj = 0; bj < 2; ++bj) *(u32x2*)(rowp + ECOL(bj)) = pack8f(acc[ai][bj][m][0], acc[ai][bj][m][1]); }
        }
    }
};
__device__ __forceinline__ float ssq_scale(const float* ssq, int row, int which, float inv_n) { const f32x4 s = *(const f32x4*)(ssq + (size_t)row * 8 + which * 4); return rsqrtf((s[0] + s[1] + s[2] + s[3]) * inv_n + EPS); }
struct QSched {
    static constexpr bool GATHER = false, FP8 = false;
    char* ws; const char* wl; int G, c;
    __device__ __forceinline__ bool next(int i, Unit& u) const {
        const int L = i * G + c; if (L >= NMT * 3) return false; const int pm = L / 3, pn = L % 3;
        u.set(pm, pn, 0, 12, 0); u.nt = 4; u.lda2 = 512u; u.ldb2 = 512u;
        u.A = ws + WS_UQ + (size_t)pm * 256 * 512; u.B = wl + WL_WUQ + (size_t)pn * 256 * 512; return true;
    }
};
struct QEpi {
    char* ws;
    __device__ __forceinline__ void operator()(Acc& acc, const Unit& u, int wr, int wc, int fr, int fq) const {
        const int pm = u.pm, pn = u.pn();
        const float* ssq = (const float*)(ws + WS_SSQ); bf16_t* Q = (bf16_t*)(ws + WS_Q); const f32x2* rope = (const f32x2*)(ws + WS_ROPE);
#pragma unroll
        for (int ai = 0; ai < 2; ++ai)
#pragma unroll
            for (int m = 0; m < 4; ++m) { EPI_GAP(ai, m); const int row = pm * 256 + EROW(ai, m); const float sc = ssq_scale(ssq, row, 0, 1.0f / 256.0f) * QSCALE;
                const int ib = row % RPB, tl = ib - CTX;
#pragma unroll
                for (int bj = 0; bj < 2; ++bj) { f32x4 v0 = acc[ai][bj][m][0] * sc, v1 = acc[ai][bj][m][1] * sc;
                    const int cc = ECOL(bj);
                    if (pn < 2) { const int col = pn * 256 + cc, h = col >> 6, d = col & 63; *(u32x4*)(Q + (size_t)row * 768 + h * 96 + d) = pack8(v0, v1); }
                    else { const int h = cc >> 5, axis = fq >> 1, i0 = 4 * (fq & 1);
                        if (tl >= 0) { const int pos = axis ? (tl & 63) : (tl >> 6);
                            const f32x2 r0 = rope[pos * 8 + i0], r1 = rope[pos * 8 + i0 + 1], r2 = rope[pos * 8 + i0 + 2], r3 = rope[pos * 8 + i0 + 3];
                            f32x4 o0, o1;
                            o0[0] = v0[0] * r0.x - v0[1] * r0.y; o0[1] = v0[1] * r0.x + v0[0] * r0.y; o0[2] = v0[2] * r1.x - v0[3] * r1.y; o0[3] = v0[3] * r1.x + v0[2] * r1.y;
                            o1[0] = v1[0] * r2.x - v1[1] * r2.y; o1[1] = v1[1] * r2.x + v1[0] * r2.y; o1[2] = v1[2] * r3.x - v1[3] * r3.y; o1[3] = v1[3] * r3.x + v1[2] * r3.y;
                            v0 = o0; v1 = o1; }
                        *(u32x4*)(Q + (size_t)row * 768 + h * 96 + 64 + 8 * fq) = pack8(v0, v1); } }
                EFENCE(); }
    }
};
struct KnSched {
    static constexpr bool GATHER = false, FP8 = false;
    char* ws; const char* wl; int G, c;
    __device__ __forceinline__ bool next(int i, Unit& u) const {
        const int L = i * G + c; if (L >= NMT * 2) return false; const int pm = L >> 1, pn = L & 1;
        u.set(pm, pn, 0, 13, 0); u.nt = 4; u.lda2 = 512u; u.ldb2 = 512u;
        u.A = ws + WS_UKV + (size_t)pm * 256 * 512; u.B = wl + WL_WUKV + (size_t)pn * 256 * 512; return true;
    }
};
struct KnEpi {
    char* ws;
    __device__ __forceinline__ void operator()(Acc& acc, const Unit& u, int wr, int wc, int fr, int fq) const {
        const float* ssq = (const float*)(ws + WS_SSQ); bf16_t* KN = (bf16_t*)(ws + WS_KN); const int pm = u.pm, pn = u.pn();
#pragma unroll
        for (int ai = 0; ai < 2; ++ai)
#pragma unroll
            for (int m = 0; m < 4; ++m) { EPI_GAP(ai, m); const int row = pm * 256 + EROW(ai, m); const float sc = ssq_scale(ssq, row, 1, 1.0f / 128.0f);
#pragma unroll
                for (int bj = 0; bj < 2; ++bj) *(u32x4*)(KN + (size_t)row * 512 + pn * 256 + ECOL(bj)) = pack8(acc[ai][bj][m][0] * sc, acc[ai][bj][m][1] * sc); }
    }
};
struct VtSched {
    static constexpr bool GATHER = false, FP8 = false;
    char* ws; const char* wl; int G, c;
    __device__ __forceinline__ bool next(int i, Unit& u) const {
        const int L = i * G + c; if (L >= NMT * 2) return false; const int pm = L >> 1, pn = L & 1;
        u.set(pm, pn, 0, 14, 0); u.nt = 4; u.lda2 = 512u; u.ldb2 = 512u;
        u.A = wl + WL_WUKV + (size_t)(2 + pn) * 256 * 512; u.B = ws + WS_UKV + (size_t)pm * 256 * 512; return true;
    }
};
struct VtEpi {
    char* ws;
    __device__ __forceinline__ void operator()(Acc& acc, const Unit& u, int wr, int wc, int fr, int fq) const {
        const float* ssq = (const float*)(ws + WS_SSQ); bf16_t* VT = (bf16_t*)(ws + WS_VT); const int pm = u.pm, pn = u.pn(), b = pm / 17, i0 = (pm % 17) * 256;
#pragma unroll
        for (int bj = 0; bj < 2; ++bj) { float sc[8];
#pragma unroll
            for (int j = 0; j < 8; ++j) sc[j] = ssq_scale(ssq, pm * 256 + ECOL(bj) + j, 1, 1.0f / 128.0f);
#pragma unroll
            for (int ai = 0; ai < 2; ++ai)
#pragma unroll
                for (int m = 0; m < 4; ++m) { EPI_GAP(ai, m); const int vc = pn * 256 + EROW(ai, m);
                    f32x4 v0 = acc[ai][bj][m][0], v1 = acc[ai][bj][m][1];
#pragma unroll
                    for (int j = 0; j < 4; ++j) { v0[j] *= sc[j]; v1[j] *= sc[4 + j]; }
                    { bf16_t* gp_ = VT + ((size_t)(b * 512 + vc)) * RPB + i0 + 128 * bj + 32 * wc + 16 * (fq >> 1) + 4 * (fq & 1);
                      u32x2 w0_, w1_; w0_.x = cvt_pk_bf16(v0[0], v0[1]); w0_.y = cvt_pk_bf16(v0[2], v0[3]); w1_.x = cvt_pk_bf16(v1[0], v1[1]); w1_.y = cvt_pk_bf16(v1[2], v1[3]);
                      *(u32x2*)gp_ = w0_; *(u32x2*)(gp_ + 8) = w1_; } }
            EFENCE(); }
    }
};


struct P2Sched {
    static constexpr bool GATHER = false, FP8 = false, COUNTED = false;
    char* ws; const char* wl; int l, G, c;
    __device__ __forceinline__ bool next(int i, Unit& u) const {
        int L = i * G + c; u.nt = 4;
        if (l < DEPTH - 1) { if (L < 32) { const int b = L >> 2, mt = (L >> 1) & 1, nn = L & 1;
                u.set(mt, nn, b, 11, 0); u.lda2 = 512u; u.ldb2 = (unsigned)RPB * 2u;
                u.A = ws + WS_DFTC + (size_t)mt * 256 * 512; u.B = ws + WS_UFT + ((size_t)(b * 512 + nn * 256) * RPB) * 2; return true; }
            L -= 32; }
        u.lda2 = 512u; u.ldb2 = 512u;
        if (L < NMT * 3) { const int pm = L / 3, pn = L % 3; u.set(pm, pn, 0, 12, 0);
            u.A = ws + WS_UQ + (size_t)pm * 256 * 512; u.B = wl + WL_WUQ + (size_t)pn * 256 * 512; return true; }
        L -= NMT * 3;
        if (L < NMT * 4) { const int pm = L >> 2, pn = L & 3; const char* a = ws + WS_UKV + (size_t)pm * 256 * 512; const char* b = wl + WL_WUKV + (size_t)pn * 256 * 512;
            if (pn < 2) { u.set(pm, pn, 0, 13, 0); u.A = a; u.B = b; } else { u.set(pm, pn - 2, 0, 14, 0); u.A = b; u.B = a; }
            return true; }
        return false;
    }
};
struct P2Epi {
    DftEpi D; QEpi Q; KnEpi K; VtEpi V;
    __device__ __forceinline__ void operator()(Acc& acc, const Unit& u, int wr, int wc, int fr, int fq) const {
        const int kind = u.kind();
        if (kind == 11) D(acc, u, wr, wc, fr, fq); else if (kind == 12) Q(acc, u, wr, wc, fr, fq); else if (kind == 13) K(acc, u, wr, wc, fr, fq); else V(acc, u, wr, wc, fr, fq);
    }
};
__device__ __forceinline__ int act_tile(int l, int at) { return (l < DEPTH - 1) ? at : at + at / 16 + 1; }
__device__ __forceinline__ int n_act_tiles(int l) { return (l < DEPTH - 1) ? NMT : NMT - NB; }
struct MergeSched {
    static constexpr bool GATHER = false, FP8 = true;
    char* ws; const char* wl; int l, G, c;
    __device__ __forceinline__ bool next(int i, Unit& u) const {
        const int seg = i % 3; int at, pn;
        if (G == 256) { const int x = c & 7, u = (i / 3) * 32 + (c >> 3); at = 8 * (u >> 2) + x; pn = u & 3; if (at >= n_act_tiles(l)) return false; }
        else { const int it = (i / 3) * G + c; if (it >= n_act_tiles(l) * 4) return false; at = it >> 2; pn = it & 3; }
        const int pm = act_tile(l, at);
        u.set(pm, pn, seg, 20, seg < 2 ? 1 : 0);
        if (seg == 0) { u.A = ws + WS_OMLA + (size_t)pm * 256 * 512; u.B = wl + WL_WM + (size_t)pn * 256 * 512; u.lda2 = 512u; u.ldb2 = 512u; u.nt = 4; }
        else if (seg == 1) { u.A = ws + WS_P + (size_t)pm * 256 * 1024; u.B = wl + WL_WF + (size_t)pn * 256 * 1024; u.lda2 = 1024u; u.ldb2 = 1024u; u.nt = 8; }
        else { u.A = ws + WS_OGLA + (size_t)pm * 256 * 512; u.B = wl + WL_WG + (size_t)pn * 256 * 512; u.lda2 = 512u; u.ldb2 = 512u; u.nt = 4; }
        return true;
    }
};
struct MergeEpi {
    char* ws; int dry;
    __device__ __forceinline__ void operator()(Acc& acc, const Unit& u, int wr, int wc, int fr, int fq) const {
        if (dry) return;
        const unsigned char* GT = (const unsigned char*)(ws + WS_GATE); unsigned char* Y = (unsigned char*)(ws + WS_Y); const int seg = u.aux(), pn = u.pn();
        const int oa = (seg < 2) ? seg * 1024 : 2048, ob = (seg < 2) ? (seg + 1) * 1024 : 2048;
#pragma unroll
        for (int ai = 0; ai < 2; ++ai) {
            u32x2 wa[4][2], wb[4][2];
#pragma unroll
            for (int m = 0; m < 4; ++m)
#pragma unroll
                for (int bj = 0; bj < 2; ++bj) { const unsigned char* gp = GT + (size_t)(u.pm * 256 + EROW(ai, m)) * 3072 + pn * 256 + ECOL(bj);
                    wa[m][bj] = *(const u32x2*)(gp + oa); wb[m][bj] = *(const u32x2*)(gp + ob); }
#pragma unroll
            for (int m = 0; m < 4; ++m) { const int row = u.pm * 256 + EROW(ai, m);
#pragma unroll
                for (int bj = 0; bj < 2; ++bj) { const int col = pn * 256 + ECOL(bj);
                    float a[8], b[8];
                    cvt_fp8x4(wa[m][bj].x, a[0], a[1], a[2], a[3]); cvt_fp8x4(wa[m][bj].y, a[4], a[5], a[6], a[7]); cvt_fp8x4(wb[m][bj].x, b[0], b[1], b[2], b[3]); cvt_fp8x4(wb[m][bj].y, b[4], b[5], b[6], b[7]);
                    f32x4& v0 = acc[ai][bj][m][0]; f32x4& v1 = acc[ai][bj][m][1];
                    if (seg < 2) {
#pragma unroll
                        for (int j = 0; j < 8; ++j) { const float f = (1.0f + b[j]) * __builtin_amdgcn_rcpf(1.0f + a[j]); if (j < 4) v0[j] *= f; else v1[j - 4] *= f; } }
                    else {
#pragma unroll
                        for (int j = 0; j < 8; ++j) { const float f = __builtin_amdgcn_rcpf(1.0f + a[j]); if (j < 4) v0[j] *= f; else v1[j - 4] *= f; } }
                    if (seg == 2) *(u32x2*)(Y + (size_t)row * 1024 + col) = pack8fs(v0, v1); } }
            EFENCE(); }
    }
};

struct WoSched {
    static constexpr bool GATHER = false, FP8 = true;
    char* ws; const char* wl; int l, G, c;
    __device__ __forceinline__ bool next(int i, Unit& u) const {
        int at, pn;
        if (G == 256) { const int x = c & 7, u = i * 32 + (c >> 3); at = 8 * (u >> 2) + x; pn = u & 3; if (at >= n_act_tiles(l)) return false; }
        else { const int it = i * G + c; if (it >= n_act_tiles(l) * 4) return false; at = it >> 2; pn = it & 3; }
        const int pm = act_tile(l, at);
        u.set(pm, pn, 0, 30, 0); u.nt = 8; u.lda2 = 1024u; u.ldb2 = 1024u;
        u.A = ws + WS_Y + (size_t)pm * 256 * 1024; u.B = wl + WL_WO + (size_t)pn * 256 * 1024; return true;
    }
};
struct WoEpi {
    char* ws; int l; int dry;
    const float* x_in; const float* ctx_in;
    __device__ __forceinline__ void operator()(Acc& acc, const Unit& u, int wr, int wc, int fr, int fq) const {
        bf16_t* X = (bf16_t*)(ws + WS_X); const int pn = u.pn(), s = (u.pm % 17 == 0) ? 8 : u.pm / 17;
        const float* g1 = (const float*)(ws + WS_MOD) + ((size_t)l * 9 + s) * 6144 + 2048;
        f32x4 gv[2][2];
#pragma unroll
        for (int bj = 0; bj < 2; ++bj) { const int col = pn * 256 + ECOL(bj); gv[bj][0] = *(const f32x4*)(g1 + col); gv[bj][1] = *(const f32x4*)(g1 + col + 4); }
#pragma unroll
        for (int ai = 0; ai < 2; ++ai) {
            f32x4 xv[4][2][2];
            if (l == 0) { const int b = u.pm / 17, j = u.pm % 17; const float* Xr = (j == 0) ? ctx_in + (size_t)b * 256 * 1024 : x_in + ((size_t)b * 4096 + (size_t)(j - 1) * 256) * 1024;
#pragma unroll
                for (int m = 0; m < 4; ++m) { const float* rowp = Xr + (size_t)EROW(ai, m) * 1024 + pn * 256;
#pragma unroll
                    for (int bj = 0; bj < 2; ++bj) { xv[m][bj][0] = *(const f32x4*)(rowp + ECOL(bj)); xv[m][bj][1] = *(const f32x4*)(rowp + ECOL(bj) + 4); } } }
            else { u32x4 xw[4][2];
#pragma unroll
                for (int m = 0; m < 4; ++m) { const bf16_t* rowp = X + (size_t)(u.pm * 256 + EROW(ai, m)) * 1024 + pn * 256;
#pragma unroll
                    for (int bj = 0; bj < 2; ++bj) xw[m][bj] = *(const u32x4*)(rowp + ECOL(bj)); }
#pragma unroll
                for (int m = 0; m < 4; ++m)
#pragma unroll
                    for (int bj = 0; bj < 2; ++bj) { const u32x4 w = xw[m][bj]; xv[m][bj][0] = (f32x4){bflo(w.x), bfhi(w.x), bflo(w.y), bfhi(w.y)}; xv[m][bj][1] = (f32x4){bflo(w.z), bfhi(w.z), bflo(w.w), bfhi(w.w)}; } }
#pragma unroll
            for (int m = 0; m < 4; ++m) { bf16_t* rowp = X + (size_t)(u.pm * 256 + EROW(ai, m)) * 1024 + pn * 256;
#pragma unroll
                for (int bj = 0; bj < 2; ++bj) { bf16_t* q = rowp + ECOL(bj);
                    const f32x4 r0 = xv[m][bj][0] + gv[bj][0] * acc[ai][bj][m][0], r1 = xv[m][bj][1] + gv[bj][1] * acc[ai][bj][m][1];
                    if (!dry) *(u32x4*)q = pack8(r0, r1); else asm volatile("" :: "v"(r0), "v"(r1)); } }
            EFENCE(); }
    }
};

struct MoeSched {
    static constexpr bool GATHER = false, FP8 = true;
    const char* A; const char* W; const LAS int* tb; int G, c; static constexpr int npn = 4; static constexpr size_t wstride = (size_t)1024 * 1024;
    __device__ __forceinline__ bool next(int i, Unit& u) const {
        const int total = __builtin_amdgcn_readfirstlane(tb[32]); int tg, pn;
        if (G == 256) { const int x = c & 7, s = c >> 3; tg = (i * 8 + x) * 8 + (s >> 2); pn = s & 3; if (tg >= total) return false; }
        else { const int L = i * G + c; if (L >= total * npn) return false; tg = L / npn; pn = L % npn; }
        int e = 0;
#pragma unroll
        for (int k = 16; k >= 1; k >>= 1) { const int v = __builtin_amdgcn_readfirstlane(tb[e + k]); if (v <= tg) e += k; }
        u.set(tg, pn, e, 40, 0); u.nt = 8; u.lda2 = 1024u; u.ldb2 = 1024u;
        u.A = A + (size_t)tg * 256 * 1024; u.B = W + (size_t)e * wstride + (size_t)pn * 256 * 1024; return true;
    }
};
struct MoeUpSched {
    static constexpr bool GATHER = true, FP8 = true; static constexpr int GPITCH = 1024;
    const char* gbase; const int* rt2; const char* W; const LAS int* tb; const LAS int* cn; int G, c;
    __device__ __forceinline__ bool next(int i, Unit& u) const {
        const int total = __builtin_amdgcn_readfirstlane(tb[32]); int tg, pn;
        if (G == 256) {
            const int x = c & 7, s = c >> 3; tg = (i * 8 + x) * 4 + (s >> 3); pn = s & 7; if (tg >= total) return false; }
        else { const int L = i * G + c; if (L >= total * 8) return false; tg = L >> 3; pn = L & 7; }
        int e = 0;
#pragma unroll
        for (int k = 16; k >= 1; k >>= 1) { const int v = __builtin_amdgcn_readfirstlane(tb[e + k]); if (v <= tg) e += k; }
        const int j = tg - __builtin_amdgcn_readfirstlane(tb[e]), n = __builtin_amdgcn_readfirstlane(cn[e]) - j * 256;
        u.set(tg, pn, e, 40, 0); u.nt = 8; u.lda2 = (unsigned)(n < 256 ? n : 256); u.ldb2 = 1024u;
        u.A = (const char*)(rt2 + (size_t)e * T + j * 256); u.B = W + (size_t)e * 2048 * 1024 + (size_t)pn * 256 * 1024; return true;
    }
};
struct UpEpi {
    char* ws; const float* b_up;
    __device__ __forceinline__ void operator()(Acc& acc, const Unit& u, int wr, int wc, int fr, int fq) const {
        unsigned char* ACT = (unsigned char*)(ws + WS_ACT); const float* bu = b_up + (size_t)u.aux() * 2048;
        const int cg = u.pn() * 128 + 32 * wc + 8 * fq;
        const f32x4 bg0 = *(const f32x4*)(bu + cg), bg1 = *(const f32x4*)(bu + cg + 4), bl0 = *(const f32x4*)(bu + 1024 + cg), bl1 = *(const f32x4*)(bu + 1024 + cg + 4);
#pragma unroll
        for (int ai = 0; ai < 2; ++ai)
#pragma unroll
            for (int m = 0; m < 4; ++m) { EPI_GAP(ai, m); f32x4 o[2];
#pragma unroll
                for (int n = 0; n < 2; ++n)
#pragma unroll
                    for (int j = 0; j < 4; ++j) { float gl = acc[ai][0][m][n][j] + (n ? bg1[j] : bg0[j]), li = acc[ai][1][m][n][j] + (n ? bl1[j] : bl0[j]);
                        gl = fminf(gl, 7.0f); li = __builtin_amdgcn_fmed3f(li, -7.0f, 7.0f);
                        const float sg = gl * __builtin_amdgcn_rcpf(1.0f + __builtin_amdgcn_exp2f(gl * -2.4554669595930156f));
                        o[n][j] = __builtin_fmaf(sg, li, sg); }
                u32x2 w8; w8.x = cvt4_fp8(o[0][0], o[0][1], o[0][2], o[0][3]); w8.y = cvt4_fp8(o[1][0], o[1][1], o[1][2], o[1][3]);
                *(u32x2*)(ACT + (size_t)(u.pm * 256 + EROW(ai, m)) * 1024 + cg) = w8; }
    }
};
struct DownEpi {
    char* ws; const float* b_down;
    __device__ __forceinline__ void operator()(Acc& acc, const Unit& u, int wr, int wc, int fr, int fq) const {
        unsigned char* YM = (unsigned char*)(ws + WS_YM); const float* bd = b_down + (size_t)u.aux() * 1024; const int pn = u.pn();
#pragma unroll
        for (int bj = 0; bj < 2; ++bj) { const int col = pn * 256 + ECOL(bj); const f32x4 bv0 = *(const f32x4*)(bd + col), bv1 = *(const f32x4*)(bd + col + 4);
#pragma unroll
            for (int ai = 0; ai < 2; ++ai)
#pragma unroll
                for (int m = 0; m < 4; ++m) { const f32x4 y0 = (acc[ai][bj][m][0] + bv0) * YM_SCALE, y1 = (acc[ai][bj][m][1] + bv1) * YM_SCALE; u32x2 w; w.x = cvt4_fp8s(y0[0], y0[1], y0[2], y0[3]); w.y = cvt4_fp8s(y1[0], y1[1], y1[2], y1[3]);
                    *(u32x2*)(YM + (size_t)(u.pm * 256 + EROW(ai, m)) * 1024 + col) = w; }
            EFENCE(); }
    }
};
namespace at {
constexpr int NSLOT = 4, KSLOT = 12288, VSLOT = 8192, OFF_V = NSLOT * KSLOT, OFF_WS = OFF_V + NSLOT * VSLOT, OFF_OST = OFF_WS + 8 * 256, LDS_NEED = OFF_OST + 8 * 4096;
__device__ __forceinline__ int crow(int r, int hi) { return (r & 3) + 8 * (r >> 2) + 4 * hi; }

__device__ __forceinline__ void attn_unit(char* ws, LAS unsigned char* lds, int b, int h, int qrow0, int nkt) {
    const int tid = ltid(), lane = tid & 63, r32 = lane & 31, hi = lane >> 5, wid = __builtin_amdgcn_readfirstlane(tid >> 6);
    const bf16_t* Q = (const bf16_t*)(ws + WS_Q); unsigned char* O = (unsigned char*)(ws + WS_OMLA);
    const size_t rowb = (size_t)b * RPB;
    const char* src[3]; unsigned inc[3], dsto[3];
#pragma unroll
    for (int j = 0; j < 3; ++j) {
        int pc = wid + 8 * j; if (pc >= 20) pc -= 8;
        if (pc < 8) { src[j] = ws + WS_KN + ((rowb + lane) * 512 + h * 64 + pc * 8) * 2; inc[j] = 64u * 1024u; dsto[j] = (unsigned)pc * 1024u; }
        else if (pc < 12) { src[j] = ws + WS_KR + ((rowb + lane) * 32 + (pc - 8) * 8) * 2; inc[j] = 64u * 64u; dsto[j] = (unsigned)pc * 1024u; }
        else { const int v = pc - 12, d = 8 * v + (lane >> 3), cl = lane & 7, lc = cl ^ ((d >> 1) & 7);
            src[j] = ws + WS_VT + (((size_t)(b * 8 + h) * 64 + d) * RPB + lc * 8) * 2; inc[j] = 128u; dsto[j] = (unsigned)(OFF_V + v * 1024); }
    }
#define AT_ISSUE(t, slot) do { _Pragma("unroll") for (int j = 0; j < 3; ++j) { \
        const unsigned so = (dsto[j] >= (unsigned)OFF_V) ? (unsigned)(slot) * VSLOT : (unsigned)(slot) * KSLOT; \
        __builtin_amdgcn_global_load_lds((const unsigned*)(src[j] + (size_t)(t) * inc[j]), (LAS unsigned*)(lds + dsto[j] + so), 16, 0, 0); } } while (0)
    const bf16_t* Qp = Q + (rowb + qrow0 + wid * 32 + r32) * 768 + h * 96 + hi * 8;
    bf16x8 qr[6];
#pragma unroll
    for (int d0 = 0; d0 < 6; ++d0) qr[d0] = *(const bf16x8*)(Qp + d0 * 16);
    f32x16 o0, o1, ol; const f32x16 zero16 = {0.f, 0.f, 0.f, 0.f, 0.f, 0.f, 0.f, 0.f, 0.f, 0.f, 0.f, 0.f, 0.f, 0.f, 0.f, 0.f};
#pragma unroll
    for (int r = 0; r < 16; ++r) { o0[r] = 0.f; o1[r] = 0.f; ol[r] = 0.f; }
    float m_run = 0.f;
    const u32x4 onesw = {0x3F803F80u, 0x3F803F80u, 0x3F803F80u, 0x3F803F80u};
    LAS float* wsf = (LAS float*)(lds + OFF_WS + wid * 256);
#define AT_QK(PD0, PD1, slot) do { const LAS unsigned char* ks_ = lds + (slot) * KSLOT + hi * 1024 + r32 * 16; \
        _Pragma("unroll") for (int d0 = 0; d0 < 6; ++d0) { \
            const bf16x8 k0 = *(const LAS bf16x8*)(ks_ + d0 * 2048), k1 = *(const LAS bf16x8*)(ks_ + d0 * 2048 + 512); \
            if (d0 == 0) { PD0 = __builtin_amdgcn_mfma_f32_32x32x16_bf16(k0, qr[0], zero16, 0, 0, 0); PD1 = __builtin_amdgcn_mfma_f32_32x32x16_bf16(k1, qr[0], zero16, 0, 0, 0); } \
            else { PD0 = __builtin_amdgcn_mfma_f32_32x32x16_bf16(k0, qr[d0], PD0, 0, 0, 0); PD1 = __builtin_amdgcn_mfma_f32_32x32x16_bf16(k1, qr[d0], PD1, 0, 0, 0); } } } while (0)
#define MX3(a, b, c) __builtin_fmaxf(__builtin_fmaxf((a), (b)), (c))
#define AT_STEP(PC0, PC1, PN0, PN1, t) do { \
        if ((t) + 2 < nkt) { asm volatile("s_waitcnt vmcnt(3)" ::: "memory"); } else { asm volatile("s_waitcnt vmcnt(0)" ::: "memory"); } \
        asm volatile("s_waitcnt lgkmcnt(0)" ::: "memory"); \
        __builtin_amdgcn_s_barrier(); asm volatile("" ::: "memory"); \
        if ((t) + 3 < nkt) AT_ISSUE((t) + 3, ((t) + 3) & 3); \
        if ((t) + 1 < nkt) AT_QK(PN0, PN1, ((t) + 1) & 3); \
        float ra = MX3(PC0[0], PC0[1], PC1[0]), rb = MX3(PC0[2], PC0[3], PC1[1]); ra = MX3(ra, PC1[2], PC1[3]); \
        _Pragma("unroll") for (int r = 4; r < 16; r += 4) { ra = MX3(ra, PC0[r], PC0[r + 1]); rb = MX3(rb, PC0[r + 2], PC0[r + 3]); ra = MX3(ra, PC1[r], PC1[r + 1]); rb = MX3(rb, PC1[r + 2], PC1[r + 3]); } \
        const float rm = half_max32(fmaxf(ra, rb));                            \
        const bool trig = ((t) == 0) ? __any(fabsf(rm) > 30.0f) : __any(rm - m_run > 30.0f); \
        if (trig) {                                                            \
            const float m_new = ((t) == 0) ? rm : fmaxf(m_run, rm), alpha = ((t) == 0) ? 1.0f : __builtin_amdgcn_exp2f(m_run - m_new); \
            m_run = m_new; \
            if (hi == 0) wsf[r32] = alpha; \
            asm volatile("s_waitcnt lgkmcnt(0)" ::: "memory"); \
            _Pragma("unroll") for (int r = 0; r < 16; ++r) { const float a_ = wsf[crow(r, hi)]; o0[r] *= a_; o1[r] *= a_; ol[r] *= a_; } \
            asm volatile("s_waitcnt lgkmcnt(0)" ::: "memory"); } \
        if (__any(m_run != 0.f)) { _Pragma("unroll") for (int r = 0; r < 16; ++r) { PC0[r] -= m_run; PC1[r] -= m_run; } }      \
        _Pragma("unroll") for (int r = 0; r < 16; ++r) { PC0[r] = __builtin_amdgcn_exp2f(PC0[r]); PC1[r] = __builtin_amdgcn_exp2f(PC1[r]); } \
        u32x4 pw[4]; \
        _Pragma("unroll") for (int k = 0; k < 4; ++k) { const int b0 = (k & 1) * 8; \
            if (k < 2) { pw[k].x = cvt_pk_bf16(PC0[b0], PC0[b0 + 1]); pw[k].y = cvt_pk_bf16(PC0[b0 + 2], PC0[b0 + 3]); pw[k].z = cvt_pk_bf16(PC0[b0 + 4], PC0[b0 + 5]); pw[k].w = cvt_pk_bf16(PC0[b0 + 6], PC0[b0 + 7]); } \
            else { pw[k].x = cvt_pk_bf16(PC1[b0], PC1[b0 + 1]); pw[k].y = cvt_pk_bf16(PC1[b0 + 2], PC1[b0 + 3]); pw[k].z = cvt_pk_bf16(PC1[b0 + 4], PC1[b0 + 5]); pw[k].w = cvt_pk_bf16(PC1[b0 + 6], PC1[b0 + 7]); } } \
        _Pragma("unroll") for (int d0 = 0; d0 < 2; ++d0) { \
            const int d = 32 * d0 + r32, swz = (d >> 1) & 7; \
            const LAS unsigned char* vrow = lds + OFF_V + ((t) & 3) * VSLOT + d * 128; \
            _Pragma("unroll") for (int k = 0; k < 4; ++k) { \
                const u32x4 vw = *(const LAS u32x4*)(vrow + (((2 * k + hi) ^ swz) * 16));     \
                if (d0 == 0) o0 = __builtin_amdgcn_mfma_f32_32x32x16_bf16(__builtin_bit_cast(bf16x8, pw[k]), __builtin_bit_cast(bf16x8, vw), o0, 0, 0, 0); \
                else         o1 = __builtin_amdgcn_mfma_f32_32x32x16_bf16(__builtin_bit_cast(bf16x8, pw[k]), __builtin_bit_cast(bf16x8, vw), o1, 0, 0, 0); } } \
        _Pragma("unroll") for (int k = 0; k < 4; ++k) ol = __builtin_amdgcn_mfma_f32_32x32x16_bf16(__builtin_bit_cast(bf16x8, pw[k]), __builtin_bit_cast(bf16x8, onesw), ol, 0, 0, 0); \
    } while (0)
    AT_ISSUE(0, 0); AT_ISSUE(1, 1); AT_ISSUE(2, 2);
    asm volatile("s_waitcnt vmcnt(6)" ::: "memory");
    __builtin_amdgcn_s_barrier(); asm volatile("" ::: "memory");
    f32x16 pA0, pA1, pB0, pB1;
    AT_QK(pA0, pA1, 0);
    for (int t = 0; t < nkt; t += 2) {
        AT_STEP(pA0, pA1, pB0, pB1, t);
        AT_STEP(pB0, pB1, pA0, pA1, t + 1);
    }
#undef AT_STEP
#undef AT_QK
#undef MX3
    asm volatile("s_waitcnt lgkmcnt(0)" ::: "memory");
    __builtin_amdgcn_s_barrier(); asm volatile("" ::: "memory");
    LAS bf16_t* stg = (LAS bf16_t*)(lds + OFF_OST + wid * 4096);
#pragma unroll
    for (int r = 0; r < 16; ++r) { const int q = crow(r, hi); const float rl = __builtin_amdgcn_rcpf(ol[r]);
        stg[q * 64 + r32] = f2bf(o0[r] * rl); stg[q * 64 + 32 + r32] = f2bf(o1[r] * rl); }
    asm volatile("s_waitcnt lgkmcnt(0)" ::: "memory");
    unsigned char* Ow = O + (rowb + qrow0 + wid * 32) * 512 + h * 64;
#pragma unroll
    for (int i = 0; i < 2; ++i) { const int row = i * 16 + (lane >> 2), ch = lane & 3; const u32x4 v0 = *(const LAS u32x4*)(stg + row * 64 + ch * 16), v1 = *(const LAS u32x4*)(stg + row * 64 + ch * 16 + 8);
        u32x4 w; w.x = cvt4_fp8s(bflo(v0.x), bfhi(v0.x), bflo(v0.y), bfhi(v0.y)); w.y = cvt4_fp8s(bflo(v0.z), bfhi(v0.z), bflo(v0.w), bfhi(v0.w));
        w.z = cvt4_fp8s(bflo(v1.x), bfhi(v1.x), bflo(v1.y), bfhi(v1.y)); w.w = cvt4_fp8s(bflo(v1.z), bfhi(v1.z), bflo(v1.w), bfhi(v1.w));
        *(u32x4*)(Ow + (size_t)row * 512 + ch * 16) = w; }
    asm volatile("s_waitcnt lgkmcnt(0)" ::: "memory");
#undef AT_ISSUE
}

__device__ __forceinline__ void attn_phase(char* ws, LAS unsigned char* lds, int l, int G, int c) {
    for (int i = 0; ; ++i) {
        int bh, qb;
        if (G == 256) { if (i >= 4) break; const int x = c & 7, s = c >> 3; bh = 16 * i + 2 * x + (s >> 4); qb = s & 15; }
        else { const int L = i * G + c; if (L >= 1024) break; bh = L >> 4; qb = L & 15; }
        attn_unit(ws, lds, bh >> 3, bh & 7, CTX + qb * 256, NCHUNK);
    }
    if (l < DEPTH - 1) for (int u = c; u < 64; u += G) attn_unit(ws, lds, u >> 3, u & 7, 0, 4);
}
}
namespace gla {
constexpr int LD = 72;
constexpr int GS = 65;
constexpr int O_GT = 0, O_UG = 33792, O_WGT4 = 116736, O_B4 = O_WGT4 + 32768, O_KST = 50688, O_QG = 50688, O_KG = 59904, O_VTL = 69120, O_STL = 87552, O_AM = 105984, O_EGM = 115200, OF_LD = 132;
typedef float LAS* lfp; typedef bf16_t LAS* lbp;

struct Pre { u32x4 ug; unsigned short kk[8]; unsigned short vv[16]; };

__device__ __forceinline__ void prefetch(const char* ws, int h, size_t row0, int tid, Pre& P) {
    if (tid < 256) P.ug = *(const u32x4*)((const bf16_t*)(ws + WS_UKV) + (row0 + (tid >> 2)) * 256 + 160 + (tid & 3) * 8);
    { const int d = tid & 63, sg = tid >> 6; const bf16_t* kp = (const bf16_t*)(ws + WS_GK) + (row0 + sg * 8) * 256 + h * 64 + d;
#pragma unroll
      for (int j = 0; j < 8; ++j) P.kk[j] = kp[(size_t)j * 256]; }
    { const int e = tid & 127, sq = tid >> 7; const bf16_t* vp = (const bf16_t*)(ws + WS_GV) + (row0 + sq * 16) * 512 + h * 128 + e;
#pragma unroll
      for (int j = 0; j < 16; ++j) P.vv[j] = vp[(size_t)j * 512]; }
}
__device__ __forceinline__ void put_vt(const Pre& P, int tid, LAS unsigned char* lds) {
    lbp VTL = (lbp)(lds + O_VTL); const int e = tid & 127, sq = tid >> 7;
    u32x4 w0, w1;
    w0.x = P.vv[0] | ((unsigned)P.vv[1] << 16); w0.y = P.vv[2] | ((unsigned)P.vv[3] << 16); w0.z = P.vv[4] | ((unsigned)P.vv[5] << 16); w0.w = P.vv[6] | ((unsigned)P.vv[7] << 16);
    w1.x = P.vv[8] | ((unsigned)P.vv[9] << 16); w1.y = P.vv[10] | ((unsigned)P.vv[11] << 16); w1.z = P.vv[12] | ((unsigned)P.vv[13] << 16); w1.w = P.vv[14] | ((unsigned)P.vv[15] << 16);
    *(LAS u32x4*)(VTL + e * LD + sq * 16) = w0; *(LAS u32x4*)(VTL + e * LD + sq * 16 + 8) = w1;
}

__device__ __forceinline__ void load_gate_weights(const PTab& p, int l, LAS unsigned char* lds) {
    const int tid = ltid(); lfp W4 = (lfp)(lds + O_WGT4); lfp B4 = (lfp)(lds + O_B4);
    const float* wgf = p.w_gf(); const float* wgb = p.w_gb(); const float* bgf = p.b_gf(); const float* bgb = p.b_gb();
    for (int i = tid; i < 8192; i += 512) { const int h = i >> 11, dir = (i >> 10) & 1, r = (i >> 6) & 15, d = i & 63; W4[i] = (dir ? wgb : wgf)[((size_t)l * 16 + r) * 256 + h * 64 + d]; }
    { const int h = tid >> 7, dir = (tid >> 6) & 1, d = tid & 63; B4[tid] = (dir ? bgb : bgf)[l * 256 + h * 64 + d]; }
    __syncthreads();
}
__device__ __forceinline__ void gates(int h, const Pre& P, int tid, LAS unsigned char* lds) {
    lfp GT = (lfp)(lds + O_GT); lfp UG = (lfp)(lds + O_UG); lfp WGT = (lfp)(lds + O_WGT4) + h * 2048; lfp BS = (lfp)(lds + O_B4) + h * 128;
    if (tid < 256) { const int s = tid >> 2, q = tid & 3, dir = q >> 1, r0 = (q & 1) * 8; float f[8]; unpack8(P.ug, f);
#pragma unroll
        for (int j = 0; j < 8; ++j) UG[(dir * 64 + s) * 16 + r0 + j] = f[j]; }
    __syncthreads();
    { const int d = tid & 63, sg = tid >> 6;
#pragma unroll
      for (int dir = 0; dir < 2; ++dir) {
          float w[16];
#pragma unroll
          for (int r = 0; r < 16; ++r) w[r] = WGT[(dir * 16 + r) * 64 + d];
          const float bias = BS[dir * 64 + d];
#pragma unroll
          for (int j = 0; j < 8; ++j) { const int s = sg * 8 + j; float z = bias;
#pragma unroll
              for (int r4 = 0; r4 < 4; ++r4) { const f32x4 u = *(const LAS f32x4*)(UG + (dir * 64 + s) * 16 + r4 * 4); z += u[0] * w[4 * r4] + u[1] * w[4 * r4 + 1] + u[2] * w[4 * r4 + 2] + u[3] * w[4 * r4 + 3]; }
              const float ls = fminf(z, 0.f) - __logf(1.0f + __expf(-fabsf(z)));
              GT[(dir * 64 + d) * GS + s] = ls * (1.0f / 16.0f); } } }
    __syncthreads();
    { const int lane = tid & 63, w = tid >> 6;
#pragma unroll
      for (int i = 0; i < 16; ++i) { const int r = w * 16 + i; const float v0 = GT[r * GS + lane]; float v = v0;
          v += __builtin_bit_cast(float, __builtin_amdgcn_update_dpp(0, __builtin_bit_cast(int, v), 0x111, 0xf, 0xf, true));
          v += __builtin_bit_cast(float, __builtin_amdgcn_update_dpp(0, __builtin_bit_cast(int, v), 0x112, 0xf, 0xf, true));
          v += __builtin_bit_cast(float, __builtin_amdgcn_update_dpp(0, __builtin_bit_cast(int, v), 0x114, 0xf, 0xf, true));
          v += __builtin_bit_cast(float, __builtin_amdgcn_update_dpp(0, __builtin_bit_cast(int, v), 0x118, 0xf, 0xf, true));
          v += __builtin_bit_cast(float, __builtin_amdgcn_update_dpp(0, __builtin_bit_cast(int, v), 0x142, 0xa, 0xf, false));
          v += __builtin_bit_cast(float, __builtin_amdgcn_update_dpp(0, __builtin_bit_cast(int, v), 0x143, 0xc, 0xf, false));
          if (r >= 64) { const float tot = __builtin_bit_cast(float, __builtin_amdgcn_readlane(__builtin_bit_cast(int, v), 63)); v = tot - v + v0; }
          GT[r * GS + lane] = v; } }
    __syncthreads();
}

__device__ __forceinline__ void g1_compute(char* ws, int b, int h, int blk, const Pre& P, int tid, LAS unsigned char* lds) {
    const int lane = tid & 63, wid = tid >> 6, fr = lane & 15, fq = lane >> 4;
    gates(h, P, tid, lds);
    lfp GT = (lfp)(lds + O_GT); lbp KST = (lbp)(lds + O_KST); lbp VTL = (lbp)(lds + O_VTL);
    { const int d = tid & 63, sg = tid >> 6;
#pragma unroll
      for (int dir = 0; dir < 2; ++dir) { const float gl = GT[(dir * 64 + d) * GS + (dir ? 0 : 63)]; float o[8];
#pragma unroll
          for (int j = 0; j < 8; ++j) o[j] = bf2f(P.kk[j]) * __expf(gl - GT[(dir * 64 + d) * GS + sg * 8 + j]);
          u32x4 w; w.x = cvt_pk_bf16(o[0], o[1]); w.y = cvt_pk_bf16(o[2], o[3]); w.z = cvt_pk_bf16(o[4], o[5]); w.w = cvt_pk_bf16(o[6], o[7]);
          *(LAS u32x4*)(KST + (dir * 64 + d) * LD + sg * 8) = w; } }
    put_vt(P, tid, lds);
    { const int s8 = tid >> 3, dg = tid & 7; unsigned short* gg = (unsigned short*)(ws + WS_GG) + ((size_t)b * RPB + blk * 64 + s8) * 512 + h * 64 + dg * 8;
#pragma unroll
      for (int dir = 0; dir < 2; ++dir) { f32x4 a, c4;
#pragma unroll
          for (int j = 0; j < 4; ++j) { a[j] = GT[(dir * 64 + dg * 8 + j) * GS + s8]; c4[j] = GT[(dir * 64 + dg * 8 + 4 + j) * GS + s8]; }
          u32x4 w; w.x = pk_f16(a[0], a[1]); w.y = pk_f16(a[2], a[3]); w.z = pk_f16(c4[0], c4[1]); w.w = pk_f16(c4[2], c4[3]);
          *(u32x4*)(gg + dir * 256) = w; } }
    const size_t item = ((size_t)(b * 4 + h) * 2) * NCHUNK;
    if (tid < 128) { const int dir = tid >> 6, d = tid & 63; ((float*)(ws + WS_DEC))[(item + dir * NCHUNK + blk) * 64 + d] = __expf(GT[(dir * 64 + d) * GS + (dir ? 0 : 63)]); }
    __syncthreads();
#pragma unroll
    for (int dir = 0; dir < 2; ++dir) {
        bf16_t* kv = (bf16_t*)(ws + WS_KVS) + (item + dir * NCHUNK + blk) * 8192;
#pragma unroll
        for (int db = 0; db < 4; ++db) { f32x4 acc = {0.f, 0.f, 0.f, 0.f};
#pragma unroll
            for (int ks = 0; ks < 2; ++ks) { const bf16x8 a = *(const LAS bf16x8*)(KST + (dir * 64 + db * 16 + fr) * LD + ks * 32 + 8 * fq), bb = *(const LAS bf16x8*)(VTL + (wid * 16 + fr) * LD + ks * 32 + 8 * fq);
                acc = __builtin_amdgcn_mfma_f32_16x16x32_bf16(a, bb, acc, 0, 0, 0); }
            u32x2 w; w.x = cvt_pk_bf16(acc[0], acc[1]); w.y = cvt_pk_bf16(acc[2], acc[3]);
            *(u32x2*)(kv + (wid * 16 + fr) * 64 + db * 16 + 4 * fq) = w; } }
    __syncthreads();
}

__device__ __forceinline__ void g2_item(char* ws, int ch, int sl) {
    const int tid = ltid(), e = sl * 32 + (tid >> 4), d4 = (tid & 15) * 4, dir = ch & 1;
    bf16_t* KV = (bf16_t*)(ws + WS_KVS) + (size_t)ch * NCHUNK * 8192 + e * 64 + d4; const float* DEC = (const float*)(ws + WS_DEC) + (size_t)ch * NCHUNK * 64 + d4;
    f32x4 S = {0.f, 0.f, 0.f, 0.f};
#pragma unroll 4
    for (int cp = 0; cp < NCHUNK; ++cp) { const int blk = dir ? (cp < 4 ? 3 - cp : 71 - cp) : cp;
        u32x2* ptr = (u32x2*)(KV + (size_t)blk * 8192); const u32x2 kvw = *ptr; const f32x4 dec = *(const f32x4*)(DEC + blk * 64);
        u32x2 sw; sw.x = cvt_pk_bf16(S[0], S[1]); sw.y = cvt_pk_bf16(S[2], S[3]); *ptr = sw;
        S[0] = dec[0] * S[0] + bflo(kvw.x); S[1] = dec[1] * S[1] + bfhi(kvw.x); S[2] = dec[2] * S[2] + bflo(kvw.y); S[3] = dec[3] * S[3] + bfhi(kvw.y); }
}

constexpr int O3_QG = 0, O3_KG = 18432, O3_VTL = 36864, O3_STL = 55296, O3_AM = 92160, O3_OF = 0;
struct Pre3 { unsigned short vv[16]; u32x4 qw, kw, sw[2][2], og0, og1, gg[2]; };
__device__ __forceinline__ void g3_load(const char* ws, int b, int h, int blk, int tid, Pre3& R) {
    const size_t row0 = (size_t)b * RPB + blk * 64; const size_t item = ((size_t)(b * 4 + h) * 2) * NCHUNK; const int s8 = tid >> 3, dg = tid & 7;
    { const int e = tid & 127, sq = tid >> 7; const bf16_t* vp = (const bf16_t*)(ws + WS_GV) + (row0 + sq * 16) * 512 + h * 128 + e;
#pragma unroll
      for (int j = 0; j < 16; ++j) R.vv[j] = vp[(size_t)j * 512]; }
    R.qw = *(const u32x4*)((const bf16_t*)(ws + WS_GQ) + (row0 + s8) * 256 + h * 64 + dg * 8);
    R.kw = *(const u32x4*)((const bf16_t*)(ws + WS_GK) + (row0 + s8) * 256 + h * 64 + dg * 8);
#pragma unroll
    for (int dir = 0; dir < 2; ++dir) { const bf16_t* sp = (const bf16_t*)(ws + WS_KVS) + (item + dir * NCHUNK + blk) * 8192 + (tid >> 2) * 64 + (tid & 3) * 16; R.sw[dir][0] = *(const u32x4*)sp; R.sw[dir][1] = *(const u32x4*)(sp + 8);
        const unsigned short* gp = (const unsigned short*)(ws + WS_GG) + (row0 + s8) * 512 + dir * 256 + h * 64 + dg * 8; R.gg[dir] = *(const u32x4*)gp; }
    const bf16_t* ogp = (const bf16_t*)(ws + WS_GOG) + (row0 + s8) * 512 + h * 128 + dg * 16;
    R.og0 = *(const u32x4*)ogp; R.og1 = *(const u32x4*)(ogp + 8);
}
__device__ __forceinline__ void g3_compute(char* ws, const float* norm_g, int b, int h, int blk, const Pre3& R, int tid, LAS unsigned char* lds) {
    const int lane = tid & 63, wid = tid >> 6, fr = lane & 15, fq = lane >> 4, s8 = tid >> 3, dg = tid & 7;
    const size_t row0 = (size_t)b * RPB + blk * 64;
    lbp QG = (lbp)(lds + O3_QG); lbp KG = (lbp)(lds + O3_KG); lbp VTL = (lbp)(lds + O3_VTL); lbp STL = (lbp)(lds + O3_STL); lbp AM = (lbp)(lds + O3_AM);
    { const int e = tid & 127, sq = tid >> 7; u32x4 w0, w1;
      w0.x = R.vv[0] | ((unsigned)R.vv[1] << 16); w0.y = R.vv[2] | ((unsigned)R.vv[3] << 16); w0.z = R.vv[4] | ((unsigned)R.vv[5] << 16); w0.w = R.vv[6] | ((unsigned)R.vv[7] << 16);
      w1.x = R.vv[8] | ((unsigned)R.vv[9] << 16); w1.y = R.vv[10] | ((unsigned)R.vv[11] << 16); w1.z = R.vv[12] | ((unsigned)R.vv[13] << 16); w1.w = R.vv[14] | ((unsigned)R.vv[15] << 16);
      *(LAS u32x4*)(VTL + e * LD + sq * 16) = w0; *(LAS u32x4*)(VTL + e * LD + sq * 16 + 8) = w1; }
    { float qf[8], kf[8]; unpack8(R.qw, qf); unpack8(R.kw, kf);
#pragma unroll
      for (int dir = 0; dir < 2; ++dir) { float qo[8], ko[8];
          float gf[8]; un_f16(R.gg[dir].x, gf[0], gf[1]); un_f16(R.gg[dir].y, gf[2], gf[3]); un_f16(R.gg[dir].z, gf[4], gf[5]); un_f16(R.gg[dir].w, gf[6], gf[7]);
#pragma unroll
          for (int j = 0; j < 8; ++j) { const float g = gf[j]; qo[j] = qf[j] * __expf(g); ko[j] = kf[j] * __expf(-g); }
          u32x4 w; w.x = cvt_pk_bf16(qo[0], qo[1]); w.y = cvt_pk_bf16(qo[2], qo[3]); w.z = cvt_pk_bf16(qo[4], qo[5]); w.w = cvt_pk_bf16(qo[6], qo[7]); *(LAS u32x4*)(QG + (dir * 64 + s8) * LD + dg * 8) = w;
          w.x = cvt_pk_bf16(ko[0], ko[1]); w.y = cvt_pk_bf16(ko[2], ko[3]); w.z = cvt_pk_bf16(ko[4], ko[5]); w.w = cvt_pk_bf16(ko[6], ko[7]); *(LAS u32x4*)(KG + (dir * 64 + s8) * LD + dg * 8) = w;
          const int e = tid >> 2, dq = tid & 3;
          *(LAS u32x4*)(STL + (dir * 128 + e) * LD + dq * 16) = R.sw[dir][0]; *(LAS u32x4*)(STL + (dir * 128 + e) * LD + dq * 16 + 8) = R.sw[dir][1]; } }
    __syncthreads();
#pragma unroll
    for (int dir = 0; dir < 2; ++dir) { const int tb = wid >> 1;
#pragma unroll
        for (int q = 0; q < 2; ++q) { const int sb = (wid & 1) * 2 + q; f32x4 a4 = {0.f, 0.f, 0.f, 0.f};
            const bool live = dir ? (sb >= tb) : (sb <= tb);
            if (live) {
#pragma unroll
                for (int ks = 0; ks < 2; ++ks) { const bf16x8 a = *(const LAS bf16x8*)(KG + (dir * 64 + sb * 16 + fr) * LD + ks * 32 + 8 * fq), bb = *(const LAS bf16x8*)(QG + (dir * 64 + tb * 16 + fr) * LD + ks * 32 + 8 * fq);
                    a4 = __builtin_amdgcn_mfma_f32_16x16x32_bf16(a, bb, a4, 0, 0, 0); } }
            const int t = tb * 16 + fr, s0 = sb * 16 + 4 * fq;
#pragma unroll
            for (int j = 0; j < 4; ++j) { const int s = s0 + j; const bool keep = dir ? (s >= t) : (s <= t); if (!keep) a4[j] = 0.f; }
            u32x2 w; w.x = cvt_pk_bf16(a4[0], a4[1]); w.y = cvt_pk_bf16(a4[2], a4[3]); *(LAS u32x2*)(AM + (dir * 64 + t) * LD + s0) = w; } }
    __syncthreads();
    f32x4 acc[4];
#pragma unroll
    for (int i = 0; i < 4; ++i) acc[i] = (f32x4){0.f, 0.f, 0.f, 0.f};
#pragma unroll
    for (int dir = 0; dir < 2; ++dir)
#pragma unroll
        for (int tb = 0; tb < 4; ++tb) {
#pragma unroll
            for (int ks = 0; ks < 2; ++ks) { const bf16x8 a = *(const LAS bf16x8*)(VTL + (wid * 16 + fr) * LD + ks * 32 + 8 * fq), bb = *(const LAS bf16x8*)(AM + (dir * 64 + tb * 16 + fr) * LD + ks * 32 + 8 * fq);
                acc[tb] = __builtin_amdgcn_mfma_f32_16x16x32_bf16(a, bb, acc[tb], 0, 0, 0); }
#pragma unroll
            for (int ks = 0; ks < 2; ++ks) { const bf16x8 a = *(const LAS bf16x8*)(STL + (dir * 128 + wid * 16 + fr) * LD + ks * 32 + 8 * fq), bb = *(const LAS bf16x8*)(QG + (dir * 64 + tb * 16 + fr) * LD + ks * 32 + 8 * fq);
                acc[tb] = __builtin_amdgcn_mfma_f32_16x16x32_bf16(a, bb, acc[tb], 0, 0, 0); } }
    __syncthreads();
    lfp OF = (lfp)(lds + O3_OF);
#pragma unroll
    for (int tb = 0; tb < 4; ++tb) *(LAS f32x4*)(OF + (tb * 16 + fr) * OF_LD + wid * 16 + 4 * fq) = acc[tb];
    __syncthreads();
    { const int t = s8, part = dg; float o[16]; float ss = 0.f;
#pragma unroll
      for (int j = 0; j < 4; ++j) { const f32x4 v = *(const LAS f32x4*)(OF + t * OF_LD + part * 16 + j * 4); o[4 * j] = v[0]; o[4 * j + 1] = v[1]; o[4 * j + 2] = v[2]; o[4 * j + 3] = v[3]; ss += v[0] * v[0] + v[1] * v[1] + v[2] * v[2] + v[3] * v[3]; }
      ss += lane_xor<1>(ss, 0); ss += lane_xor<2>(ss, 0); ss += lane_xor<4>(ss, 0);
      const float rs = rsqrtf(ss * (1.0f / 128.0f) + EPS);
      const float* ng = norm_g + h * 128 + part * 16;
      unsigned char* dst = (unsigned char*)(ws + WS_OGLA) + (row0 + t) * 512 + h * 128 + part * 16;
#pragma unroll
      for (int hh = 0; hh < 2; ++hh) { float g[8]; unpack8(hh ? R.og1 : R.og0, g); float r[8];
#pragma unroll
          for (int j = 0; j < 8; ++j) r[j] = o[hh * 8 + j] * rs * ng[hh * 8 + j] * siluf_(g[j]);
          u32x2 w; w.x = cvt4_fp8s(r[0], r[1], r[2], r[3]); w.y = cvt4_fp8s(r[4], r[5], r[6], r[7]); *(u32x2*)(dst + hh * 8) = w; } }
    __syncthreads();
}

__device__ __forceinline__ void g1_phase(const PTab& p, int l, LAS unsigned char* lds, int G, int c) {
    char* ws = p.ws(); const int tid = ltid(); constexpr int NIT = NB * 4 * NCHUNK;
    load_gate_weights(p, l, lds);
    int it = c; if (it >= NIT) return;
    Pre cur; prefetch(ws, (it / NCHUNK) & 3, (size_t)(it / (4 * NCHUNK)) * RPB + (it % NCHUNK) * 64, tid, cur);
    for (;;) { const int nx = it + G; Pre nxt = cur;
        if (nx < NIT) prefetch(ws, (nx / NCHUNK) & 3, (size_t)(nx / (4 * NCHUNK)) * RPB + (nx % NCHUNK) * 64, tid, nxt);
        g1_compute(ws, it / (4 * NCHUNK), (it / NCHUNK) & 3, it % NCHUNK, cur, tid, lds);
        if (nx >= NIT) break; cur = nxt; it = nx; }
}
__device__ __forceinline__ void g3_phase(const PTab& p, int l, LAS unsigned char* lds, int G, int c) {
    char* ws = p.ws(); const int tid = ltid(); const float* ng = p.gla_norm_g() + l * 512;
    const int nblk = (l == DEPTH - 1) ? 64 : NCHUNK, blk0 = NCHUNK - nblk, NIT = NB * 4 * nblk;
    int it = c; if (it >= NIT) return;
    Pre3 cur; g3_load(ws, it / (4 * nblk), (it / nblk) & 3, blk0 + it % nblk, tid, cur);
    for (;;) { const int nx = it + G; Pre3 nxt = cur;
        if (nx < NIT) g3_load(ws, nx / (4 * nblk), (nx / nblk) & 3, blk0 + nx % nblk, tid, nxt);
        g3_compute(ws, ng, it / (4 * nblk), (it / nblk) & 3, blk0 + it % nblk, cur, tid, lds);
        if (nx >= NIT) break; cur = nxt; it = nx; }
}
}
namespace moe {
constexpr int A_LG = LDS_AUX + 1024, A_HIST = LDS_AUX + 5120, A_BASE = LDS_AUX + 5248, A_TB = LDS_AUX + 5376, A_CN = LDS_AUX + 5632, A_RANK = LDS_AUX + 6144;
constexpr int RWS = 1028;
__device__ __forceinline__ int n_act_rows(int l) { return (l < DEPTH - 1) ? T : NB * SEQ; }
__device__ __forceinline__ int act_row(int l, int r) { return (l < DEPTH - 1) ? r : (r >> 12) * RPB + CTX + (r & 4095); }

__device__ __forceinline__ void tables(char* ws, int l, LAS unsigned char* lds) {
    LAS int* tb = (LAS int*)(lds + A_TB); LAS int* cn = (LAS int*)(lds + A_CN);
    if (ltid() == 0) { unsigned* cnt = (unsigned*)(ws + WS_CTL + CTL_CNT) + l * 32; int run = 0;
        for (int e = 0; e < NE; ++e) { const int n = (int)__hip_atomic_load(cnt + e, __ATOMIC_RELAXED, __HIP_MEMORY_SCOPE_AGENT); tb[e] = run; cn[e] = n; run += (n + 255) >> 8; }
        tb[NE] = run; }
    __syncthreads();
}

__device__ __forceinline__ void route_phase(const PTab& p, int l, LAS unsigned char* lds, int G, int c, int dry = 0) {
    const int tid = ltid(), lane = tid & 63, wid = tid >> 6; char* ws = p.ws();
    LAS float* RW = (LAS float*)lds;
    LAS float* LG = (LAS float*)(lds + A_LG) + wid * 32; LAS int* hist = (LAS int*)(lds + A_HIST); LAS int* base = (LAS int*)(lds + A_BASE); LAS int* rank = (LAS int*)(lds + A_RANK);
    { const float* rw = p.router_w() + (size_t)l * 1024 * 32;
      for (int i = tid; i < 32768; i += 512) { const int k = i >> 5, e = i & 31; RW[e * RWS + k] = rw[i]; } }
    if (tid < 32) hist[tid] = 0;
    __syncthreads();
    const int nact = n_act_rows(l), chunk = (nact + G - 1) / G, r0 = c * chunk, r1 = (r0 + chunk < nact) ? r0 + chunk : nact;
    const bf16_t* X = (const bf16_t*)(ws + WS_X); unsigned char* H8 = (unsigned char*)(ws + WS_H8);
    const float* M = (const float*)(ws + WS_MOD) + (size_t)l * 9 * 6144; const float* g2n = p.norm2_g() + l * D; const float* rb = p.router_b() + l * 32;
    for (int rb0 = r0 + wid; rb0 < r1; rb0 += 32) {
        f32x4 hv[4][4]; int rows[4]; bool ok[4];
#pragma unroll
        for (int q = 0; q < 4; ++q) { const int r = rb0 + 8 * q; ok[q] = r < r1; rows[q] = act_row(l, ok[q] ? r : rb0); const bf16_t* xr = X + (size_t)rows[q] * D;
#pragma unroll
            for (int i = 0; i < 4; ++i) { const u32x2 w = *(const u32x2*)(xr + i * 256 + lane * 4); hv[q][i] = (f32x4){bflo(w.x), bfhi(w.x), bflo(w.y), bfhi(w.y)}; } }
#pragma unroll
        for (int q = 0; q < 4; ++q) { const int row = rows[q], b = row / RPB, s = (row % RPB) < CTX ? 8 : b; const float* sh = M + s * 6144 + 3072; const float* sc = M + s * 6144 + 4096;
            float ss = 0.f;
#pragma unroll
            for (int i = 0; i < 4; ++i) ss += hv[q][i][0] * hv[q][i][0] + hv[q][i][1] * hv[q][i][1] + hv[q][i][2] * hv[q][i][2] + hv[q][i][3] * hv[q][i][3];
            ss = wave_sum(ss);
            const float rs = rsqrtf(ss * (1.0f / 1024.0f) + EPS);
#pragma unroll
            for (int i = 0; i < 4; ++i) { const int col = i * 256 + lane * 4; const f32x4 gg = *(const f32x4*)(g2n + col), sv = *(const f32x4*)(sh + col), cv = *(const f32x4*)(sc + col);
#pragma unroll
                for (int j = 0; j < 4; ++j) hv[q][i][j] = hv[q][i][j] * rs * gg[j] * (1.0f + cv[j]) + sv[j];
                if (!dry && ok[q]) *(unsigned*)(H8 + (size_t)row * D + col) = cvt4_fp8s(hv[q][i][0], hv[q][i][1], hv[q][i][2], hv[q][i][3]); } }
#pragma unroll 1
        for (int ec = 0; ec < 4; ++ec) {
            float a[4][8];
#pragma unroll
            for (int q = 0; q < 4; ++q)
#pragma unroll
                for (int e = 0; e < 8; ++e) a[q][e] = 0.f;
#pragma unroll
            for (int e = 0; e < 8; ++e)
#pragma unroll
                for (int i = 0; i < 4; ++i) { const f32x4 w = *(const LAS f32x4*)(RW + (ec * 8 + e) * RWS + i * 256 + lane * 4);
#pragma unroll
                    for (int q = 0; q < 4; ++q) a[q][e] += hv[q][i][0] * w[0] + hv[q][i][1] * w[1] + hv[q][i][2] * w[2] + hv[q][i][3] * w[3]; }
            const bool b5 = lane & 32, b4 = lane & 16, b3 = lane & 8;
#pragma unroll
            for (int q = 0; q < 4; ++q) {
#pragma unroll
                for (int i = 0; i < 4; ++i) { const float keep = b5 ? a[q][i + 4] : a[q][i], send = b5 ? a[q][i] : a[q][i + 4]; a[q][i] = keep + lane_xor<32>(send, lane); }
#pragma unroll
                for (int i = 0; i < 2; ++i) { const float keep = b4 ? a[q][i + 2] : a[q][i], send = b4 ? a[q][i] : a[q][i + 2]; a[q][i] = keep + lane_xor<16>(send, lane); }
                { const float keep = b3 ? a[q][1] : a[q][0], send = b3 ? a[q][0] : a[q][1]; a[q][0] = keep + lane_xor<8>(send, lane); }
                a[q][0] += lane_xor<4>(a[q][0], lane); a[q][0] += lane_xor<2>(a[q][0], lane); a[q][0] += lane_xor<1>(a[q][0], lane);
                const int e = ec * 8 + ((lane >> 5) & 1) * 4 + ((lane >> 4) & 1) * 2 + ((lane >> 3) & 1);
                if ((lane & 7) == 0) (LG + q * 256)[e] = a[q][0] + rb[e]; }
        }
        asm volatile("s_waitcnt lgkmcnt(0)" ::: "memory");
        {
            const int q = lane >> 4, sub = lane & 15;
            unsigned k0, k1;
            { const float l0 = (LG + q * 256)[sub], l1 = (LG + q * 256)[sub + 16];
              unsigned u0 = __float_as_uint(l0), u1 = __float_as_uint(l1);
              u0 = (u0 & 0x80000000u) ? ~u0 : (u0 | 0x80000000u); u1 = (u1 & 0x80000000u) ? ~u1 : (u1 | 0x80000000u);
              k0 = (u0 & ~31u) | (unsigned)(31 - sub); k1 = (u1 & ~31u) | (unsigned)(15 - sub); }
            float tv[4]; int ti[4];
#pragma unroll
            for (int k = 0; k < 4; ++k) { unsigned mx = k0 > k1 ? k0 : k1;
                { const unsigned o = (unsigned)__builtin_amdgcn_update_dpp(0, (int)mx, 0xB1, 0xf, 0xf, true); mx = o > mx ? o : mx; }
                { const unsigned o = (unsigned)__builtin_amdgcn_update_dpp(0, (int)mx, 0x4E, 0xf, 0xf, true); mx = o > mx ? o : mx; }
                { const unsigned o = (unsigned)__builtin_amdgcn_update_dpp(0, (int)mx, 0x141, 0xf, 0xf, true); mx = o > mx ? o : mx; }
                { const unsigned o = (unsigned)__builtin_amdgcn_update_dpp(0, (int)mx, 0x140, 0xf, 0xf, true); mx = o > mx ? o : mx; }
                k0 = (k0 == mx) ? 0u : k0; k1 = (k1 == mx) ? 0u : k1;
                ti[k] = 31 - (int)(mx & 31u); const unsigned u = mx & ~31u; tv[k] = __uint_as_float((u & 0x80000000u) ? (u & 0x7fffffffu) : ~u); }
            const float e1 = __expf(tv[1] - tv[0]), e2 = __expf(tv[2] - tv[0]), e3 = __expf(tv[3] - tv[0]), inv = 1.0f / (1.0f + e1 + e2 + e3);
            const int r = rb0 + 8 * q;
            if (sub < 4 && !dry && r < r1) { const int row = act_row(l, r); const int ek = sub == 0 ? ti[0] : sub == 1 ? ti[1] : sub == 2 ? ti[2] : ti[3]; const float gk = (sub == 0 ? 1.0f : sub == 1 ? e1 : sub == 2 ? e2 : e3) * inv;
                ((int*)(ws + WS_TOPI))[(size_t)row * 4 + sub] = ek; ((float*)(ws + WS_TOPG))[(size_t)row * 4 + sub] = gk;
                const int rk = atomicAdd((int*)(hist + ek), 1);
                rank[(r - r0) * 4 + sub] = rk | (ek << 24); }
        }
        asm volatile("s_waitcnt lgkmcnt(0)" ::: "memory");
    }
    __syncthreads();
    if (dry) return;
    if (tid < 32) base[tid] = (int)__hip_atomic_fetch_add((unsigned*)(ws + WS_CTL + CTL_CNT) + l * 32 + tid, (unsigned)hist[tid], __ATOMIC_RELAXED, __HIP_MEMORY_SCOPE_AGENT);
    __syncthreads();
    for (int i = tid; i < (r1 - r0) * 4; i += 512) { const int v = rank[i], e = v >> 24, rk = v & 0xffffff, row = act_row(l, r0 + (i >> 2)), pos = base[e] + rk;
        ((int*)(ws + WS_TOPP))[(size_t)row * 4 + (i & 3)] = pos; ((int*)(ws + WS_RT2))[(size_t)e * T + pos] = row; }
    __syncthreads();
}

__device__ __forceinline__ void permute_phase(const PTab& p, int l, LAS unsigned char* lds, int G, int c) {
    const int tid_ = ltid(), lane = tid_ & 63, wid = tid_ >> 6; char* ws = p.ws();
    tables(ws, l, lds);
    const LAS int* tb = (const LAS int*)(lds + A_TB); const LAS int* cn = (const LAS int*)(lds + A_CN);
    const bf16_t* H = (const bf16_t*)(ws + WS_H); bf16_t* HS = (bf16_t*)(ws + WS_HS);
    const int nact = n_act_rows(l);
    for (int r = c * 8 + wid; r < nact; r += G * 8) { const int row = act_row(l, r);
        const u32x4 a = *(const u32x4*)(H + (size_t)row * D + lane * 16), b = *(const u32x4*)(H + (size_t)row * D + lane * 16 + 8);
        const int* ti = (const int*)(ws + WS_TOPI) + (size_t)row * 4; const int* tp = (const int*)(ws + WS_TOPP) + (size_t)row * 4;
#pragma unroll
        for (int k = 0; k < 4; ++k) { const int e = ti[k], pos = tp[k]; bf16_t* d = HS + ((size_t)tb[e] * 256 + pos) * D + lane * 16; *(u32x4*)d = a; *(u32x4*)(d + 8) = b; } }
    for (int e = 0; e < NE; ++e) { const int n = cn[e], end = ((n + 255) >> 8) << 8;
        for (int pr = n + c * 8 + wid; pr < end; pr += G * 8) { bf16_t* d = HS + ((size_t)tb[e] * 256 + pr) * D + lane * 16; const u32x4 z = {0u, 0u, 0u, 0u}; *(u32x4*)d = z; *(u32x4*)(d + 8) = z; } }
}

__device__ __forceinline__ void combine_phase(const PTab& p, int l, LAS unsigned char* lds, int G, int c, int dry = 0) {
    const int tid_ = ltid(), lane = tid_ & 63, wid = tid_ >> 6; char* ws = p.ws();
    tables(ws, l, lds);
    const LAS int* tb = (const LAS int*)(lds + A_TB);
    bf16_t* X = (bf16_t*)(ws + WS_X); bf16_t* H = (bf16_t*)(ws + WS_H); const unsigned char* YM = (const unsigned char*)(ws + WS_YM);
    const float* M = (const float*)(ws + WS_MOD) + (size_t)l * 9 * 6144; const float* Mn = M + 9 * 6144;
    const int nact = n_act_rows(l); const float* n1g = p.norm1_g(); const float* fing = p.final_g(); float* outp = p.out();
    int r = c * 8 + wid;
    typedef int i32x4 __attribute__((ext_vector_type(4)));
    i32x4 nti = {0, 0, 0, 0}, ntp = {0, 0, 0, 0}; f32x4 ntg = {0.f, 0.f, 0.f, 0.f};
    if (r < nact) { const int row0 = act_row(l, r); nti = *(const i32x4*)((const int*)(ws + WS_TOPI) + (size_t)row0 * 4); ntp = *(const i32x4*)((const int*)(ws + WS_TOPP) + (size_t)row0 * 4); ntg = *(const f32x4*)((const float*)(ws + WS_TOPG) + (size_t)row0 * 4); }
    for (; r < nact; r += G * 8) { const int row = act_row(l, r), b = row / RPB, s = (row % RPB) < CTX ? 8 : b;
        const i32x4 ti = nti, tp = ntp; const f32x4 tg = ntg;
        { const int rn = r + G * 8; if (rn < nact) { const int rown = act_row(l, rn); nti = *(const i32x4*)((const int*)(ws + WS_TOPI) + (size_t)rown * 4); ntp = *(const i32x4*)((const int*)(ws + WS_TOPP) + (size_t)rown * 4); ntg = *(const f32x4*)((const float*)(ws + WS_TOPG) + (size_t)rown * 4); } }
        f32x4 acc[4];
#pragma unroll
        for (int i = 0; i < 4; ++i) acc[i] = (f32x4){0.f, 0.f, 0.f, 0.f};
        unsigned yw[4][4];
#pragma unroll
        for (int k = 0; k < 4; ++k) { const int e = ti[k], pos = tp[k]; const unsigned char* y = YM + ((size_t)tb[e] * 256 + pos) * D + lane * 4;
#pragma unroll
            for (int i = 0; i < 4; ++i) yw[k][i] = *(const unsigned*)(y + i * 256); }
#pragma unroll
        for (int k = 0; k < 4; ++k) { const float gk = tg[k] * (1.0f / YM_SCALE);
#pragma unroll
            for (int i = 0; i < 4; ++i) { float a0, a1, a2, a3; cvt_fp8x4(yw[k][i], a0, a1, a2, a3); acc[i][0] += gk * a0; acc[i][1] += gk * a1; acc[i][2] += gk * a2; acc[i][3] += gk * a3; } }
        bf16_t* xrow = X + (size_t)row * D; const float* g2 = M + s * 6144 + 5120; f32x4 xv[4]; float ss = 0.f;
#pragma unroll
        for (int i = 0; i < 4; ++i) { const int col = i * 256 + lane * 4; { const u32x2 xw = *(const u32x2*)(xrow + col); xv[i] = (f32x4){bflo(xw.x), bfhi(xw.x), bflo(xw.y), bfhi(xw.y)} + *(const f32x4*)(g2 + col) * acc[i]; } if (!dry && l < DEPTH - 1) { u32x2 ow; ow.x = cvt_pk_bf16(xv[i][0], xv[i][1]); ow.y = cvt_pk_bf16(xv[i][2], xv[i][3]); *(u32x2*)(xrow + col) = ow; }
            ss += xv[i][0] * xv[i][0] + xv[i][1] * xv[i][1] + xv[i][2] * xv[i][2] + xv[i][3] * xv[i][3]; }
        ss = wave_sum(ss);
        const float rs = rsqrtf(ss * (1.0f / 1024.0f) + EPS);
        if (l < DEPTH - 1) { const float* gn = n1g + (l + 1) * D; const float* sh = Mn + s * 6144; const float* sc = Mn + s * 6144 + 1024;
#pragma unroll
            for (int i = 0; i < 4; ++i) { const int col = i * 256 + lane * 4; const f32x4 gg = *(const f32x4*)(gn + col), sv = *(const f32x4*)(sh + col), cv = *(const f32x4*)(sc + col); float o[4];
#pragma unroll
                for (int j = 0; j < 4; ++j) o[j] = xv[i][j] * rs * gg[j] * (1.0f + cv[j]) + sv[j];
                u32x2 w; w.x = cvt_pk_bf16(o[0], o[1]); w.y = cvt_pk_bf16(o[2], o[3]); if (!dry) { *(u32x2*)(H + (size_t)row * D + col) = w; *(unsigned*)((unsigned char*)(ws + WS_HA8) + (size_t)row * D + col) = cvt4_fp8s(o[0], o[1], o[2], o[3]); } else asm volatile("" :: "v"(w)); } }
        else { float* orow = outp + (size_t)r * D;
#pragma unroll
            for (int i = 0; i < 4; ++i) { const int col = i * 256 + lane * 4; const f32x4 gg = *(const f32x4*)(fing + col); { const f32x4 ov = xv[i] * rs * gg; if (!dry) *(f32x4*)(orow + col) = ov; else asm volatile("" :: "v"(ov)); } } }
    }
}
__device__ __forceinline__ void krope_job(char* ws, int G, int c) {
    const bf16_t* U = (const bf16_t*)(ws + WS_UKV); bf16_t* KR = (bf16_t*)(ws + WS_KR); const f32x2* rope = (const f32x2*)(ws + WS_ROPE);
    for (int i = c * 512 + ltid(); i < T * 16; i += G * 512) { const int row = i >> 4, pr = i & 15, axis = pr >> 3, f = pr & 7, tl = (row % RPB) - CTX;
        const float x1 = bf2f(U[(size_t)row * 256 + 128 + axis * 16 + f]), x2 = bf2f(U[(size_t)row * 256 + 128 + axis * 16 + 8 + f]); float o1 = x1, o2 = x2;
        if (tl >= 0) { const int pos = axis ? (tl & 63) : (tl >> 6); const f32x2 cs = rope[pos * 8 + f]; o1 = x1 * cs.x - x2 * cs.y; o2 = x2 * cs.x + x1 * cs.y; }
        *(unsigned*)(KR + (size_t)row * 32 + axis * 16 + 2 * f) = cvt_pk_bf16(o1, o2); }
}
}
constexpr int N_PHASES = 2 + 10 * DEPTH;
#ifndef MK_PER_PHASE
#define MK_PER_PHASE 0
#endif

__global__ void __launch_bounds__(512, 2) mega(Params p, int ph_lo, int ph_hi) {
    extern __shared__ __attribute__((aligned(16))) unsigned char smem_raw[];
    LAS unsigned char* lds0 = (LAS unsigned char*)smem_raw; LAS unsigned char* lds = lds0;
    const int G0 = (int)gridDim.x, c0 = (int)blockIdx.x;
    volatile LAS unsigned* st = (volatile LAS unsigned*)(lds + LDS_BYTES - 16);
    if (threadIdx.x == 0) { st[0] = 0u; st[1] = 0u; st[2] = 0u; st[3] = 0u;
        LAS unsigned long long* t = (LAS unsigned long long*)(lds + LDS_PTAB);
        t[0] = (unsigned long long)p.x; t[1] = (unsigned long long)p.c; t[2] = (unsigned long long)p.ctx; t[3] = (unsigned long long)p.c_ctx; t[4] = (unsigned long long)p.w_mod; t[5] = (unsigned long long)p.b_mod;
        t[6] = (unsigned long long)p.norm1_g; t[7] = (unsigned long long)p.w_in; t[8] = (unsigned long long)p.q_norm_g; t[9] = (unsigned long long)p.w_uq; t[10] = (unsigned long long)p.kv_norm_g; t[11] = (unsigned long long)p.w_ukv;
        t[12] = (unsigned long long)p.w_gf; t[13] = (unsigned long long)p.b_gf; t[14] = (unsigned long long)p.w_gb; t[15] = (unsigned long long)p.b_gb; t[16] = (unsigned long long)p.gla_norm_g; t[17] = (unsigned long long)p.w_br_mla;
        t[18] = (unsigned long long)p.w_br_fnet; t[19] = (unsigned long long)p.w_br_gla; t[20] = (unsigned long long)p.w_o; t[21] = (unsigned long long)p.norm2_g; t[22] = (unsigned long long)p.router_w; t[23] = (unsigned long long)p.router_b;
        t[24] = (unsigned long long)p.w_up; t[25] = (unsigned long long)p.b_up; t[26] = (unsigned long long)p.w_down; t[27] = (unsigned long long)p.b_down; t[28] = (unsigned long long)p.final_g; t[29] = (unsigned long long)p.out; t[30] = (unsigned long long)p.ws; }
    __syncthreads();
    const PTab pt{(const LAS unsigned long long*)(lds + LDS_PTAB)};
    XcdBarrier bar = xcd_barrier_post((unsigned*)(pt.ws() + WS_CTL), st);
#define WS_GET() const int G = lsgpr(G0), c = lsgpr(c0); LAS unsigned char* lds = lds_launder(lds0); const PTab pt{(const LAS unsigned long long*)(lds + LDS_PTAB)}; char* ws = pt.ws(); const char* wl = ws + WS_W + (size_t)l * WL_BYTES; (void)wl
#ifndef PH_REPEAT
#define PH_REPEAT 0
#endif
#define DRYV(rep_) (PH_REPEAT ? lsgpr((rep_) ? 1 : 0) : 0)
#ifndef PH_SKIPEPI
#define PH_SKIPEPI 0
#endif
#ifndef STAGGER_TICKS
#define STAGGER_TICKS 0
#endif
#define STAGGER(c) do { if (STAGGER_TICKS) { const unsigned long long t0_ = __builtin_amdgcn_s_memrealtime(); const unsigned long long d_ = (unsigned long long)(((c) >> 3) & 7) * STAGGER_TICKS; while (__builtin_amdgcn_s_memrealtime() - t0_ < d_) __builtin_amdgcn_s_sleep(8); } } while (0)
#ifndef PH_MASK
#define PH_MASK 0x1fff
#endif
#if MK_PER_PHASE || defined(DBG_STOP)
#define PH_ON(n) (ph_lo <= (n) && (n) < ph_hi)
#define PH_END(n) do { if ((n) + 1 < ph_hi) grid_sync(bar); } while (0)
#else
#define PH_ON(n) true
#ifdef DBL_BAR
#define PH_END(n) do { if ((n) + 1 < N_PHASES) { grid_sync(bar); grid_sync(bar); } } while (0)
#else
#define PH_END(n) do { if ((n) + 1 < N_PHASES) grid_sync(bar); } while (0)
#endif
#endif
#define PHC(k) ((PH_MASK >> (k)) & 1)
    if (PHC(0) && PH_ON(0)) { prologue_phase(pt, lds, G0, c0); __syncthreads(); if (PH_REPEAT & 1) { grid_sync(bar); prologue_phase(pt, lds, lsgpr(G0), lsgpr(c0)); __syncthreads(); } PH_END(0); }
    if (PHC(1) && PH_ON(1)) { norm1_phase(pt, 0, G0, c0); PH_END(1); }
#pragma unroll 1
    for (int l = 0; l < DEPTH; ++l) {
        const int pb = 2 + 10 * l;
        if (PHC(2) && PH_ON(pb + 0)) { { constexpr bool rep_ = false; (void)rep_; WS_GET(); { G1Sched8 S{ws + WS_HA8, wl + WL_WIN8, G, c}; G1EpiB E{ws}; gk::gemm_phase(lds, S, E); } { G1Sched S{ws + WS_H, wl + WL_WIN, G, (c + 96) % G}; G1EpiA E{ws}; gk::gemm_phase(lds, S, E); } }
            if ((PH_REPEAT >> 2) & 1) { grid_sync(bar); { constexpr bool rep_ = true; (void)rep_; WS_GET(); { G1Sched8 S{ws + WS_HA8, wl + WL_WIN8, G, c}; G1EpiB E{ws}; gk::gemm_phase(lds, S, E); } { G1Sched S{ws + WS_H, wl + WL_WIN, G, (c + 96) % G}; G1EpiA E{ws}; gk::gemm_phase(lds, S, E); } } }
            PH_END(pb + 0); }
        if (PHC(3) && PH_ON(pb + 1)) { { constexpr bool rep_ = false; (void)rep_; WS_GET();
            { P2Sched S{ws, wl, l, G, c}; P2Epi E{DftEpi{ws}, QEpi{ws}, KnEpi{ws}, VtEpi{ws}}; gk::gemm_phase(lds, S, E); }
            dft_stage_a(ws, G, c);
            moe::krope_job(ws, G, c);
            __syncthreads();
            gla::g1_phase(pt, l, lds, G, c);
            }
            if ((PH_REPEAT >> 3) & 1) { grid_sync(bar); { constexpr bool rep_ = true; (void)rep_; WS_GET();
            { P2Sched S{ws, wl, l, G, c}; P2Epi E{DftEpi{ws}, QEpi{ws}, KnEpi{ws}, VtEpi{ws}}; gk::gemm_phase(lds, S, E); }
            dft_stage_a(ws, G, c);
            moe::krope_job(ws, G, c);
            __syncthreads();
            gla::g1_phase(pt, l, lds, G, c);
            } }
            PH_END(pb + 1); }
        if (PHC(4) && PH_ON(pb + 2)) { { constexpr bool rep_ = false; (void)rep_; WS_GET();
            if (!rep_) for (int it = c; it < 256; it += G) gla::g2_item(ws, it >> 2, it & 3);
            { DftBSched S{ws, G, c}; DftEpi E{ws}; gk::gemm_phase(lds, S, E); }
            at::attn_phase(ws, lds, l, G, c);
            }
            if ((PH_REPEAT >> 4) & 1) { grid_sync(bar); { constexpr bool rep_ = true; (void)rep_; WS_GET();
            if (!rep_) for (int it = c; it < 256; it += G) gla::g2_item(ws, it >> 2, it & 3);
            { DftBSched S{ws, G, c}; DftEpi E{ws}; gk::gemm_phase(lds, S, E); }
            at::attn_phase(ws, lds, l, G, c);
            } }
            PH_END(pb + 2); }
        if (PHC(5) && PH_ON(pb + 3)) { { constexpr bool rep_ = false; (void)rep_; WS_GET();
            gla::g3_phase(pt, l, lds, G, c);
            }
            if ((PH_REPEAT >> 5) & 1) { grid_sync(bar); { constexpr bool rep_ = true; (void)rep_; WS_GET();
            gla::g3_phase(pt, l, lds, G, c);
            } }
            PH_END(pb + 3); }
        if (PHC(6) && PH_ON(pb + 4)) { { constexpr bool rep_ = false; (void)rep_; WS_GET(); MergeSched S{ws, wl, l, G, c}; MergeEpi E{ws, (PH_REPEAT ? lsgpr((rep_ && PH_SKIPEPI) ? 1 : 0) : 0)}; gk::gemm_phase(lds, S, E); }
            if ((PH_REPEAT >> 6) & 1) { grid_sync(bar); { constexpr bool rep_ = true; (void)rep_; WS_GET(); MergeSched S{ws, wl, l, G, c}; MergeEpi E{ws, (PH_REPEAT ? lsgpr((rep_ && PH_SKIPEPI) ? 1 : 0) : 0)}; gk::gemm_phase(lds, S, E); } }
            PH_END(pb + 4); }
        if (PHC(7) && PH_ON(pb + 5)) { { constexpr bool rep_ = false; (void)rep_; WS_GET(); WoSched S{ws, wl, l, G, c}; WoEpi E{ws, l, DRYV(rep_), pt.x(), pt.ctx()}; gk::gemm_phase(lds, S, E); }
            if ((PH_REPEAT >> 7) & 1) { grid_sync(bar); { constexpr bool rep_ = true; (void)rep_; WS_GET(); WoSched S{ws, wl, l, G, c}; WoEpi E{ws, l, DRYV(rep_), pt.x(), pt.ctx()}; gk::gemm_phase(lds, S, E); } }
            PH_END(pb + 5); }
        if (PHC(8) && PH_ON(pb + 6)) { { constexpr bool rep_ = false; (void)rep_; WS_GET(); moe::route_phase(pt, l, lds, G, c, DRYV(rep_)); }
            if ((PH_REPEAT >> 8) & 1) { grid_sync(bar); { constexpr bool rep_ = true; (void)rep_; WS_GET(); moe::route_phase(pt, l, lds, G, c, DRYV(rep_)); } }
            PH_END(pb + 6); }
        if (PHC(10) && PH_ON(pb + 7)) { { constexpr bool rep_ = false; (void)rep_; WS_GET(); moe::tables(ws, l, lds);
            MoeUpSched S{ws + WS_H8, (const int*)(ws + WS_RT2), wl + WL_WUP, (const LAS int*)(lds + moe::A_TB), (const LAS int*)(lds + moe::A_CN), G, c};
            UpEpi E{ws, pt.b_up() + (size_t)l * NE * 2048}; gk::gemm_phase(lds, S, E); }
            if ((PH_REPEAT >> 10) & 1) { grid_sync(bar); { constexpr bool rep_ = true; (void)rep_; WS_GET(); moe::tables(ws, l, lds);
            MoeUpSched S{ws + WS_H8, (const int*)(ws + WS_RT2), wl + WL_WUP, (const LAS int*)(lds + moe::A_TB), (const LAS int*)(lds + moe::A_CN), G, c};
            UpEpi E{ws, pt.b_up() + (size_t)l * NE * 2048}; gk::gemm_phase(lds, S, E); } }
            PH_END(pb + 7); }
        if (PHC(11) && PH_ON(pb + 8)) { { constexpr bool rep_ = false; (void)rep_; WS_GET(); moe::tables(ws, l, lds);
            MoeSched S{ws + WS_ACT, wl + WL_WDN, (const LAS int*)(lds + moe::A_TB), G, c};
            DownEpi E{ws, pt.b_down() + (size_t)l * NE * 1024}; gk::gemm_phase(lds, S, E); }
            if ((PH_REPEAT >> 11) & 1) { grid_sync(bar); { constexpr bool rep_ = true; (void)rep_; WS_GET(); moe::tables(ws, l, lds);
            MoeSched S{ws + WS_ACT, wl + WL_WDN, (const LAS int*)(lds + moe::A_TB), G, c};
            DownEpi E{ws, pt.b_down() + (size_t)l * NE * 1024}; gk::gemm_phase(lds, S, E); } }
            PH_END(pb + 8); }
        if (PHC(12) && PH_ON(pb + 9)) { { constexpr bool rep_ = false; (void)rep_; WS_GET(); moe::combine_phase(pt, l, lds, G, c, DRYV(rep_)); }
            if ((PH_REPEAT >> 12) & 1) { grid_sync(bar); { constexpr bool rep_ = true; (void)rep_; WS_GET(); moe::combine_phase(pt, l, lds, G, c, DRYV(rep_)); } }
            PH_END(pb + 9); }
    }
#undef PH_ON
#undef PH_END
}

#ifdef DBG_STOP
struct DbgEnt { size_t off; size_t n; int f32; };
__global__ void dbg_dump(const char* ws, float* out, int n) {
    const DbgEnt L[] = { DBG_LIST };
    for (size_t i = (size_t)blockIdx.x * blockDim.x + threadIdx.x; i < (size_t)n; i += (size_t)gridDim.x * blockDim.x) {
        float s = 0.f;
        for (int k = 0; k < (int)(sizeof(L) / sizeof(L[0])); ++k) { const size_t j = i % L[k].n; const float v = L[k].f32 ? ((const float*)(ws + L[k].off))[j] : bf2f(((const bf16_t*)(ws + L[k].off))[j]); s += v; }
        out[i] = s;
    }
}
#endif
extern "C" void kernel_launch(void* const* d_in, const int* in_sizes, int n_in, void* d_out, int out_size, void* d_ws, size_t ws_size, hipStream_t stream) {
    static int grid = 0;
    if (!grid) {
        if (n_in != 29 || ws_size < WS_END) { fprintf(stderr, "kernel_launch: unexpected inputs (%d) or workspace (%zu < %zu)\n", n_in, ws_size, (size_t)WS_END); grid = -1; return; }
        int dev = 0, cus = 0, per_cu = 0;
        hipGetDevice(&dev); hipDeviceGetAttribute(&cus, hipDeviceAttributeMultiprocessorCount, dev);
        if (hipFuncSetAttribute((const void*)mega, hipFuncAttributeMaxDynamicSharedMemorySize, LDS_BYTES) != hipSuccess) { fprintf(stderr, "kernel_launch: hipFuncSetAttribute failed\n"); grid = -1; return; }
        hipOccupancyMaxActiveBlocksPerMultiprocessor(&per_cu, (const void*)mega, 512, LDS_BYTES);
        if (per_cu < 1 || cus < 1) { fprintf(stderr, "kernel_launch: kernel is not resident (occupancy %d, CUs %d)\n", per_cu, cus); grid = -1; return; }
        grid = cus;
    }
    if (grid < 0) return;
    hipMemsetAsync((char*)d_ws + WS_CTL, 0, CTL_BYTES, stream);
    Params p{};
    const float** f = (const float**)&p;
    for (int i = 0; i < 29; ++i) f[i] = (const float*)d_in[i];
    p.out = (float*)d_out; p.ws = (char*)d_ws;
#ifdef DBG_STOP
    for (int ph = 0; ph < DBG_STOP; ++ph) hipLaunchKernelGGL(mega, dim3(grid), dim3(512), LDS_BYTES, stream, p, ph, ph + 1);
    hipLaunchKernelGGL(dbg_dump, dim3(2048), dim3(256), 0, stream, (const char*)d_ws, (float*)d_out, out_size);
#elif MK_PER_PHASE
    for (int ph = 0; ph < N_PHASES; ++ph) hipLaunchKernelGGL(mega, dim3(grid), dim3(512), LDS_BYTES, stream, p, ph, ph + 1);
#else
    hipLaunchKernelGGL(mega, dim3(grid), dim3(512), LDS_BYTES, stream, p, 0, N_PHASES);
#endif
}
```

```cpp
#include <hip/hip_runtime.h>
#include <cstdio>
#include <cstdint>

#define LAS __attribute__((address_space(3)))
typedef unsigned short bf16_t;
typedef short bf16x8 __attribute__((ext_vector_type(8)));
typedef short s16x4 __attribute__((ext_vector_type(4)));
typedef float f32x2 __attribute__((ext_vector_type(2)));
typedef float f32x4 __attribute__((ext_vector_type(4)));
typedef float f32x16 __attribute__((ext_vector_type(16)));
typedef unsigned u32x2 __attribute__((ext_vector_type(2)));
typedef unsigned u32x4 __attribute__((ext_vector_type(4)));

constexpr int D = 1024, NB = 8, SEQ = 4096, CTX = 256, DEPTH = 4;
constexpr int RPB = CTX + SEQ;
constexpr int T = NB * RPB;
constexpr int NMT = T / 256;
constexpr int NE = 32, TOPK = 4;
constexpr int NPAD = 147456;
constexpr int INW = 5568;
constexpr int G1N = 5632;
constexpr float EPS = 1e-6f;
constexpr float QSCALE = 0.10206207261596575f * 1.4426950408889634f;
constexpr int NCHUNK = 68;

constexpr int CO_Q = 0, CO_KV = 256, CO_FN = 416, CO_GQ = 928, CO_GK = 1184, CO_GV = 1440, CO_OG = 1952, CO_GF = 2464, CO_GB = 2480, CO_GATE = 2496;

constexpr size_t al256(size_t x) { return (x + 255) & ~(size_t)255; }
constexpr size_t WS_CTL   = 0;
constexpr size_t CTL_BYTES = 65536;
constexpr size_t CTL_CNT  = 16384;
constexpr size_t WS_X     = WS_CTL + CTL_BYTES;
constexpr size_t WS_H     = WS_X + (size_t)T * D * 4;
constexpr size_t WS_UQ    = WS_H + (size_t)T * D * 2;
constexpr size_t WS_UKV   = WS_UQ + (size_t)T * 256 * 2;
constexpr size_t WS_UFT   = WS_UKV + (size_t)T * 256 * 2;
constexpr size_t WS_GQ    = WS_UFT + (size_t)NB * 512 * RPB * 2;
constexpr size_t WS_GK    = WS_GQ + (size_t)T * 256 * 2;
constexpr size_t WS_GV    = WS_GK + (size_t)T * 256 * 2;
constexpr size_t WS_GOG   = WS_GV + (size_t)T * 512 * 2;
constexpr size_t WS_GATE  = WS_GOG + (size_t)T * 512 * 2;
constexpr size_t WS_SSQ   = WS_GATE + (size_t)T * 3072 * 2;
constexpr size_t WS_Q     = WS_SSQ + (size_t)T * 8 * 4;
constexpr size_t WS_KN    = WS_Q + (size_t)T * 768 * 2;
constexpr size_t WS_KR    = WS_KN + (size_t)T * 512 * 2;
constexpr size_t WS_VT    = WS_KR + (size_t)T * 32 * 2;
constexpr size_t WS_OMLA  = WS_VT + (size_t)NB * 8 * 64 * RPB * 2;
constexpr size_t WS_P     = WS_OMLA + (size_t)T * 512 * 2;
constexpr size_t WS_KVS   = WS_P + (size_t)T * D * 2;
constexpr size_t WS_DEC   = WS_KVS + (size_t)NB * 4 * 2 * NCHUNK * 128 * 64 * 2;
constexpr size_t WS_OGLA  = WS_DEC + (size_t)NB * 4 * 2 * NCHUNK * 64 * 4;
constexpr size_t WS_Y     = WS_OGLA + (size_t)T * 512 * 2;
constexpr size_t WS_TOPI  = WS_Y + (size_t)T * D * 2;
constexpr size_t WS_TOPG  = WS_TOPI + (size_t)T * 16;
constexpr size_t WS_TOPP  = WS_TOPG + (size_t)T * 16;
constexpr size_t WS_HS    = WS_TOPP + (size_t)T * 16;
constexpr size_t WS_ACT   = WS_HS + (size_t)NPAD * D * 2;
constexpr size_t WS_YM    = WS_ACT + (size_t)NPAD * D * 2;
constexpr size_t WS_GG    = WS_YM + (size_t)NPAD * D * 2;
constexpr size_t WS_RT2   = WS_GG + (size_t)T * 512 * 4;
constexpr size_t WS_H8    = WS_RT2 + (size_t)NE * T * 4;
constexpr size_t WS_HA8   = WS_H8 + (size_t)T * D;
constexpr size_t WS_MOD   = WS_HA8 + (size_t)T * D;
constexpr size_t WS_ROPE  = WS_MOD + (size_t)DEPTH * 9 * 6144 * 4;
constexpr size_t WS_DFTL  = al256(WS_ROPE + 4096);
constexpr size_t WS_DFTC  = WS_DFTL + (size_t)8192 * 4096 * 2;
constexpr size_t WS_DB    = WS_DFTC + (size_t)512 * 256 * 2;
constexpr size_t WS_TW    = WS_DB + (size_t)512 * 512 * 2;
constexpr size_t WS_W     = WS_TW + (size_t)16 * 256 * 8;
constexpr size_t WL_WIN = 0;
constexpr size_t WL_WUQ = WL_WIN + (size_t)G1N * 1024 * 2;
constexpr size_t WL_WUKV = WL_WUQ + (size_t)768 * 256 * 2;
constexpr size_t WL_WM = WL_WUKV + (size_t)1024 * 256 * 2;
constexpr size_t WL_WF = WL_WM + (size_t)1024 * 512 * 2;
constexpr size_t WL_WG = WL_WF + (size_t)1024 * 1024 * 2;
constexpr size_t WL_WO = WL_WG + (size_t)1024 * 512 * 2;
constexpr size_t WL_WUP = WL_WO + (size_t)1024 * 1024 * 2;
constexpr size_t WL_WDN = WL_WUP + (size_t)NE * 2048 * 1024;
constexpr size_t WL_WIN8 = WL_WDN + (size_t)NE * 1024 * 1024;
constexpr size_t WL_BYTES = WL_WIN8 + (size_t)G1N * 1024;
constexpr size_t WS_END = WS_W + (size_t)DEPTH * WL_BYTES;
static_assert(WS_END < ((size_t)4 << 30), "workspace map exceeds 4 GiB");
static_assert(WS_W % 256 == 0 && WL_BYTES % 256 == 0, "alignment");

constexpr int LDS_BYTES = 160 * 1024;
constexpr int LDS_AUX = 131072;

struct Params {
    const float *x, *c, *ctx, *c_ctx, *w_mod, *b_mod, *norm1_g, *w_in, *q_norm_g, *w_uq, *kv_norm_g, *w_ukv,
                *w_gf, *b_gf, *w_gb, *b_gb, *gla_norm_g, *w_br_mla, *w_br_fnet, *w_br_gla, *w_o, *norm2_g,
                *router_w, *router_b, *w_up, *b_up, *w_down, *b_down, *final_g;
    float* out; char* ws;
};

struct PTab {
    const LAS unsigned long long* t;
    __device__ __forceinline__ unsigned long long get(int i) const { const unsigned long long v = t[i]; const unsigned lo = __builtin_amdgcn_readfirstlane((unsigned)v), hi = __builtin_amdgcn_readfirstlane((unsigned)(v >> 32)); return ((unsigned long long)hi << 32) | lo; }
    __device__ __forceinline__ const float* x() const { return (const float*)(const __attribute__((address_space(1))) float*)get(0); }
    __device__ __forceinline__ const float* c() const { return (const float*)(const __attribute__((address_space(1))) float*)get(1); }
    __device__ __forceinline__ const float* ctx() const { return (const float*)(const __attribute__((address_space(1))) float*)get(2); }
    __device__ __forceinline__ const float* c_ctx() const { return (const float*)(const __attribute__((address_space(1))) float*)get(3); }
    __device__ __forceinline__ const float* w_mod() const { return (const float*)(const __attribute__((address_space(1))) float*)get(4); }
    __device__ __forceinline__ const float* b_mod() const { return (const float*)(const __attribute__((address_space(1))) float*)get(5); }
    __device__ __forceinline__ const float* norm1_g() const { return (const float*)(const __attribute__((address_space(1))) float*)get(6); }
    __device__ __forceinline__ const float* w_in() const { return (const float*)(const __attribute__((address_space(1))) float*)get(7); }
    __device__ __forceinline__ const float* q_norm_g() const { return (const float*)(const __attribute__((address_space(1))) float*)get(8); }
    __device__ __forceinline__ const float* w_uq() const { return (const float*)(const __attribute__((address_space(1))) float*)get(9); }
    __device__ __forceinline__ const float* kv_norm_g() const { return (const float*)(const __attribute__((address_space(1))) float*)get(10); }
    __device__ __forceinline__ const float* w_ukv() const { return (const float*)(const __attribute__((address_space(1))) float*)get(11); }
    __device__ __forceinline__ const float* w_gf() const { return (const float*)(const __attribute__((address_space(1))) float*)get(12); }
    __device__ __forceinline__ const float* b_gf() const { return (const float*)(const __attribute__((address_space(1))) float*)get(13); }
    __device__ __forceinline__ const float* w_gb() const { return (const float*)(const __attribute__((address_space(1))) float*)get(14); }
    __device__ __forceinline__ const float* b_gb() const { return (const float*)(const __attribute__((address_space(1))) float*)get(15); }
    __device__ __forceinline__ const float* gla_norm_g() const { return (const float*)(const __attribute__((address_space(1))) float*)get(16); }
    __device__ __forceinline__ const float* w_br_mla() const { return (const float*)(const __attribute__((address_space(1))) float*)get(17); }
    __device__ __forceinline__ const float* w_br_fnet() const { return (const float*)(const __attribute__((address_space(1))) float*)get(18); }
    __device__ __forceinline__ const float* w_br_gla() const { return (const float*)(const __attribute__((address_space(1))) float*)get(19); }
    __device__ __forceinline__ const float* w_o() const { return (const float*)(const __attribute__((address_space(1))) float*)get(20); }
    __device__ __forceinline__ const float* norm2_g() const { return (const float*)(const __attribute__((address_space(1))) float*)get(21); }
    __device__ __forceinline__ const float* router_w() const { return (const float*)(const __attribute__((address_space(1))) float*)get(22); }
    __device__ __forceinline__ const float* router_b() const { return (const float*)(const __attribute__((address_space(1))) float*)get(23); }
    __device__ __forceinline__ const float* w_up() const { return (const float*)(const __attribute__((address_space(1))) float*)get(24); }
    __device__ __forceinline__ const float* b_up() const { return (const float*)(const __attribute__((address_space(1))) float*)get(25); }
    __device__ __forceinline__ const float* w_down() const { return (const float*)(const __attribute__((address_space(1))) float*)get(26); }
    __device__ __forceinline__ const float* b_down() const { return (const float*)(const __attribute__((address_space(1))) float*)get(27); }
    __device__ __forceinline__ const float* final_g() const { return (const float*)(const __attribute__((address_space(1))) float*)get(28); }
    __device__ __forceinline__ float* out() const { return (float*)(__attribute__((address_space(1))) float*)get(29); }
    __device__ __forceinline__ char* ws() const { return (char*)(__attribute__((address_space(1))) char*)get(30); }
};
constexpr int LDS_PTAB = LDS_AUX + 24576;

__device__ __forceinline__ int ltid() { int t = (int)threadIdx.x; asm volatile("" : "+v"(t)); return t; }
__device__ __forceinline__ int lsgpr(int v) { asm volatile("" : "+s"(v)); return v; }
__device__ __forceinline__ LAS unsigned char* lds_launder(LAS unsigned char* p) { unsigned a = (unsigned)(unsigned long long)p; asm volatile("" : "+s"(a)); return (LAS unsigned char*)(unsigned long long)a; }

typedef __bf16 bf16x2_t __attribute__((ext_vector_type(2)));
template <int K> __device__ __forceinline__ float lane_xor(float v, int lane) {
    if constexpr (K == 32) { const auto rr = __builtin_amdgcn_permlane32_swap(__float_as_uint(v), __float_as_uint(v), false, false); return __uint_as_float((lane & 32) ? rr[0] : rr[1]); }
    else return __int_as_float(__builtin_amdgcn_ds_swizzle(__float_as_int(v), (K << 10) | 0x1f));
}
__device__ __forceinline__ float half_sum32(float v) { const auto rr = __builtin_amdgcn_permlane32_swap(__float_as_uint(v), __float_as_uint(v), false, false); return __uint_as_float(rr[0]) + __uint_as_float(rr[1]); }
__device__ __forceinline__ float half_max32(float v) { const auto rr = __builtin_amdgcn_permlane32_swap(__float_as_uint(v), __float_as_uint(v), false, false); return fmaxf(__uint_as_float(rr[0]), __uint_as_float(rr[1])); }
__device__ __forceinline__ float wave_sum(float v) { v += lane_xor<1>(v, 0); v += lane_xor<2>(v, 0); v += lane_xor<4>(v, 0); v += lane_xor<8>(v, 0); v += lane_xor<16>(v, 0); return half_sum32(v); }

__device__ __forceinline__ unsigned cvt_pk_bf16(float lo, float hi) { const f32x2 v = {lo, hi}; const bf16x2_t b = __builtin_convertvector(v, bf16x2_t); return __builtin_bit_cast(unsigned, b); }
__device__ __forceinline__ unsigned cvt4_fp8(float a, float b, float c, float d) { int w = 0; w = __builtin_amdgcn_cvt_pk_fp8_f32(a, b, w, false); w = __builtin_amdgcn_cvt_pk_fp8_f32(c, d, w, true); return (unsigned)w; }
__device__ __forceinline__ float sat8(float x) { x = __builtin_fmaxf(x, -448.0f); asm volatile("" : "+v"(x)); return __builtin_fminf(x, 448.0f); }
__device__ __forceinline__ unsigned cvt4_fp8s(float a, float b, float c, float d) { return cvt4_fp8(sat8(a), sat8(b), sat8(c), sat8(d)); }
constexpr float YM_SCALE = 16.0f;
constexpr float W8_SCALE = 128.0f;
constexpr int W8_E8M0 = 0x78787878, ONE_E8M0 = 0x7f7f7f7f;
__device__ __forceinline__ void cvt_fp8x4(unsigned w, float& a, float& b, float& c, float& d) { const f32x2 lo = __builtin_amdgcn_cvt_pk_f32_fp8((int)w, false), hi = __builtin_amdgcn_cvt_pk_f32_fp8((int)w, true); a = lo.x; b = lo.y; c = hi.x; d = hi.y; }
__device__ __forceinline__ bf16_t f2bf(float f) { return (bf16_t)(cvt_pk_bf16(f, 0.f) & 0xffffu); }
__device__ __forceinline__ float bf2f(bf16_t b) { return __uint_as_float(((unsigned)b) << 16); }
typedef _Float16 f16x2_t __attribute__((ext_vector_type(2)));
__device__ __forceinline__ unsigned pk_f16(float a, float b) { const f16x2_t v = {(_Float16)a, (_Float16)b}; return __builtin_bit_cast(unsigned, v); }
__device__ __forceinline__ void un_f16(unsigned w, float& a, float& b) { const f16x2_t v = __builtin_bit_cast(f16x2_t, w); a = (float)v[0]; b = (float)v[1]; }
__device__ __forceinline__ float bflo(unsigned w) { return __uint_as_float(w << 16); }
__device__ __forceinline__ float bfhi(unsigned w) { return __uint_as_float(w & 0xffff0000u); }
__device__ __forceinline__ float sigmoidf_(float x) { return __builtin_amdgcn_rcpf(1.0f + __expf(-x)); }
__device__ __forceinline__ float siluf_(float x) { return x * __builtin_amdgcn_rcpf(1.0f + __expf(-x)); }

#define XB_TMO      128
#define XB_XCNT(j)  (256  + 64 * (j))
#define XB_XSUB(j)  (1280 + 64 * (j))
#define XB_XGEN(j)  (2304 + 64 * (j))
#define XB_TOP      3328
#define XB_TOPGEN   3392
#define XCD_BAR_WORDS 3456
#define XB_SPIN_CAP (1u << 18)
__device__ __forceinline__ unsigned xb_ld(unsigned* p)              { return __hip_atomic_load(p, __ATOMIC_RELAXED, __HIP_MEMORY_SCOPE_AGENT); }
__device__ __forceinline__ unsigned xb_add(unsigned* p, unsigned v) { return __hip_atomic_fetch_add(p, v, __ATOMIC_RELAXED, __HIP_MEMORY_SCOPE_AGENT); }
__device__ __forceinline__ unsigned xb_xcc_id() { return (unsigned)__builtin_amdgcn_s_getreg((3 << 11) | 20) & 0xFu; }
#define XB_SPIN(cond, bar) do { unsigned _sp = 0; while (cond) { __builtin_amdgcn_s_sleep(1); \
    if ((++_sp & 255u) == 0u) { if (xb_ld(&(bar)[XB_TMO])) break; if (_sp > XB_SPIN_CAP) { atomicAdd(&(bar)[XB_TMO], 1u); break; } } } } while (0)
struct XcdBarrier { unsigned* bar; unsigned x; volatile LAS unsigned* st; };
__device__ __forceinline__ XcdBarrier xcd_barrier_post(unsigned* bar, volatile LAS unsigned* st) {
    XcdBarrier b; b.bar = bar; b.x = xb_xcc_id(); b.st = st;
    if (threadIdx.x == 0) (void)xb_add(&bar[XB_XCNT(b.x)], 1u);
    return b;
}
__device__ __forceinline__ void xcd_barrier_complete(unsigned* bar, unsigned x, unsigned& nloc, unsigned& nx) {
    const unsigned G = gridDim.x * gridDim.y * gridDim.z;
    unsigned sum, cnt, mine, sp = 0u;
    for (;;) {
        sum = 0u; cnt = 0u; mine = 0u;
#pragma unroll
        for (unsigned j = 0; j < 16; ++j) { const unsigned c = xb_ld(&bar[XB_XCNT(j)]); sum += c; cnt += (c > 0u) ? 1u : 0u; mine = (j == x) ? c : mine; }
        if (sum == G) break;
        __builtin_amdgcn_s_sleep(1);
        if ((++sp & 255u) == 0u) { if (xb_ld(&bar[XB_TMO])) break; if (sp > XB_SPIN_CAP) { atomicAdd(&bar[XB_TMO], 1u); break; } }
    }
    nloc = mine > 0u ? mine : 1u; nx = cnt > 0u ? cnt : 1u;
}
__device__ __forceinline__ void xcd_barrier(const XcdBarrier& b) {
    asm volatile("s_waitcnt vmcnt(0)" ::: "memory");
    __syncthreads();
    if (threadIdx.x == 0) {
        unsigned* bar = b.bar;
        __builtin_amdgcn_s_waitcnt(0);
        unsigned nloc = b.st[0], nx = b.st[1];
        if (nloc == 0u) { xcd_barrier_complete(bar, b.x, nloc, nx); b.st[0] = nloc; b.st[1] = nx; }
        const unsigned old = xb_add(&bar[XB_XSUB(b.x)], 1u);
        const unsigned gen = old / nloc;
        if (old + 1u == (gen + 1u) * nloc) {
            __builtin_amdgcn_fence(__ATOMIC_RELEASE, "agent");
            asm volatile("s_waitcnt vmcnt(0)" ::: "memory");
            const unsigned og = xb_add(&bar[XB_TOP], 1u);
            const unsigned tg = og / nx;
            if (og + 1u == (tg + 1u) * nx) xb_add(&bar[XB_TOPGEN], 1u);
            else XB_SPIN(xb_ld(&bar[XB_TOPGEN]) == tg, bar);
            __builtin_amdgcn_fence(__ATOMIC_ACQUIRE, "agent");
            xb_add(&bar[XB_XGEN(b.x)], 1u);
            asm volatile("s_waitcnt vmcnt(0)" ::: "memory");
        } else {
            XB_SPIN(xb_ld(&bar[XB_XGEN(b.x)]) == gen, bar);
            __builtin_amdgcn_fence(__ATOMIC_ACQUIRE, "agent");
            asm volatile("s_waitcnt vmcnt(0)" ::: "memory");
        }
    }
    __syncthreads();
}

__device__ __forceinline__ void grid_sync(const XcdBarrier& b) {
    XcdBarrier c = b; unsigned long long p = (unsigned long long)c.bar; unsigned x = c.x, st = (unsigned)(unsigned long long)c.st;
    asm volatile("" : "+s"(p), "+s"(x), "+s"(st));
    c.bar = (unsigned*)(__attribute__((address_space(1))) unsigned*)p; c.x = x; c.st = (volatile LAS unsigned*)(unsigned long long)st;
    xcd_barrier(c);
}
#ifndef GK_ALIGN_EPI
#define GK_ALIGN_EPI 1
#endif
typedef int i32x8 __attribute__((ext_vector_type(8)));
namespace gk {
constexpr int BM = 256, BK = 64, HALF = 128, HTB = HALF * BK * 2, STAGE_BYTES = 8 * HTB;
__device__ __forceinline__ int lds_byte(int r, int c) { const int st = (r >> 4) * 2 + (c >> 5), rr = r & 15, cc = c & 31, ob = rr * 64 + cc * 2; return st * 1024 + (ob ^ (((ob >> 9) & 1) << 5)); }
__device__ __forceinline__ void stage_rc(int b, int& R, int& C) { const int st = b / 1024, sb = b % 1024, swz = sb ^ (((sb >> 9) & 1) << 5); R = (st >> 1) * 16 + swz / 64; C = (st & 1) * 32 + (swz % 64) / 2; }
__device__ __forceinline__ int perm32(int rho) { const int n = rho >> 4, i = rho & 15; return 8 * (i >> 2) + 4 * n + (i & 3); }

struct Unit {
    const char* A; const char* B;
    unsigned lda2, ldb2;
    int nt;
    int pm;
    int info;
    __device__ __forceinline__ int pn() const { return info & 0xff; }
    __device__ __forceinline__ int aux() const { return (info >> 8) & 0xff; }
    __device__ __forceinline__ int kind() const { return (info >> 16) & 0xff; }
    __device__ __forceinline__ int keep() const { return (info >> 24) & 1; }
    __device__ __forceinline__ void set(int pm_, int pn_, int aux_, int kind_, int keep_) { pm = pm_; info = pn_ | (aux_ << 8) | (kind_ << 16) | (keep_ << 24); }
};
typedef f32x4 Acc[2][2][4][2];

template <bool F8> struct FragT { typedef bf16x8 A4[4][2]; typedef bf16x8 B2[2][2]; };
template <> struct FragT<true> { typedef i32x8 A4[4]; typedef i32x8 B2[2]; };
__device__ __forceinline__ void frag_ld(bf16x8 (&d)[2], const LAS unsigned char* p) { d[0] = *(const LAS bf16x8*)p; d[1] = *(const LAS bf16x8*)(p + 1024); }
__device__ __forceinline__ void frag_ld(i32x8& d, const LAS unsigned char* p) { const u32x4 lo = *(const LAS u32x4*)p, hi = *(const LAS u32x4*)(p + 1024);
    d = (i32x8){(int)lo.x, (int)lo.y, (int)lo.z, (int)lo.w, (int)hi.x, (int)hi.y, (int)hi.z, (int)hi.w}; }
__device__ __forceinline__ f32x4 frag_mma(const bf16x8 (&b)[2], const bf16x8 (&a)[2], f32x4 c, int) { c = __builtin_amdgcn_mfma_f32_16x16x32_bf16(b[0], a[0], c, 0, 0, 0); return __builtin_amdgcn_mfma_f32_16x16x32_bf16(b[1], a[1], c, 0, 0, 0); }
__device__ __forceinline__ f32x4 frag_mma(const i32x8& b, const i32x8& a, f32x4 c, int sc) { return __builtin_amdgcn_mfma_scale_f32_16x16x128_f8f6f4(b, a, c, 0, 0, 0, sc, 1, sc); }
template <class Sched> __device__ __forceinline__ const char* a_base(const Sched& S, const Unit& u) { if constexpr (Sched::GATHER) return S.gbase; else return u.A; }
template <class Epi, class Sched>
__device__ __forceinline__ void gemm_phase(LAS unsigned char* lds, const Sched& S, const Epi& E) {
    const int tid = ltid(), wid = __builtin_amdgcn_readfirstlane(tid >> 6), lane = tid & 63, wr = wid >> 2, wc = wid & 3, fr = lane & 15, fq = lane >> 4;
#define GK_OFFS(U, a0, a1, b0, b1) do { int tz_ = ltid(); int R0_, C0_, R1_, C1_; stage_rc(tz_ * 16, R0_, C0_); stage_rc(tz_ * 16 + 8192, R1_, C1_); \
        a0 = (unsigned)R0_ * (U).lda2 + (unsigned)C0_ * 2u; a1 = (unsigned)R1_ * (U).lda2 + (unsigned)C1_ * 2u; \
        b0 = (unsigned)((R0_ & ~31) + perm32(R0_ & 31)) * (U).ldb2 + (unsigned)C0_ * 2u; b1 = (unsigned)((R1_ & ~31) + perm32(R1_ & 31)) * (U).ldb2 + (unsigned)C1_ * 2u; } while (0)
#define GK_GLOAD(U, g0, g1, g2, g3) do { int tz_ = ltid(); int R0_, C0_, R1_, C1_; stage_rc(tz_ * 16, R0_, C0_); stage_rc(tz_ * 16 + 8192, R1_, C1_); const int* lst_ = (const int*)(U).A; const int cnt_ = (int)(U).lda2; \
        g0 = (R0_ < cnt_) ? lst_[R0_] : 0; g1 = (R1_ < cnt_) ? lst_[R1_] : 0; g2 = (R0_ + 128 < cnt_) ? lst_[R0_ + 128] : 0; g3 = (R1_ + 128 < cnt_) ? lst_[R1_ + 128] : 0; } while (0)
#define GK_GOFFS(U, g0, g1, g2, g3, a0, a1, ah0, ah1, b0, b1) do { int tz_ = ltid(); int R0_, C0_, R1_, C1_; stage_rc(tz_ * 16, R0_, C0_); stage_rc(tz_ * 16 + 8192, R1_, C1_); \
        a0 = (unsigned)(g0) * (unsigned)Sched::GPITCH + (unsigned)C0_ * 2u; a1 = (unsigned)(g1) * (unsigned)Sched::GPITCH + (unsigned)C1_ * 2u; ah0 = (unsigned)(g2) * (unsigned)Sched::GPITCH + (unsigned)C0_ * 2u; ah1 = (unsigned)(g3) * (unsigned)Sched::GPITCH + (unsigned)C1_ * 2u; \
        b0 = (unsigned)((R0_ & ~31) + perm32(R0_ & 31)) * (U).ldb2 + (unsigned)C0_ * 2u; b1 = (unsigned)((R1_ & ~31) + perm32(R1_ & 31)) * (U).ldb2 + (unsigned)C1_ * 2u; } while (0)
#define GK_STAGE_AH(bufoff, base, hstep) do { if constexpr (Sched::GATHER) GK_STAGE(bufoff, base, cah0, cah1); else GK_STAGE(bufoff, (base) + (hstep), ca0, ca1); } while (0)
#define GK_AB(U) a_base(S, (U))
    const unsigned ldsw = (unsigned)wid * 1024u;
    const int aoff = lds_byte(wr * 64 + fr, fq * 8), boff = lds_byte(wc * 32 + fr, fq * 8);
#define GK_SA(b, h) (((b) * 2 + (h)) * HTB)
#define GK_SB(b, h) ((4 + (b) * 2 + (h)) * HTB)
#define GK_STAGE(bufoff, gbase, v0, v1) do { \
        __builtin_amdgcn_global_load_lds((const unsigned*)((const char*)(gbase) + (v0)), (LAS unsigned*)(lds + (bufoff) + ldsw), 16, 0, 0); \
        __builtin_amdgcn_global_load_lds((const unsigned*)((const char*)(gbase) + (v1)), (LAS unsigned*)(lds + (bufoff) + ldsw + 8192), 16, 0, 0); } while (0)
#define GK_LDA(dst, b, h) do { _Pragma("unroll") for (int m = 0; m < 4; ++m) frag_ld(dst[m], lds + GK_SA(b, h) + aoff + m * 2048); } while (0)
#define GK_LDB(dst, b, h) do { _Pragma("unroll") for (int n = 0; n < 2; ++n) frag_ld(dst[n], lds + GK_SB(b, h) + boff + n * 2048); } while (0)
#define GK_MMA(ai, bj, At, Bt) do { __builtin_amdgcn_s_setprio(1); _Pragma("unroll") for (int m = 0; m < 4; ++m) _Pragma("unroll") for (int n = 0; n < 2; ++n) \
        acc[ai][bj][m][n] = frag_mma(Bt[n], At[m], acc[ai][bj][m][n], sc_w); __builtin_amdgcn_s_setprio(0); } while (0)
#define GK_WAIT_V(n) asm volatile("s_waitcnt vmcnt(" #n ")" ::: "memory")
#define GK_WAIT_L(n) asm volatile("s_waitcnt lgkmcnt(" #n ")" ::: "memory")
#define GK_BAR __builtin_amdgcn_s_barrier()
#define GK_SCHED __builtin_amdgcn_sched_barrier(0)
    Unit cur, nxt; int ui = 0;
    if (!S.next(0, cur)) return;
    int sc_w = (int)((ONE_E8M0 & 0xffffff00u) | (W8_E8M0 & 0xffu)); asm volatile("" : "+v"(sc_w));
    Acc acc;
#pragma unroll
    for (int a = 0; a < 2; ++a)
#pragma unroll
        for (int b = 0; b < 2; ++b)
#pragma unroll
            for (int m = 0; m < 4; ++m)
#pragma unroll
                for (int n = 0; n < 2; ++n) acc[a][b][m][n] = (f32x4){0.f, 0.f, 0.f, 0.f};
    typedef typename FragT<Sched::FP8>::A4 FragA; typedef typename FragT<Sched::FP8>::B2 FragB;
    FragA At; FragB B0, B1;
    unsigned ca0, ca1, cb0, cb1; [[maybe_unused]] unsigned cah0 = 0, cah1 = 0; [[maybe_unused]] int gi0 = 0, gi1 = 0, gi2 = 0, gi3 = 0;
    if constexpr (Sched::GATHER) { GK_GLOAD(cur, gi0, gi1, gi2, gi3); GK_GOFFS(cur, gi0, gi1, gi2, gi3, ca0, ca1, cah0, cah1, cb0, cb1); } else { GK_OFFS(cur, ca0, ca1, cb0, cb1); }
    {
        const char* cA = GK_AB(cur); const char* cB = cur.B; const size_t hA = (size_t)HALF * cur.lda2, hB = (size_t)HALF * cur.ldb2;
        GK_STAGE(GK_SB(0, 0), cB, cb0, cb1); GK_STAGE(GK_SB(0, 1), cB + hB, cb0, cb1); GK_STAGE(GK_SA(0, 0), cA, ca0, ca1); GK_STAGE_AH(GK_SA(0, 1), cA, hA);
        if (wr == 1) GK_BAR;
        GK_WAIT_V(2); GK_BAR;
        GK_STAGE(GK_SB(1, 0), cB + 128, cb0, cb1); GK_STAGE(GK_SA(1, 0), cA + 128, ca0, ca1); GK_STAGE(GK_SB(1, 1), cB + hB + 128, cb0, cb1);
        GK_WAIT_V(6); GK_BAR;
    }
    for (;;) {
        const bool has_next = S.next(ui + 1, nxt);
        if (!has_next) nxt = cur;
        if constexpr (Sched::GATHER) GK_GLOAD(nxt, gi0, gi1, gi2, gi3);
        const size_t hA = (size_t)HALF * cur.lda2, hB = (size_t)HALF * cur.ldb2, nhA = (size_t)HALF * nxt.lda2, nhB = (size_t)HALF * nxt.ldb2;
        const int nt = cur.nt;
        for (int t = 0; t < nt; t += 2) {
            const bool last = (t == nt - 2);
            const char* a1 = GK_AB(cur) + (size_t)(t + 1) * 128;
            const char* a2 = last ? GK_AB(nxt) : GK_AB(cur) + (size_t)(t + 2) * 128; const char* b2 = last ? nxt.B : cur.B + (size_t)(t + 2) * 128;
            const char* a3 = a2 + 128; const char* b3 = b2 + 128;
            const size_t h2A = last ? nhA : hA, h2B = last ? nhB : hB;
            GK_LDB(B0, 0, 0); GK_LDB(B1, 0, 1); GK_SCHED; GK_LDA(At, 0, 0); GK_STAGE_AH(GK_SA(1, 1), a1, hA);
            if (last) { if constexpr (Sched::GATHER) GK_GOFFS(nxt, gi0, gi1, gi2, gi3, ca0, ca1, cah0, cah1, cb0, cb1); else GK_OFFS(nxt, ca0, ca1, cb0, cb1); }
            GK_WAIT_V(8); GK_WAIT_L(0); GK_BAR; GK_MMA(0, 0, At, B0); GK_MMA(0, 1, At, B1); GK_BAR; GK_SCHED;
            GK_LDA(At, 0, 1); GK_STAGE(GK_SB(0, 0), b2, cb0, cb1); GK_STAGE(GK_SB(0, 1), b2 + h2B, cb0, cb1); GK_STAGE(GK_SA(0, 0), a2, ca0, ca1);
            GK_WAIT_V(8); GK_WAIT_L(0); GK_BAR; GK_MMA(1, 0, At, B0); GK_MMA(1, 1, At, B1); GK_BAR; GK_SCHED;
            GK_LDB(B0, 1, 0); GK_LDB(B1, 1, 1); GK_SCHED; GK_LDA(At, 1, 0); GK_STAGE_AH(GK_SA(0, 1), a2, h2A);
            GK_WAIT_V(8); GK_WAIT_L(0); GK_BAR; GK_MMA(0, 0, At, B0); GK_MMA(0, 1, At, B1); GK_BAR; GK_SCHED;
            GK_LDA(At, 1, 1); GK_STAGE(GK_SB(1, 0), b3, cb0, cb1); GK_STAGE(GK_SB(1, 1), b3 + h2B, cb0, cb1); GK_STAGE(GK_SA(1, 0), a3, ca0, ca1);
            GK_WAIT_V(8); GK_WAIT_L(0); GK_BAR; GK_MMA(1, 0, At, B0); GK_MMA(1, 1, At, B1); GK_BAR; GK_SCHED;
        }
        if (GK_ALIGN_EPI && wr == 0) GK_BAR;
        { const int tz_ = ltid(), wz_ = __builtin_amdgcn_readfirstlane(tz_ >> 6), lz_ = tz_ & 63;
          E(acc, cur, wz_ >> 2, wz_ & 3, lz_ & 15, lz_ >> 4); }
        if (!has_next) break;
        if (!cur.keep()) {
#pragma unroll
            for (int a = 0; a < 2; ++a)
#pragma unroll
                for (int b = 0; b < 2; ++b)
#pragma unroll
                    for (int m = 0; m < 4; ++m)
#pragma unroll
                        for (int n = 0; n < 2; ++n) acc[a][b][m][n] = (f32x4){0.f, 0.f, 0.f, 0.f};
        }
        cur = nxt; ++ui;
        if (GK_ALIGN_EPI && wr == 1) GK_BAR;
    }
    GK_WAIT_V(0);
    if (!GK_ALIGN_EPI && wr == 0) GK_BAR;
    GK_BAR;
#undef GK_OFFS
#undef GK_GLOAD
#undef GK_GOFFS
#undef GK_STAGE_AH
#undef GK_AB
#undef GK_SA
#undef GK_SB
#undef GK_STAGE
#undef GK_LDA
#undef GK_LDB
#undef GK_MMA
#undef GK_WAIT_V
#undef GK_WAIT_L
#undef GK_BAR
#undef GK_SCHED
}

__device__ __forceinline__ void tile_order(int L, int nM, int nN, int& pm, int& pn) {
    const int nwg = nM * nN; int wgid = L;
    { const int q = nwg / 8, r = nwg % 8, xcd = wgid % 8, off = wgid / 8; wgid = (xcd < r ? xcd * (q + 1) : r * (q + 1) + (xcd - r) * q) + off; }
    const int nig = 8 * nN, gid = wgid / nig, fm = gid * 8, gsz = (nM - fm) < 8 ? (nM - fm) : 8;
    pm = fm + ((wgid % nig) % gsz); pn = (wgid % nig) / gsz;
}
}
template <class ColF>
__device__ __forceinline__ void cvt_tr(const float* __restrict__ src, int ld_src, int Ksrc, bf16_t* __restrict__ dst, int Kdst, int N, const ColF& colf, const float* __restrict__ kscale,
                                       unsigned& ctr, int G, int c) {
    const int tid = ltid(), lane = tid & 63, wid = __builtin_amdgcn_readfirstlane(tid >> 6);
    const int nkt = Kdst / 256, nnt = N / 64, ntile = nkt * nnt;
    const int t0 = (int)(((unsigned)c + (unsigned)G - (ctr % (unsigned)G)) % (unsigned)G);
    for (int tt = t0; tt < ntile; tt += G) {
        const int kt = tt / nnt, nt_ = tt % nnt, n = nt_ * 64 + lane, kb = kt * 256 + wid * 32;
        float mul; const int sc = colf(n, mul);
        const float* sp = src + (size_t)kb * ld_src + (sc >= 0 ? sc : 0);
        float v[32];
#pragma unroll
        for (int j = 0; j < 32; ++j) v[j] = (kb + j < Ksrc) ? sp[(size_t)j * ld_src] : 0.f;
        if (sc < 0) mul = 0.f;
#pragma unroll
        for (int j = 0; j < 32; ++j) { float m2 = mul; if (kscale) m2 *= (kb + j < Ksrc) ? kscale[kb + j] : 0.f; v[j] *= m2; }
        bf16_t* dp = dst + (size_t)n * Kdst + kb;
#pragma unroll
        for (int q = 0; q < 4; ++q) { u32x4 w; w.x = cvt_pk_bf16(v[8 * q], v[8 * q + 1]); w.y = cvt_pk_bf16(v[8 * q + 2], v[8 * q + 3]); w.z = cvt_pk_bf16(v[8 * q + 4], v[8 * q + 5]); w.w = cvt_pk_bf16(v[8 * q + 6], v[8 * q + 7]);
            *(u32x4*)(dp + 8 * q) = w; }
    }
    ctr += (unsigned)ntile;
}

template <class ColF>
__device__ __forceinline__ void cvt_tr8(const float* __restrict__ src, int ld_src, unsigned char* __restrict__ dst, int Kdst, int N, const ColF& colf, float mul0, unsigned& ctr, int G, int c) {
    const int tid = ltid(), lane = tid & 63, wid = __builtin_amdgcn_readfirstlane(tid >> 6);
    const int nkt = Kdst / 256, nnt = N / 64, ntile = nkt * nnt;
    const int t0 = (int)(((unsigned)c + (unsigned)G - (ctr % (unsigned)G)) % (unsigned)G);
    for (int tt = t0; tt < ntile; tt += G) {
        const int kt = tt / nnt, nt_ = tt % nnt, n = nt_ * 64 + lane, kb = kt * 256 + wid * 32;
        float mul; const int sc = colf(n, mul); mul *= mul0; if (sc < 0) mul = 0.f;
        const float* sp = src + (size_t)kb * ld_src + (sc >= 0 ? sc : 0);
        float v[32];
#pragma unroll
        for (int j = 0; j < 32; ++j) v[j] = sp[(size_t)j * ld_src] * mul;
        unsigned char* dp = dst + (size_t)n * Kdst + kb;
#pragma unroll
        for (int q = 0; q < 2; ++q) { u32x4 w; w.x = cvt4_fp8s(v[16 * q], v[16 * q + 1], v[16 * q + 2], v[16 * q + 3]); w.y = cvt4_fp8s(v[16 * q + 4], v[16 * q + 5], v[16 * q + 6], v[16 * q + 7]);
            w.z = cvt4_fp8s(v[16 * q + 8], v[16 * q + 9], v[16 * q + 10], v[16 * q + 11]); w.w = cvt4_fp8s(v[16 * q + 12], v[16 * q + 13], v[16 * q + 14], v[16 * q + 15]);
            *(u32x4*)(dp + 16 * q) = w; }
    }
    ctr += (unsigned)ntile;
}

__device__ __forceinline__ int g1_col(int n, float& mul) {
    mul = 1.0f;
    if (n < 256) return CO_Q + n;
    if (n < 512) { const int r = n - 256; if (r < 160) return CO_KV + r; if (r < 176) return CO_GF + (r - 160); if (r < 192) return CO_GB + (r - 176); return -1; }
    if (n < 1024) return CO_FN + (n - 512);
    if (n < 1280) { mul = 0.125f; return CO_GQ + (n - 1024); }
    if (n < 1536) return CO_GK + (n - 1280);
    if (n < 2048) return CO_GV + (n - 1536);
    if (n < 2560) return CO_OG + (n - 2048);
    return CO_GATE + (n - 2560);
}
__device__ __forceinline__ int uq_col(int n, float& mul) {
    mul = 1.0f;
    if (n < 512) return (n >> 6) * 96 + (n & 63);
    const int r = n - 512, h = r >> 5, j = r & 31, axis = j >> 4, i = (j & 15) >> 1;
    return h * 96 + 64 + axis * 16 + i + 8 * (j & 1);
}
__device__ __forceinline__ int ukv_col(int n, float& mul) { mul = 1.0f; if (n < 512) return (n >> 6) * 128 + (n & 63); const int r = n - 512; return (r >> 6) * 128 + 64 + (r & 63); }
__device__ __forceinline__ int ident_col(int n, float& mul) { mul = 1.0f; return n; }
__device__ __forceinline__ int up_col(int n, float& mul) { mul = 1.0f; const int pn = n >> 8, r = n & 255; return r < 128 ? pn * 128 + r : 1024 + pn * 128 + (r - 128); }

struct G1ColF { __device__ int operator()(int n, float& m) const { return g1_col(n, m); } };
struct UqColF { __device__ int operator()(int n, float& m) const { return uq_col(n, m); } };
struct UkvColF { __device__ int operator()(int n, float& m) const { return ukv_col(n, m); } };
struct IdColF { __device__ int operator()(int n, float& m) const { return ident_col(n, m); } };
struct G1ColF8 { __device__ int operator()(int n, float& m) const { return g1_col(n + 2560, m); } };
struct UpColF { __device__ int operator()(int n, float& m) const { return up_col(n, m); } };

__device__ __forceinline__ void cvt_experts(const PTab& p, char* ws, int G, int c) {
    const int tid = ltid(), lane = tid & 63, wid = __builtin_amdgcn_readfirstlane(tid >> 6);
    constexpr int NUP = 128 * 32, NIT = NUP + 128 * 16;
    for (int it = c; it < NIT; it += G) {
        const float* sp; unsigned char* dp; int ld;
        if (it < NUP) { const int mat = it >> 5, n = (it & 31) * 64 + lane; float mul; const int sc = up_col(n, mul);
            sp = p.w_up() + ((size_t)mat * 1024 + wid * 128) * 2048 + sc; ld = 2048;
            dp = (unsigned char*)(ws + WS_W + (size_t)(mat >> 5) * WL_BYTES + WL_WUP) + (size_t)(mat & 31) * 2048 * 1024 + (size_t)n * 1024 + wid * 128; }
        else { const int i2 = it - NUP, mat = i2 >> 4, n = (i2 & 15) * 64 + lane;
            sp = p.w_down() + ((size_t)mat * 1024 + wid * 128) * 1024 + n; ld = 1024;
            dp = (unsigned char*)(ws + WS_W + (size_t)(mat >> 5) * WL_BYTES + WL_WDN) + (size_t)(mat & 31) * 1024 * 1024 + (size_t)n * 1024 + wid * 128; }
        float v[128];
#pragma unroll
        for (int j = 0; j < 128; ++j) v[j] = sp[(size_t)j * ld];
#pragma unroll
        for (int q = 0; q < 8; ++q) { u32x4 w;
            w.x = cvt4_fp8s(v[16 * q] * W8_SCALE, v[16 * q + 1] * W8_SCALE, v[16 * q + 2] * W8_SCALE, v[16 * q + 3] * W8_SCALE);
            w.y = cvt4_fp8s(v[16 * q + 4] * W8_SCALE, v[16 * q + 5] * W8_SCALE, v[16 * q + 6] * W8_SCALE, v[16 * q + 7] * W8_SCALE);
            w.z = cvt4_fp8s(v[16 * q + 8] * W8_SCALE, v[16 * q + 9] * W8_SCALE, v[16 * q + 10] * W8_SCALE, v[16 * q + 11] * W8_SCALE);
            w.w = cvt4_fp8s(v[16 * q + 12] * W8_SCALE, v[16 * q + 13] * W8_SCALE, v[16 * q + 14] * W8_SCALE, v[16 * q + 15] * W8_SCALE);
            *(u32x4*)(dp + 16 * q) = w; }
    }
}

__device__ __forceinline__ void prologue_phase(const PTab& p, LAS unsigned char* lds, int G, int c) {
    const int tid = ltid();
    char* ws = p.ws();
    if (c == 0) {
        float* R = (float*)(ws + WS_ROPE);
        const int pos = tid >> 3, i = tid & 7;
        const float inv = powf(10000.0f, -(float)(2 * i) / 16.0f), ang = (float)pos * inv;
        R[tid * 2] = cosf(ang); R[tid * 2 + 1] = sinf(ang);
    }
    {
        bf16_t* DB = (bf16_t*)(ws + WS_DB);
        for (int i = c * 512 + tid; i < 512 * 512 / 8; i += G * 512) {
            const int r = i >> 6, q0 = (i & 63) * 8, k1 = r & 255; float v[8];
#pragma unroll
            for (int j = 0; j < 8; ++j) { const int q = q0 + j, t1 = q & 255; const int m = (k1 * t1) & 255; float s, co; sincospif((float)m * (1.0f / 128.0f), &s, &co);
                const float val = (r < 256) ? ((q < 256) ? co : s) : ((q < 256) ? s : -co); v[j] = val * (1.0f / 64.0f); }
            u32x4 w; w.x = cvt_pk_bf16(v[0], v[1]); w.y = cvt_pk_bf16(v[2], v[3]); w.z = cvt_pk_bf16(v[4], v[5]); w.w = cvt_pk_bf16(v[6], v[7]);
            *(u32x4*)(DB + (size_t)i * 8) = w;
        }
        float* TW = (float*)(ws + WS_TW);
        for (int i = c * 512 + tid; i < 16 * 256; i += G * 512) { const int k2 = i >> 8, t1 = i & 255; float s, co; sincospif((float)(k2 * t1) * (1.0f / 2048.0f), &s, &co); TW[2 * i] = co; TW[2 * i + 1] = s; }
        bf16_t* DC = (bf16_t*)(ws + WS_DFTC);
        for (int i = c * 512 + tid; i < 512 * 256 / 8; i += G * 512) {
            const int r = i >> 5, t0 = (i & 31) * 8, k = r & 255; float v[8];
#pragma unroll
            for (int j = 0; j < 8; ++j) { const int m = (k * (t0 + j)) & 255; float s, co; sincospif((float)m * (1.0f / 128.0f), &s, &co); v[j] = (r < 256 ? co : s) * (1.0f / 16.0f); }
            u32x4 w; w.x = cvt_pk_bf16(v[0], v[1]); w.y = cvt_pk_bf16(v[2], v[3]); w.z = cvt_pk_bf16(v[4], v[5]); w.w = cvt_pk_bf16(v[6], v[7]);
            *(u32x4*)(DC + (size_t)i * 8) = w;
        }
    }
#ifndef PRO_REP_D
#define PRO_REP_D 1
#endif
#ifndef PRO_REP_E
#define PRO_REP_E 1
#endif
    {
        for (int rep_ = 0; rep_ < PRO_REP_D; ++rep_) {
        LAS float* sl = (LAS float*)lds;
        LAS float* red = (LAS float*)(lds + 40960);
        { const float* cc = p.c(); const float* ccx = p.c_ctx();
          for (int i = tid; i < 9 * 1024; i += 512) { const int s = i >> 10, k = i & 1023; const float v = (s < 8) ? cc[s * 1024 + k] : ccx[k]; sl[i] = siluf_(v); } }
        __syncthreads();
        const float* wm = p.w_mod(); const float* bmod = p.b_mod();
        for (int job = c; job < DEPTH * 48; job += G) {
            const int l = job / 48, jl = tid & 127, kq = tid >> 7, j = (job % 48) * 128 + jl;
            const float* W = wm + (size_t)l * 1024 * 6144 + (size_t)(kq * 256) * 6144 + j;
            float a[9];
#pragma unroll
            for (int s = 0; s < 9; ++s) a[s] = 0.f;
            for (int k0 = 0; k0 < 256; k0 += 32) { float w[32];
#pragma unroll
                for (int q = 0; q < 32; ++q) w[q] = W[(size_t)(k0 + q) * 6144];
#pragma unroll
                for (int q4 = 0; q4 < 8; ++q4)
#pragma unroll
                    for (int s = 0; s < 9; ++s) { const f32x4 t = *(const LAS f32x4*)(sl + s * 1024 + kq * 256 + k0 + 4 * q4);
                        a[s] += t[0] * w[4 * q4] + t[1] * w[4 * q4 + 1] + t[2] * w[4 * q4 + 2] + t[3] * w[4 * q4 + 3]; } }
#pragma unroll
            for (int s = 0; s < 9; ++s) red[(kq * 9 + s) * 128 + jl] = a[s];
            __syncthreads();
            for (int i = tid; i < 9 * 128; i += 512) { const int s = i >> 7, jj = i & 127, col = (job % 48) * 128 + jj;
                ((float*)(ws + WS_MOD))[((size_t)l * 9 + s) * 6144 + col] = red[(0 * 9 + s) * 128 + jj] + red[(1 * 9 + s) * 128 + jj] + red[(2 * 9 + s) * 128 + jj] + red[(3 * 9 + s) * 128 + jj] + bmod[l * 6144 + col]; }
            __syncthreads();
        }
        }
    }
    {
        for (int rep_ = 0; rep_ < PRO_REP_E; ++rep_) {
        LAS float* TT = (LAS float*)lds;
        LAS float* tile = (LAS float*)(lds + 65536);
        const int kt = (c >> 4) & 15, jt = c & 15, part = kt >> 3;
        if (G % 256 == 0) {
            for (int i = tid; i < 128 * 128; i += 512) { const int m = i >> 7, cc = i & 127; float sn, co; sincospif((float)((m * cc) & 127) * (1.0f / 64.0f), &sn, &co); TT[i] = part ? sn : co; }
        }
        __syncthreads();
        for (int job = c; job < DEPTH * 256; job += G) {
            const int l = job >> 8;
            int kt_ = kt, jt_ = jt;
            if (G % 256 != 0) {
                kt_ = (job >> 4) & 15; jt_ = job & 15; const int pj = kt_ >> 3;
                __syncthreads();
                for (int i = tid; i < 128 * 128; i += 512) { const int m = i >> 7, cc = i & 127; float sn, co; sincospif((float)((m * cc) & 127) * (1.0f / 64.0f), &sn, &co); TT[i] = pj ? sn : co; }
                __syncthreads();
            }
            const int jl = tid & 63, kg = __builtin_amdgcn_readfirstlane(tid >> 6);
            const int kidx0 = kt_ * 64 + kg * 8, pj = kidx0 >> 9, g = (kidx0 >> 7) & 3, cc0 = kidx0 & 127;
            const float* W = p.w_br_fnet() + (size_t)l * 512 * 1024 + (size_t)(g * 128) * 1024 + jt_ * 64 + jl;
            float a[8];
#pragma unroll
            for (int q = 0; q < 8; ++q) a[q] = 0.f;
#pragma unroll
            for (int mh = 0; mh < 2; ++mh) {
                float w[64];
#pragma unroll
                for (int m = 0; m < 64; ++m) w[m] = W[(size_t)(mh * 64 + m) * 1024];
#pragma unroll
                for (int m = 0; m < 64; ++m) { const f32x4 t0 = *(const LAS f32x4*)(TT + (mh * 64 + m) * 128 + cc0), t1 = *(const LAS f32x4*)(TT + (mh * 64 + m) * 128 + cc0 + 4);
                    a[0] += w[m] * t0[0]; a[1] += w[m] * t0[1]; a[2] += w[m] * t0[2]; a[3] += w[m] * t0[3]; a[4] += w[m] * t1[0]; a[5] += w[m] * t1[1]; a[6] += w[m] * t1[2]; a[7] += w[m] * t1[3]; }
            }
            const float sc = (pj ? -1.0f : 1.0f) * 0.08838834764831845f;
#pragma unroll
            for (int q = 0; q < 8; ++q) tile[(kg * 8 + q) * 65 + jl] = a[q] * sc;
            __syncthreads();
            { unsigned char* dst = (unsigned char*)(ws + WS_W + (size_t)l * WL_BYTES + WL_WF);
              const int kp = tid & 15, nl0 = tid >> 4;
#pragma unroll
              for (int i = 0; i < 2; ++i) { const int nl = nl0 + 32 * i;
                  *(unsigned*)(dst + (size_t)(jt_ * 64 + nl) * 1024 + kt_ * 64 + 4 * kp) = cvt4_fp8s(tile[(4 * kp) * 65 + nl] * W8_SCALE, tile[(4 * kp + 1) * 65 + nl] * W8_SCALE, tile[(4 * kp + 2) * 65 + nl] * W8_SCALE, tile[(4 * kp + 3) * 65 + nl] * W8_SCALE); } }
            __syncthreads();
        }
        __syncthreads(); }
    }
    {
        unsigned ctr = 0;
        for (int l = 0; l < DEPTH; ++l) {
            char* wl = ws + WS_W + (size_t)l * WL_BYTES;
            cvt_tr(p.w_in() + (size_t)l * 1024 * INW, INW, 1024, (bf16_t*)(wl + WL_WIN), 1024, 2560, G1ColF(), nullptr, ctr, G, c);
            cvt_tr8(p.w_in() + (size_t)l * 1024 * INW, INW, (unsigned char*)(wl + WL_WIN8) + (size_t)2560 * 1024, 1024, G1N - 2560, G1ColF8(), W8_SCALE, ctr, G, c);
            cvt_tr(p.w_uq() + (size_t)l * 256 * 768, 768, 256, (bf16_t*)(wl + WL_WUQ), 256, 768, UqColF(), p.q_norm_g() + l * 256, ctr, G, c);
            cvt_tr(p.w_ukv() + (size_t)l * 128 * 1024, 1024, 128, (bf16_t*)(wl + WL_WUKV), 256, 1024, UkvColF(), p.kv_norm_g() + l * 128, ctr, G, c);
            cvt_tr8(p.w_br_mla() + (size_t)l * 512 * 1024, 1024, (unsigned char*)(wl + WL_WM), 512, 1024, IdColF(), W8_SCALE, ctr, G, c);
            cvt_tr8(p.w_br_gla() + (size_t)l * 512 * 1024, 1024, (unsigned char*)(wl + WL_WG), 512, 1024, IdColF(), W8_SCALE, ctr, G, c);
            cvt_tr8(p.w_o() + (size_t)l * 1024 * 1024, 1024, (unsigned char*)(wl + WL_WO), 1024, 1024, IdColF(), W8_SCALE, ctr, G, c);
        }
#ifndef PRO_REP_F
#define PRO_REP_F 1
#endif
        for (int rf_ = 0; rf_ < PRO_REP_F; ++rf_) cvt_experts(p, ws, G, c);
    }
}

__device__ __forceinline__ void norm_mod_row(const float* __restrict__ xrow, const float* __restrict__ g, const float* __restrict__ shift, const float* __restrict__ scale, bf16_t* __restrict__ hrow, unsigned char* __restrict__ h8row, int lane) {
    f32x4 v[4]; float ss = 0.f;
#pragma unroll
    for (int i = 0; i < 4; ++i) { v[i] = *(const f32x4*)(xrow + i * 256 + lane * 4); ss += v[i][0] * v[i][0] + v[i][1] * v[i][1] + v[i][2] * v[i][2] + v[i][3] * v[i][3]; }
    ss = wave_sum(ss);
    const float rs = rsqrtf(ss * (1.0f / 1024.0f) + EPS);
#pragma unroll
    for (int i = 0; i < 4; ++i) { const int col = i * 256 + lane * 4; const f32x4 gg = *(const f32x4*)(g + col), sh = *(const f32x4*)(shift + col), sc = *(const f32x4*)(scale + col);
        float o[4];
#pragma unroll
        for (int j = 0; j < 4; ++j) o[j] = v[i][j] * rs * gg[j] * (1.0f + sc[j]) + sh[j];
        u32x2 w; w.x = cvt_pk_bf16(o[0], o[1]); w.y = cvt_pk_bf16(o[2], o[3]); *(u32x2*)(hrow + col) = w; *(unsigned*)(h8row + col) = cvt4_fp8s(o[0], o[1], o[2], o[3]); }
}
__device__ __forceinline__ void norm1_phase(const PTab& p, int l, int G, int c) {
    const int tid_ = ltid(), wid = tid_ >> 6, lane = tid_ & 63; char* ws = p.ws();
    const float* px = p.x(); const float* pctx = p.ctx(); bf16_t* H = (bf16_t*)(ws + WS_H);
    const float* M = (const float*)(ws + WS_MOD) + (size_t)l * 9 * 6144; const float* n1g = p.norm1_g() + l * D;
    for (int row = c * 8 + wid; row < T; row += G * 8) {
        const int b = row / RPB, r = row % RPB, s = r < CTX ? 8 : b;
        const float* xrow = (r < CTX) ? pctx + (size_t)(b * CTX + r) * D : px + (size_t)(b * SEQ + (r - CTX)) * D;
        norm_mod_row(xrow, n1g, M + s * 6144, M + s * 6144 + 1024, H + (size_t)row * D, (unsigned char*)(ws + WS_HA8) + (size_t)row * D, lane);
    }
}

__device__ __forceinline__ void dft_stage_a(char* ws, int G, int c) {
    const int tid = ltid(), t1 = tid & 255, cc = tid >> 8;
    const bf16_t* UFT = (const bf16_t*)(ws + WS_UFT); bf16_t* HB = (bf16_t*)(ws + WS_DFTL); const f32x2* TW = (const f32x2*)(ws + WS_TW);
    constexpr float C16[9] = {1.0f, 0.9238795325f, 0.7071067812f, 0.3826834324f, 0.0f, -0.3826834324f, -0.7071067812f, -0.9238795325f, -1.0f};
    constexpr float S16[9] = {0.0f, 0.3826834324f, 0.7071067812f, 0.9238795325f, 1.0f, 0.9238795325f, 0.7071067812f, 0.3826834324f, 0.0f};
    f32x2 tw[16];
#pragma unroll
    for (int k2 = 0; k2 < 16; ++k2) tw[k2] = TW[k2 * 256 + t1];
    int it = c; if (it >= NB * 256) return;
    unsigned short ur[16];
    { const bf16_t* up = UFT + ((size_t)((it >> 8) * 512 + (it & 255) * 2 + cc)) * RPB + CTX + t1;
#pragma unroll
      for (int j = 0; j < 16; ++j) ur[j] = up[j * 256]; }
    for (;;) {
        const int nx = it + G; unsigned short un[16];
#pragma unroll
        for (int j = 0; j < 16; ++j) un[j] = ur[j];
        if (nx < NB * 256) { const bf16_t* up = UFT + ((size_t)((nx >> 8) * 512 + (nx & 255) * 2 + cc)) * RPB + CTX + t1;
#pragma unroll
            for (int j = 0; j < 16; ++j) un[j] = up[j * 256]; }
        const int b = it >> 8, ch = (it & 255) * 2 + cc;
        float u[16];
#pragma unroll
        for (int j = 0; j < 16; ++j) u[j] = bf2f(ur[j]);
        float sa[8], sb[8];
#pragma unroll
        for (int j = 1; j < 8; ++j) { sa[j] = u[j] + u[16 - j]; sb[j] = u[j] - u[16 - j]; }
        float re[9], im[9];
#pragma unroll
        for (int k2 = 0; k2 <= 8; ++k2) { float r = u[0] + ((k2 & 1) ? -u[8] : u[8]), m = 0.f;
#pragma unroll
            for (int j = 1; j < 8; ++j) { const int q = (k2 * j) & 15;
                const float cq = (q <= 8) ? C16[q] : C16[16 - q], sq = (q <= 8) ? S16[q] : -S16[16 - q];
                r += sa[j] * cq; m -= sb[j] * sq; }
            re[k2] = r; im[k2] = m; }
        bf16_t* hp = HB + ((size_t)b * 8192 + ch) * 512 + t1;
#pragma unroll
        for (int k2 = 0; k2 < 16; ++k2) { const float r = (k2 <= 8) ? re[k2] : re[16 - k2], m = (k2 <= 8) ? im[k2] : -im[16 - k2];
            const float r2 = r * tw[k2].x + m * tw[k2].y, i2 = m * tw[k2].x - r * tw[k2].y;
            hp[(size_t)k2 * 512 * 512] = f2bf(r2); hp[(size_t)k2 * 512 * 512 + 256] = f2bf(i2); }
        if (nx >= NB * 256) break;
#pragma unroll
        for (int j = 0; j < 16; ++j) ur[j] = un[j];
        it = nx;
    }
}
using gk::Unit; using gk::Acc;
__device__ __forceinline__ u32x4 pack8(const f32x4& a, const f32x4& b) { u32x4 w; w.x = cvt_pk_bf16(a[0], a[1]); w.y = cvt_pk_bf16(a[2], a[3]); w.z = cvt_pk_bf16(b[0], b[1]); w.w = cvt_pk_bf16(b[2], b[3]); return w; }
__device__ __forceinline__ u32x2 pack8f(const f32x4& a, const f32x4& b) { u32x2 w; w.x = cvt4_fp8(a[0], a[1], a[2], a[3]); w.y = cvt4_fp8(b[0], b[1], b[2], b[3]); return w; }
__device__ __forceinline__ u32x2 pack8fs(const f32x4& a, const f32x4& b) { u32x2 w; w.x = cvt4_fp8s(a[0], a[1], a[2], a[3]); w.y = cvt4_fp8s(b[0], b[1], b[2], b[3]); return w; }
__device__ __forceinline__ void unpack8(const u32x4& w, float (&f)[8]) { f[0] = bflo(w.x); f[1] = bfhi(w.x); f[2] = bflo(w.y); f[3] = bfhi(w.y); f[4] = bflo(w.z); f[5] = bfhi(w.z); f[6] = bflo(w.w); f[7] = bfhi(w.w); }
#define EROW(ai, m) (128 * (ai) + 64 * wr + 16 * (m) + fr)
#define ECOL(bj) (128 * (bj) + 32 * wc + 8 * fq)
#define EFENCE() asm volatile("" ::: "memory")
#ifndef EPI_GAP_N
#define EPI_GAP_N 0
#endif
#define EPI_GAP(ai, m) do { if ((ai) == 1 && (m) == 0 && EPI_GAP_N) { asm volatile("" ::: "memory"); __builtin_amdgcn_s_sleep(EPI_GAP_N); asm volatile("" ::: "memory"); } } while (0)
#ifndef EPI_NT
#define EPI_NT 0
#endif
#if EPI_NT
#define ST16(p, v) __builtin_nontemporal_store((v), (u32x4*)(p))
#else
#define ST16(p, v) (*(u32x4*)(p) = (v))
#endif

struct G1Sched {
    static constexpr bool GATHER = false, FP8 = false, COUNTED = false;
    const char* H; const char* W; int G, c;
    __device__ __forceinline__ bool next(int i, Unit& u) const {
        const int L = i * G + c; if (L >= NMT * 10) return false;
        int pm, pn; gk::tile_order(L, NMT, 10, pm, pn);
        u.nt = 16; u.lda2 = 2048u; u.ldb2 = 2048u;
        const char* a = H + (size_t)pm * 256 * 2048; const char* b = W + (size_t)pn * 256 * 2048;
        if (pn == 2 || pn == 3) { u.set(pm, pn, 0, 1, 0); u.A = b; u.B = a; } else { u.set(pm, pn, 0, 0, 0); u.A = a; u.B = b; }
        return true;
    }
};
struct G1Sched8 {
    static constexpr bool GATHER = false, FP8 = true, COUNTED = false;
    const char* H; const char* W; int G, c;
    __device__ __forceinline__ bool next(int i, Unit& u) const {
        const int L = i * G + c; if (L >= NMT * 12) return false;
        int pm, pn; gk::tile_order(L, NMT, 12, pm, pn); pn += 10;
        u.nt = 8; u.lda2 = 1024u; u.ldb2 = 1024u; u.set(pm, pn, 0, 0, 0);
        u.A = H + (size_t)pm * 256 * 1024; u.B = W + (size_t)pn * 256 * 1024; return true;
    }
};
struct G1EpiA {
    char* ws;
    __device__ __forceinline__ void operator()(Acc& acc, const Unit& u, int wr, int wc, int fr, int fq) const {
        const int pn = u.pn(), pm = u.pm;
        if (pn <= 1) {
            bf16_t* dst = (bf16_t*)(ws + (pn == 0 ? WS_UQ : WS_UKV)); float* ssq = (float*)(ws + WS_SSQ);
#pragma unroll
            for (int ai = 0; ai < 2; ++ai)
#pragma unroll
                for (int m = 0; m < 4; ++m) { const int row = pm * 256 + EROW(ai, m); bf16_t* rowp = dst + (size_t)row * 256; float s = 0.f;
#pragma unroll
                    for (int bj = 0; bj < 2; ++bj) { *(u32x4*)(rowp + ECOL(bj)) = pack8(acc[ai][bj][m][0], acc[ai][bj][m][1]);
                        if (pn == 1 && bj == 1) continue;
#pragma unroll
                        for (int n = 0; n < 2; ++n) { const f32x4 x = acc[ai][bj][m][n]; s += x[0] * x[0] + x[1] * x[1] + x[2] * x[2] + x[3] * x[3]; } }
                    s += lane_xor<16>(s, 0); s = half_sum32(s);
                    if (fq == 0) ssq[(size_t)row * 8 + pn * 4 + wc] = s; }
        } else if (pn >= 4) {
            size_t base; int ld, coff = 0;
            if (pn == 4) { base = WS_GQ; ld = 256; } else if (pn == 5) { base = WS_GK; ld = 256; } else if (pn < 8) { base = WS_GV; ld = 512; coff = (pn - 6) * 256; } else { base = WS_GOG; ld = 512; coff = (pn - 8) * 256; }
            bf16_t* dst = (bf16_t*)(ws + base);
#pragma unroll
            for (int ai = 0; ai < 2; ++ai)
#pragma unroll
                for (int m = 0; m < 4; ++m) { bf16_t* rowp = dst + (size_t)(pm * 256 + EROW(ai, m)) * ld + coff;
#pragma unroll
                    for (int bj = 0; bj < 2; ++bj) *(u32x4*)(rowp + ECOL(bj)) = pack8(acc[ai][bj][m][0], acc[ai][bj][m][1]); }
        } else {
            bf16_t* dst = (bf16_t*)(ws + WS_UFT); const int b = pm / 17, i0 = (pm % 17) * 256;
#pragma unroll
            for (int ai = 0; ai < 2; ++ai)
#pragma unroll
                for (int m = 0; m < 4; ++m) { const int ch = (pn - 2) * 256 + EROW(ai, m); bf16_t* rowp = dst + ((size_t)(b * 512 + ch)) * RPB + i0;
#pragma unroll
                    for (int bj = 0; bj < 2; ++bj) *(u32x4*)(rowp + ECOL(bj)) = pack8(acc[ai][bj][m][0], acc[ai][bj][m][1]); }
        }
    }
};
struct G1EpiB {
    char* ws;
    __device__ __forceinline__ void operator()(Acc& acc, const Unit& u, int wr, int wc, int fr, int fq) const {
        const int pn = u.pn(), pm = u.pm;
        unsigned char* g8 = (unsigned char*)(ws + WS_GATE); const int coff = (pn - 10) * 256;
#pragma unroll
        for (int ai = 0; ai < 2; ++ai)
#pragma unroll
            for (int m = 0; m < 4; ++m) { unsigned char* rowp = g8 + (size_t)(pm * 256 + EROW(ai, m)) * 3072 + coff;
#pragma unroll
                for (int bj = 0; bj < 2; ++bj) { f32x4 v0 = acc[ai][bj][m][0], v1 = acc[ai][bj][m][1];
#pragma unroll
                    for (int j = 0; j < 4; ++j) { v0[j] = fminf(__expf(-v0[j]), 448.0f); v1[j] = fminf(__expf(-v1[j]), 448.0f); }
                    u32x2 w8; w8.x = cvt4_fp8(v0[0], v0[1], v0[2], v0[3]); w8.y = cvt4_fp8(v1[0], v1[1], v1[2], v1[3]);
                    *(u32x2*)(rowp + ECOL(bj)) = w8; } }
    }
};

struct DftBSched {
    static constexpr bool GATHER = false, FP8 = false;
    char* ws; int G, c;
    __device__ __forceinline__ bool next(int i, Unit& u) const {
        const int L = i * G + c; if (L >= 512) return false;
        const int b = L >> 6, pm = (L >> 5) & 1, pn = L & 31;
        u.set(pm, pn, b, 10, 0); u.nt = 8; u.lda2 = 1024u; u.ldb2 = 1024u;
        u.A = ws + WS_DB + (size_t)pm * 256 * 1024; u.B = ws + WS_DFTL + ((size_t)b * 8192 + pn * 256) * 1024; return true;
    }
};
struct DftCSched {
    static constexpr bool GATHER = false, FP8 = false;
    char* ws; int G, c;
    __device__ __forceinline__ bool next(int i, Unit& u) const {
        const int L = i * G + c; if (L >= 32) return false;
        const int b = L >> 2, mt = (L >> 1) & 1, nn = L & 1;
        u.set(mt, nn, b, 11, 0); u.nt = 4; u.lda2 = 512u; u.ldb2 = (unsigned)RPB * 2u;
        u.A = ws + WS_DFTC + (size_t)mt * 256 * 512; u.B = ws + WS_UFT + ((size_t)(b * 512 + nn * 256) * RPB) * 2; return true;
    }
};
struct DftEpi {
    char* ws;
    __device__ __forceinline__ void operator()(Acc& acc, const Unit& u, int wr, int wc, int fr, int fq) const {
        unsigned char* P = (unsigned char*)(ws + WS_P); const int pm = u.pm, pn = u.pn(), b = u.aux();
#pragma unroll
        for (int ai = 0; ai < 2; ++ai)
#pragma unroll
            for (int bj = 0; bj < 2; ++bj)
#pragma unroll
                for (int m = 0; m < 4; ++m)
#pragma unroll
                    for (int j = 0; j < 4; ++j) { acc[ai][bj][m][0][j] = sat8(acc[ai][bj][m][0][j]); acc[ai][bj][m][1][j] = sat8(acc[ai][bj][m][1][j]); }
        if (u.kind() == 10) {
            const int k2 = pn >> 1, cb = (pn & 1) * 256;
#pragma unroll
            for (int ai = 0; ai < 2; ++ai)
#pragma unroll
                for (int m = 0; m < 4; ++m) { EPI_GAP(ai, m); unsigned char* rowp = P + (size_t)(b * RPB + CTX + 16 * EROW(ai, m) + k2) * 1024 + pm * 512 + cb;
#pragma unroll
                    for (int bj = 0; bj < 2; ++bj) *(u32x2*)(rowp + ECOL(bj)) = pack8f(acc[ai][bj][m][0], acc[ai][bj][m][1]); }
        } else {
#pragma unroll
            for (int ai = 0; ai < 2; ++ai)
#pragma unroll
                for (int m = 0; m < 4; ++m) { EPI_GAP(ai, m); unsigned char* rowp = P + (size_t)(b * RPB + EROW(ai, m)) * 1024 + pm * 512 + pn * 256;
#pragma unroll
                    for (int bj = 0; bj < 2; ++bj) *(u32x2*)(rowp + ECOL(bj)) = pack8f(acc[ai][bj][m][0], acc[ai][bj][m][1]); }
        }
    }
};
__device__ __forceinline__ float ssq_scale(const float* ssq, int row, int which, float inv_n) { const f32x4 s = *(const f32x4*)(ssq + (size_t)row * 8 + which * 4); return rsqrtf((s[0] + s[1] + s[2] + s[3]) * inv_n + EPS); }
struct QSched {
    static constexpr bool GATHER = false, FP8 = false;
    char* ws; const char* wl; int G, c;
    __device__ __forceinline__ bool next(int i, Unit& u) const {
        const int L = i * G + c; if (L >= NMT * 3) return false; const int pm = L / 3, pn = L % 3;
        u.set(pm, pn, 0, 12, 0); u.nt = 4; u.lda2 = 512u; u.ldb2 = 512u;
        u.A = ws + WS_UQ + (size_t)pm * 256 * 512; u.B = wl + WL_WUQ + (size_t)pn * 256 * 512; return true;
    }
};
struct QEpi {
    char* ws;
    __device__ __forceinline__ void operator()(Acc& acc, const Unit& u, int wr, int wc, int fr, int fq) const {
        const int pm = u.pm, pn = u.pn();
        const float* ssq = (const float*)(ws + WS_SSQ); bf16_t* Q = (bf16_t*)(ws + WS_Q); const f32x2* rope = (const f32x2*)(ws + WS_ROPE);
#pragma unroll
        for (int ai = 0; ai < 2; ++ai)
#pragma unroll
            for (int m = 0; m < 4; ++m) { EPI_GAP(ai, m); const int row = pm * 256 + EROW(ai, m); const float sc = ssq_scale(ssq, row, 0, 1.0f / 256.0f) * QSCALE;
                const int ib = row % RPB, tl = ib - CTX;
#pragma unroll
                for (int bj = 0; bj < 2; ++bj) { f32x4 v0 = acc[ai][bj][m][0] * sc, v1 = acc[ai][bj][m][1] * sc;
                    const int cc = ECOL(bj);
                    if (pn < 2) { const int col = pn * 256 + cc, h = col >> 6, d = col & 63; *(u32x4*)(Q + (size_t)row * 768 + h * 96 + d) = pack8(v0, v1); }
                    else { const int h = cc >> 5, axis = fq >> 1, i0 = 4 * (fq & 1);
                        if (tl >= 0) { const int pos = axis ? (tl & 63) : (tl >> 6);
                            const f32x2 r0 = rope[pos * 8 + i0], r1 = rope[pos * 8 + i0 + 1], r2 = rope[pos * 8 + i0 + 2], r3 = rope[pos * 8 + i0 + 3];
                            f32x4 o0, o1;
                            o0[0] = v0[0] * r0.x - v0[1] * r0.y; o0[1] = v0[1] * r0.x + v0[0] * r0.y; o0[2] = v0[2] * r1.x - v0[3] * r1.y; o0[3] = v0[3] * r1.x + v0[2] * r1.y;
                            o1[0] = v1[0] * r2.x - v1[1] * r2.y; o1[1] = v1[1] * r2.x + v1[0] * r2.y; o1[2] = v1[2] * r3.x - v1[3] * r3.y; o1[3] = v1[3] * r3.x + v1[2] * r3.y;
                            v0 = o0; v1 = o1; }
                        *(u32x4*)(Q + (size_t)row * 768 + h * 96 + 64 + 8 * fq) = pack8(v0, v1); } }
                EFENCE(); }
    }
};
struct KnSched {
    static constexpr bool GATHER = false, FP8 = false;
    char* ws; const char* wl; int G, c;
    __device__ __forceinline__ bool next(int i, Unit& u) const {
        const int L = i * G + c; if (L >= NMT * 2) return false; const int pm = L >> 1, pn = L & 1;
        u.set(pm, pn, 0, 13, 0); u.nt = 4; u.lda2 = 512u; u.ldb2 = 512u;
        u.A = ws + WS_UKV + (size_t)pm * 256 * 512; u.B = wl + WL_WUKV + (size_t)pn * 256 * 512; return true;
    }
};
struct KnEpi {
    char* ws;
    __device__ __forceinline__ void operator()(Acc& acc, const Unit& u, int wr, int wc, int fr, int fq) const {
        const float* ssq = (const float*)(ws + WS_SSQ); bf16_t* KN = (bf16_t*)(ws + WS_KN); const int pm = u.pm, pn = u.pn();
#pragma unroll
        for (int ai = 0; ai < 2; ++ai)
#pragma unroll
            for (int m = 0; m < 4; ++m) { EPI_GAP(ai, m); const int row = pm * 256 + EROW(ai, m); const float sc = ssq_scale(ssq, row, 1, 1.0f / 128.0f);
#pragma unroll
                for (int bj = 0; bj < 2; ++bj) *(u32x4*)(KN + (size_t)row * 512 + pn * 256 + ECOL(bj)) = pack8(acc[ai][bj][m][0] * sc, acc[ai][bj][m][1] * sc); }
    }
};
struct VtSched {
    static constexpr bool GATHER = false, FP8 = false;
    char* ws; const char* wl; int G, c;
    __device__ __forceinline__ bool next(int i, Unit& u) const {
        const int L = i * G + c; if (L >= NMT * 2) return false; const int pm = L >> 1, pn = L & 1;
        u.set(pm, pn, 0, 14, 0); u.nt = 4; u.lda2 = 512u; u.ldb2 = 512u;
        u.A = wl + WL_WUKV + (size_t)(2 + pn) * 256 * 512; u.B = ws + WS_UKV + (size_t)pm * 256 * 512; return true;
    }
};
struct VtEpi {
    char* ws;
    __device__ __forceinline__ void operator()(Acc& acc, const Unit& u, int wr, int wc, int fr, int fq) const {
        const float* ssq = (const float*)(ws + WS_SSQ); bf16_t* VT = (bf16_t*)(ws + WS_VT); const int pm = u.pm, pn = u.pn(), b = pm / 17, i0 = (pm % 17) * 256;
#pragma unroll
        for (int bj = 0; bj < 2; ++bj) { float sc[8];
#pragma unroll
            for (int j = 0; j < 8; ++j) sc[j] = ssq_scale(ssq, pm * 256 + ECOL(bj) + j, 1, 1.0f / 128.0f);
#pragma unroll
            for (int ai = 0; ai < 2; ++ai)
#pragma unroll
                for (int m = 0; m < 4; ++m) { EPI_GAP(ai, m); const int vc = pn * 256 + EROW(ai, m);
                    f32x4 v0 = acc[ai][bj][m][0], v1 = acc[ai][bj][m][1];
#pragma unroll
                    for (int j = 0; j < 4; ++j) { v0[j] *= sc[j]; v1[j] *= sc[4 + j]; }
                    { bf16_t* gp_ = VT + ((size_t)(b * 512 + vc)) * RPB + i0 + 128 * bj + 32 * wc + 16 * (fq >> 1) + 4 * (fq & 1);
                      u32x2 w0_, w1_; w0_.x = cvt_pk_bf16(v0[0], v0[1]); w0_.y = cvt_pk_bf16(v0[2], v0[3]); w1_.x = cvt_pk_bf16(v1[0], v1[1]); w1_.y = cvt_pk_bf16(v1[2], v1[3]);
                      *(u32x2*)gp_ = w0_; *(u32x2*)(gp_ + 8) = w1_; } }
            EFENCE(); }
    }
};


struct P2Sched {
    static constexpr bool GATHER = false, FP8 = false, COUNTED = false;
    char* ws; const char* wl; int l, G, c;
    __device__ __forceinline__ bool next(int i, Unit& u) const {
        int L = i * G + c; u.nt = 4;
        if (l < DEPTH - 1) { if (L < 32) { const int b = L >> 2, mt = (L >> 1) & 1, nn = L & 1;
                u.set(mt, nn, b, 11, 0); u.lda2 = 512u; u.ldb2 = (unsigned)RPB * 2u;
                u.A = ws + WS_DFTC + (size_t)mt * 256 * 512; u.B = ws + WS_UFT + ((size_t)(b * 512 + nn * 256) * RPB) * 2; return true; }
            L -= 32; }
        u.lda2 = 512u; u.ldb2 = 512u;
        if (L < NMT * 3) { const int pm = L / 3, pn = L % 3; u.set(pm, pn, 0, 12, 0);
            u.A = ws + WS_UQ + (size_t)pm * 256 * 512; u.B = wl + WL_WUQ + (size_t)pn * 256 * 512; return true; }
        L -= NMT * 3;
        if (L < NMT * 4) { const int pm = L >> 2, pn = L & 3; const char* a = ws + WS_UKV + (size_t)pm * 256 * 512; const char* b = wl + WL_WUKV + (size_t)pn * 256 * 512;
            if (pn < 2) { u.set(pm, pn, 0, 13, 0); u.A = a; u.B = b; } else { u.set(pm, pn - 2, 0, 14, 0); u.A = b; u.B = a; }
            return true; }
        return false;
    }
};
struct P2Epi {
    DftEpi D; QEpi Q; KnEpi K; VtEpi V;
    __device__ __forceinline__ void operator()(Acc& acc, const Unit& u, int wr, int wc, int fr, int fq) const {
        const int kind = u.kind();
        if (kind == 11) D(acc, u, wr, wc, fr, fq); else if (kind == 12) Q(acc, u, wr, wc, fr, fq); else if (kind == 13) K(acc, u, wr, wc, fr, fq); else V(acc, u, wr, wc, fr, fq);
    }
};
__device__ __forceinline__ int act_tile(int l, int at) { return (l < DEPTH - 1) ? at : at + at / 16 + 1; }
__device__ __forceinline__ int n_act_tiles(int l) { return (l < DEPTH - 1) ? NMT : NMT - NB; }
struct MergeSched {
    static constexpr bool GATHER = false, FP8 = true;
    char* ws; const char* wl; int l, G, c;
    __device__ __forceinline__ bool next(int i, Unit& u) const {
        const int seg = i % 3; int at, pn;
        if (G == 256) { const int x = c & 7, u = (i / 3) * 32 + (c >> 3); at = 8 * (u >> 2) + x; pn = u & 3; if (at >= n_act_tiles(l)) return false; }
        else { const int it = (i / 3) * G + c; if (it >= n_act_tiles(l) * 4) return false; at = it >> 2; pn = it & 3; }
        const int pm = act_tile(l, at);
        u.set(pm, pn, seg, 20, seg < 2 ? 1 : 0);
        if (seg == 0) { u.A = ws + WS_OMLA + (size_t)pm * 256 * 512; u.B = wl + WL_WM + (size_t)pn * 256 * 512; u.lda2 = 512u; u.ldb2 = 512u; u.nt = 4; }
        else if (seg == 1) { u.A = ws + WS_P + (size_t)pm * 256 * 1024; u.B = wl + WL_WF + (size_t)pn * 256 * 1024; u.lda2 = 1024u; u.ldb2 = 1024u; u.nt = 8; }
        else { u.A = ws + WS_OGLA + (size_t)pm * 256 * 512; u.B = wl + WL_WG + (size_t)pn * 256 * 512; u.lda2 = 512u; u.ldb2 = 512u; u.nt = 4; }
        return true;
    }
};
struct MergeEpi {
    char* ws; int dry;
    __device__ __forceinline__ void operator()(Acc& acc, const Unit& u, int wr, int wc, int fr, int fq) const {
        if (dry) return;
        const unsigned char* GT = (const unsigned char*)(ws + WS_GATE); unsigned char* Y = (unsigned char*)(ws + WS_Y); const int seg = u.aux(), pn = u.pn();
        const int oa = (seg < 2) ? seg * 1024 : 2048, ob = (seg < 2) ? (seg + 1) * 1024 : 2048;
#pragma unroll
        for (int ai = 0; ai < 2; ++ai) {
            u32x2 wa[4][2], wb[4][2];
#pragma unroll
            for (int m = 0; m < 4; ++m)
#pragma unroll
                for (int bj = 0; bj < 2; ++bj) { const unsigned char* gp = GT + (size_t)(u.pm * 256 + EROW(ai, m)) * 3072 + pn * 256 + ECOL(bj);
                    wa[m][bj] = *(const u32x2*)(gp + oa); wb[m][bj] = *(const u32x2*)(gp + ob); }
#pragma unroll
            for (int m = 0; m < 4; ++m) { const int row = u.pm * 256 + EROW(ai, m);
#pragma unroll
                for (int bj = 0; bj < 2; ++bj) { const int col = pn * 256 + ECOL(bj);
                    float a[8], b[8];
                    cvt_fp8x4(wa[m][bj].x, a[0], a[1], a[2], a[3]); cvt_fp8x4(wa[m][bj].y, a[4], a[5], a[6], a[7]); cvt_fp8x4(wb[m][bj].x, b[0], b[1], b[2], b[3]); cvt_fp8x4(wb[m][bj].y, b[4], b[5], b[6], b[7]);
                    f32x4& v0 = acc[ai][bj][m][0]; f32x4& v1 = acc[ai][bj][m][1];
                    if (seg < 2) {
#pragma unroll
                        for (int j = 0; j < 8; ++j) { const float f = (1.0f + b[j]) * __builtin_amdgcn_rcpf(1.0f + a[j]); if (j < 4) v0[j] *= f; else v1[j - 4] *= f; } }
                    else {
#pragma unroll
                        for (int j = 0; j < 8; ++j) { const float f = __builtin_amdgcn_rcpf(1.0f + a[j]); if (j < 4) v0[j] *= f; else v1[j - 4] *= f; } }
                    if (seg == 2) *(u32x2*)(Y + (size_t)row * 1024 + col) = pack8fs(v0, v1); } }
            EFENCE(); }
    }
};

struct WoSched {
    static constexpr bool GATHER = false, FP8 = true;
    char* ws; const char* wl; int l, G, c;
    __device__ __forceinline__ bool next(int i, Unit& u) const {
        int at, pn;
        if (G == 256) { const int x = c & 7, u = i * 32 + (c >> 3); at = 8 * (u >> 2) + x; pn = u & 3; if (at >= n_act_tiles(l)) return false; }
        else { const int it = i * G + c; if (it >= n_act_tiles(l) * 4) return false; at = it >> 2; pn = it & 3; }
        const int pm = act_tile(l, at);
        u.set(pm, pn, 0, 30, 0); u.nt = 8; u.lda2 = 1024u; u.ldb2 = 1024u;
        u.A = ws + WS_Y + (size_t)pm * 256 * 1024; u.B = wl + WL_WO + (size_t)pn * 256 * 1024; return true;
    }
};
struct WoEpi {
    char* ws; int l; int dry;
    const float* x_in; const float* ctx_in;
    __device__ __forceinline__ void operator()(Acc& acc, const Unit& u, int wr, int wc, int fr, int fq) const {
        bf16_t* X = (bf16_t*)(ws + WS_X); const int pn = u.pn(), s = (u.pm % 17 == 0) ? 8 : u.pm / 17;
        const float* g1 = (const float*)(ws + WS_MOD) + ((size_t)l * 9 + s) * 6144 + 2048;
        f32x4 gv[2][2];
#pragma unroll
        for (int bj = 0; bj < 2; ++bj) { const int col = pn * 256 + ECOL(bj); gv[bj][0] = *(const f32x4*)(g1 + col); gv[bj][1] = *(const f32x4*)(g1 + col + 4); }
#pragma unroll
        for (int ai = 0; ai < 2; ++ai) {
            f32x4 xv[4][2][2];
            if (l == 0) { const int b = u.pm / 17, j = u.pm % 17; const float* Xr = (j == 0) ? ctx_in + (size_t)b * 256 * 1024 : x_in + ((size_t)b * 4096 + (size_t)(j - 1) * 256) * 1024;
#pragma unroll
                for (int m = 0; m < 4; ++m) { const float* rowp = Xr + (size_t)EROW(ai, m) * 1024 + pn * 256;
#pragma unroll
                    for (int bj = 0; bj < 2; ++bj) { xv[m][bj][0] = *(const f32x4*)(rowp + ECOL(bj)); xv[m][bj][1] = *(const f32x4*)(rowp + ECOL(bj) + 4); } } }
            else { u32x4 xw[4][2];
#pragma unroll
                for (int m = 0; m < 4; ++m) { const bf16_t* rowp = X + (size_t)(u.pm * 256 + EROW(ai, m)) * 1024 + pn * 256;
#pragma unroll
                    for (int bj = 0; bj < 2; ++bj) xw[m][bj] = *(const u32x4*)(rowp + ECOL(bj)); }
#pragma unroll
                for (int m = 0; m < 4; ++m)
#pragma unroll
                    for (int bj = 0; bj < 2; ++bj) { const u32x4 w = xw[m][bj]; xv[m][bj][0] = (f32x4){bflo(w.x), bfhi(w.x), bflo(w.y), bfhi(w.y)}; xv[m][bj][1] = (f32x4){bflo(w.z), bfhi(w.z), bflo(w.w), bfhi(w.w)}; } }
#pragma unroll
            for (int m = 0; m < 4; ++m) { bf16_t* rowp = X + (size_t)(u.pm * 256 + EROW(ai, m)) * 1024 + pn * 256;
#pragma unroll
                for (int bj = 0; bj < 2; ++bj) { bf16_t* q = rowp + ECOL(bj);
                    const f32x4 r0 = xv[m][bj][0] + gv[bj][0] * acc[ai][bj][m][0], r1 = xv[m][bj][1] + gv[bj][1] * acc[ai][bj][m][1];
                    if (!dry) *(u32x4*)q = pack8(r0, r1); else asm volatile("" :: "v"(r0), "v"(r1)); } }
            EFENCE(); }
    }
};

struct MoeSched {
    static constexpr bool GATHER = false, FP8 = true;
    const char* A; const char* W; const LAS int* tb; int G, c; static constexpr int npn = 4; static constexpr size_t wstride = (size_t)1024 * 1024;
    __device__ __forceinline__ bool next(int i, Unit& u) const {
        const int total = __builtin_amdgcn_readfirstlane(tb[32]); int tg, pn;
        if (G == 256) { const int x = c & 7, s = c >> 3; tg = (i * 8 + x) * 8 + (s >> 2); pn = s & 3; if (tg >= total) return false; }
        else { const int L = i * G + c; if (L >= total * npn) return false; tg = L / npn; pn = L % npn; }
        int e = 0;
#pragma unroll
        for (int k = 16; k >= 1; k >>= 1) { const int v = __builtin_amdgcn_readfirstlane(tb[e + k]); if (v <= tg) e += k; }
        u.set(tg, pn, e, 40, 0); u.nt = 8; u.lda2 = 1024u; u.ldb2 = 1024u;
        u.A = A + (size_t)tg * 256 * 1024; u.B = W + (size_t)e * wstride + (size_t)pn * 256 * 1024; return true;
    }
};
struct MoeUpSched {
    static constexpr bool GATHER = true, FP8 = true; static constexpr int GPITCH = 1024;
    const char* gbase; const int* rt2; const char* W; const LAS int* tb; const LAS int* cn; int G, c;
    __device__ __forceinline__ bool next(int i, Unit& u) const {
        const int total = __builtin_amdgcn_readfirstlane(tb[32]); int tg, pn;
        if (G == 256) {
            const int x = c & 7, s = c >> 3; tg = (i * 8 + x) * 4 + (s >> 3); pn = s & 7; if (tg >= total) return false; }
        else { const int L = i * G + c; if (L >= total * 8) return false; tg = L >> 3; pn = L & 7; }
        int e = 0;
#pragma unroll
        for (int k = 16; k >= 1; k >>= 1) { const int v = __builtin_amdgcn_readfirstlane(tb[e + k]); if (v <= tg) e += k; }
        const int j = tg - __builtin_amdgcn_readfirstlane(tb[e]), n = __builtin_amdgcn_readfirstlane(cn[e]) - j * 256;
        u.set(tg, pn, e, 40, 0); u.nt = 8; u.lda2 = (unsigned)(n < 256 ? n : 256); u.ldb2 = 1024u;
        u.A = (const char*)(rt2 + (size_t)e * T + j * 256); u.B = W + (size_t)e * 2048 * 1024 + (size_t)pn * 256 * 1024; return true;
    }
};
struct UpEpi {
    char* ws; const float* b_up;
    __device__ __forceinline__ void operator()(Acc& acc, const Unit& u, int wr, int wc, int fr, int fq) const {
        unsigned char* ACT = (unsigned char*)(ws + WS_ACT); const float* bu = b_up + (size_t)u.aux() * 2048;
        const int cg = u.pn() * 128 + 32 * wc + 8 * fq;
        const f32x4 bg0 = *(const f32x4*)(bu + cg), bg1 = *(const f32x4*)(bu + cg + 4), bl0 = *(const f32x4*)(bu + 1024 + cg), bl1 = *(const f32x4*)(bu + 1024 + cg + 4);
#pragma unroll
        for (int ai = 0; ai < 2; ++ai)
#pragma unroll
            for (int m = 0; m < 4; ++m) { EPI_GAP(ai, m); f32x4 o[2];
#pragma unroll
                for (int n = 0; n < 2; ++n)
#pragma unroll
                    for (int j = 0; j < 4; ++j) { float gl = acc[ai][0][m][n][j] + (n ? bg1[j] : bg0[j]), li = acc[ai][1][m][n][j] + (n ? bl1[j] : bl0[j]);
                        gl = fminf(gl, 7.0f); li = __builtin_amdgcn_fmed3f(li, -7.0f, 7.0f);
                        const float sg = gl * __builtin_amdgcn_rcpf(1.0f + __builtin_amdgcn_exp2f(gl * -2.4554669595930156f));
                        o[n][j] = __builtin_fmaf(sg, li, sg); }
                u32x2 w8; w8.x = cvt4_fp8(o[0][0], o[0][1], o[0][2], o[0][3]); w8.y = cvt4_fp8(o[1][0], o[1][1], o[1][2], o[1][3]);
                *(u32x2*)(ACT + (size_t)(u.pm * 256 + EROW(ai, m)) * 1024 + cg) = w8; }
    }
};
struct DownEpi {
    char* ws; const float* b_down;
    __device__ __forceinline__ void operator()(Acc& acc, const Unit& u, int wr, int wc, int fr, int fq) const {
        unsigned char* YM = (unsigned char*)(ws + WS_YM); const float* bd = b_down + (size_t)u.aux() * 1024; const int pn = u.pn();
#pragma unroll
        for (int bj = 0; bj < 2; ++bj) { const int col = pn * 256 + ECOL(bj); const f32x4 bv0 = *(const f32x4*)(bd + col), bv1 = *(const f32x4*)(bd + col + 4);
#pragma unroll
            for (int ai = 0; ai < 2; ++ai)
#pragma unroll
                for (int m = 0; m < 4; ++m) { const f32x4 y0 = (acc[ai][bj][m][0] + bv0) * YM_SCALE, y1 = (acc[ai][bj][m][1] + bv1) * YM_SCALE; u32x2 w; w.x = cvt4_fp8s(y0[0], y0[1], y0[2], y0[3]); w.y = cvt4_fp8s(y1[0], y1[1], y1[2], y1[3]);
                    *(u32x2*)(YM + (size_t)(u.pm * 256 + EROW(ai, m)) * 1024 + col) = w; }
            EFENCE(); }
    }
};
namespace at {
constexpr int NSLOT = 4, KSLOT = 12288, VSLOT = 8192, OFF_V = NSLOT * KSLOT, OFF_WS = OFF_V + NSLOT * VSLOT, OFF_OST = OFF_WS + 8 * 256, LDS_NEED = OFF_OST + 8 * 4096;
__device__ __forceinline__ int crow(int r, int hi) { return (r & 3) + 8 * (r >> 2) + 4 * hi; }

__device__ __forceinline__ void attn_unit(char* ws, LAS unsigned char* lds, int b, int h, int qrow0, int nkt) {
    const int tid = ltid(), lane = tid & 63, r32 = lane & 31, hi = lane >> 5, wid = __builtin_amdgcn_readfirstlane(tid >> 6);
    const bf16_t* Q = (const bf16_t*)(ws + WS_Q); unsigned char* O = (unsigned char*)(ws + WS_OMLA);
    const size_t rowb = (size_t)b * RPB;
    const char* src[3]; unsigned inc[3], dsto[3];
#pragma unroll
    for (int j = 0; j < 3; ++j) {
        int pc = wid + 8 * j; if (pc >= 20) pc -= 8;
        if (pc < 8) { src[j] = ws + WS_KN + ((rowb + lane) * 512 + h * 64 + pc * 8) * 2; inc[j] = 64u * 1024u; dsto[j] = (unsigned)pc * 1024u; }
        else if (pc < 12) { src[j] = ws + WS_KR + ((rowb + lane) * 32 + (pc - 8) * 8) * 2; inc[j] = 64u * 64u; dsto[j] = (unsigned)pc * 1024u; }
        else { const int v = pc - 12, d = 8 * v + (lane >> 3), cl = lane & 7, lc = cl ^ ((d >> 1) & 7);
            src[j] = ws + WS_VT + (((size_t)(b * 8 + h) * 64 + d) * RPB + lc * 8) * 2; inc[j] = 128u; dsto[j] = (unsigned)(OFF_V + v * 1024); }
    }
#define AT_ISSUE(t, slot) do { _Pragma("unroll") for (int j = 0; j < 3; ++j) { \
        const unsigned so = (dsto[j] >= (unsigned)OFF_V) ? (unsigned)(slot) * VSLOT : (unsigned)(slot) * KSLOT; \
        __builtin_amdgcn_global_load_lds((const unsigned*)(src[j] + (size_t)(t) * inc[j]), (LAS unsigned*)(lds + dsto[j] + so), 16, 0, 0); } } while (0)
    const bf16_t* Qp = Q + (rowb + qrow0 + wid * 32 + r32) * 768 + h * 96 + hi * 8;
    bf16x8 qr[6];
#pragma unroll
    for (int d0 = 0; d0 < 6; ++d0) qr[d0] = *(const bf16x8*)(Qp + d0 * 16);
    f32x16 o0, o1, ol; const f32x16 zero16 = {0.f, 0.f, 0.f, 0.f, 0.f, 0.f, 0.f, 0.f, 0.f, 0.f, 0.f, 0.f, 0.f, 0.f, 0.f, 0.f};
#pragma unroll
    for (int r = 0; r < 16; ++r) { o0[r] = 0.f; o1[r] = 0.f; ol[r] = 0.f; }
    float m_run = 0.f;
    const u32x4 onesw = {0x3F803F80u, 0x3F803F80u, 0x3F803F80u, 0x3F803F80u};
    LAS float* wsf = (LAS float*)(lds + OFF_WS + wid * 256);
#define AT_QK(PD0, PD1, slot) do { const LAS unsigned char* ks_ = lds + (slot) * KSLOT + hi * 1024 + r32 * 16; \
        _Pragma("unroll") for (int d0 = 0; d0 < 6; ++d0) { \
            const bf16x8 k0 = *(const LAS bf16x8*)(ks_ + d0 * 2048), k1 = *(const LAS bf16x8*)(ks_ + d0 * 2048 + 512); \
            if (d0 == 0) { PD0 = __builtin_amdgcn_mfma_f32_32x32x16_bf16(k0, qr[0], zero16, 0, 0, 0); PD1 = __builtin_amdgcn_mfma_f32_32x32x16_bf16(k1, qr[0], zero16, 0, 0, 0); } \
            else { PD0 = __builtin_amdgcn_mfma_f32_32x32x16_bf16(k0, qr[d0], PD0, 0, 0, 0); PD1 = __builtin_amdgcn_mfma_f32_32x32x16_bf16(k1, qr[d0], PD1, 0, 0, 0); } } } while (0)
#define MX3(a, b, c) __builtin_fmaxf(__builtin_fmaxf((a), (b)), (c))
#define AT_STEP(PC0, PC1, PN0, PN1, t) do { \
        if ((t) + 2 < nkt) { asm volatile("s_waitcnt vmcnt(3)" ::: "memory"); } else { asm volatile("s_waitcnt vmcnt(0)" ::: "memory"); } \
        asm volatile("s_waitcnt lgkmcnt(0)" ::: "memory"); \
        __builtin_amdgcn_s_barrier(); asm volatile("" ::: "memory"); \
        if ((t) + 3 < nkt) AT_ISSUE((t) + 3, ((t) + 3) & 3); \
        if ((t) + 1 < nkt) AT_QK(PN0, PN1, ((t) + 1) & 3); \
        float ra = MX3(PC0[0], PC0[1], PC1[0]), rb = MX3(PC0[2], PC0[3], PC1[1]); ra = MX3(ra, PC1[2], PC1[3]); \
        _Pragma("unroll") for (int r = 4; r < 16; r += 4) { ra = MX3(ra, PC0[r], PC0[r + 1]); rb = MX3(rb, PC0[r + 2], PC0[r + 3]); ra = MX3(ra, PC1[r], PC1[r + 1]); rb = MX3(rb, PC1[r + 2], PC1[r + 3]); } \
        const float rm = half_max32(fmaxf(ra, rb));                            \
        const bool trig = ((t) == 0) ? __any(fabsf(rm) > 30.0f) : __any(rm - m_run > 30.0f); \
        if (trig) {                                                            \
            const float m_new = ((t) == 0) ? rm : fmaxf(m_run, rm), alpha = ((t) == 0) ? 1.0f : __builtin_amdgcn_exp2f(m_run - m_new); \
            m_run = m_new; \
            if (hi == 0) wsf[r32] = alpha; \
            asm volatile("s_waitcnt lgkmcnt(0)" ::: "memory"); \
            _Pragma("unroll") for (int r = 0; r < 16; ++r) { const float a_ = wsf[crow(r, hi)]; o0[r] *= a_; o1[r] *= a_; ol[r] *= a_; } \
            asm volatile("s_waitcnt lgkmcnt(0)" ::: "memory"); } \
        if (__any(m_run != 0.f)) { _Pragma("unroll") for (int r = 0; r < 16; ++r) { PC0[r] -= m_run; PC1[r] -= m_run; } }      \
        _Pragma("unroll") for (int r = 0; r < 16; ++r) { PC0[r] = __builtin_amdgcn_exp2f(PC0[r]); PC1[r] = __builtin_amdgcn_exp2f(PC1[r]); } \
        u32x4 pw[4]; \
        _Pragma("unroll") for (int k = 0; k < 4; ++k) { const int b0 = (k & 1) * 8; \
            if (k < 2) { pw[k].x = cvt_pk_bf16(PC0[b0], PC0[b0 + 1]); pw[k].y = cvt_pk_bf16(PC0[b0 + 2], PC0[b0 + 3]); pw[k].z = cvt_pk_bf16(PC0[b0 + 4], PC0[b0 + 5]); pw[k].w = cvt_pk_bf16(PC0[b0 + 6], PC0[b0 + 7]); } \
            else { pw[k].x = cvt_pk_bf16(PC1[b0], PC1[b0 + 1]); pw[k].y = cvt_pk_bf16(PC1[b0 + 2], PC1[b0 + 3]); pw[k].z = cvt_pk_bf16(PC1[b0 + 4], PC1[b0 + 5]); pw[k].w = cvt_pk_bf16(PC1[b0 + 6], PC1[b0 + 7]); } } \
        _Pragma("unroll") for (int d0 = 0; d0 < 2; ++d0) { \
            const int d = 32 * d0 + r32, swz = (d >> 1) & 7; \
            const LAS unsigned char* vrow = lds + OFF_V + ((t) & 3) * VSLOT + d * 128; \
            _Pragma("unroll") for (int k = 0; k < 4; ++k) { \
                const u32x4 vw = *(const LAS u32x4*)(vrow + (((2 * k + hi) ^ swz) * 16));     \
                if (d0 == 0) o0 = __builtin_amdgcn_mfma_f32_32x32x16_bf16(__builtin_bit_cast(bf16x8, pw[k]), __builtin_bit_cast(bf16x8, vw), o0, 0, 0, 0); \
                else         o1 = __builtin_amdgcn_mfma_f32_32x32x16_bf16(__builtin_bit_cast(bf16x8, pw[k]), __builtin_bit_cast(bf16x8, vw), o1, 0, 0, 0); } } \
        _Pragma("unroll") for (int k = 0; k < 4; ++k) ol = __builtin_amdgcn_mfma_f32_32x32x16_bf16(__builtin_bit_cast(bf16x8, pw[k]), __builtin_bit_cast(bf16x8, onesw), ol, 0, 0, 0); \
    } while (0)
    AT_ISSUE(0, 0); AT_ISSUE(1, 1); AT_ISSUE(2, 2);
    asm volatile("s_waitcnt vmcnt(6)" ::: "memory");
    __builtin_amdgcn_s_barrier(); asm volatile("" ::: "memory");
    f32x16 pA0, pA1, pB0, pB1;
    AT_QK(pA0, pA1, 0);
    for (int t = 0; t < nkt; t += 2) {
        AT_STEP(pA0, pA1, pB0, pB1, t);
        AT_STEP(pB0, pB1, pA0, pA1, t + 1);
    }
#undef AT_STEP
#undef AT_QK
#undef MX3
    asm volatile("s_waitcnt lgkmcnt(0)" ::: "memory");
    __builtin_amdgcn_s_barrier(); asm volatile("" ::: "memory");
    LAS bf16_t* stg = (LAS bf16_t*)(lds + OFF_OST + wid * 4096);
#pragma unroll
    for (int r = 0; r < 16; ++r) { const int q = crow(r, hi); const float rl = __builtin_amdgcn_rcpf(ol[r]);
        stg[q * 64 + r32] = f2bf(o0[r] * rl); stg[q * 64 + 32 + r32] = f2bf(o1[r] * rl); }
    asm volatile("s_waitcnt lgkmcnt(0)" ::: "memory");
    unsigned char* Ow = O + (rowb + qrow0 + wid * 32) * 512 + h * 64;
#pragma unroll
    for (int i = 0; i < 2; ++i) { const int row = i * 16 + (lane >> 2), ch = lane & 3; const u32x4 v0 = *(const LAS u32x4*)(stg + row * 64 + ch * 16), v1 = *(const LAS u32x4*)(stg + row * 64 + ch * 16 + 8);
        u32x4 w; w.x = cvt4_fp8s(bflo(v0.x), bfhi(v0.x), bflo(v0.y), bfhi(v0.y)); w.y = cvt4_fp8s(bflo(v0.z), bfhi(v0.z), bflo(v0.w), bfhi(v0.w));
        w.z = cvt4_fp8s(bflo(v1.x), bfhi(v1.x), bflo(v1.y), bfhi(v1.y)); w.w = cvt4_fp8s(bflo(v1.z), bfhi(v1.z), bflo(v1.w), bfhi(v1.w));
        *(u32x4*)(Ow + (size_t)row * 512 + ch * 16) = w; }
    asm volatile("s_waitcnt lgkmcnt(0)" ::: "memory");
#undef AT_ISSUE
}

__device__ __forceinline__ void attn_phase(char* ws, LAS unsigned char* lds, int l, int G, int c) {
    for (int i = 0; ; ++i) {
        int bh, qb;
        if (G == 256) { if (i >= 4) break; const int x = c & 7, s = c >> 3; bh = 16 * i + 2 * x + (s >> 4); qb = s & 15; }
        else { const int L = i * G + c; if (L >= 1024) break; bh = L >> 4; qb = L & 15; }
        attn_unit(ws, lds, bh >> 3, bh & 7, CTX + qb * 256, NCHUNK);
    }
    if (l < DEPTH - 1) for (int u = c; u < 64; u += G) attn_unit(ws, lds, u >> 3, u & 7, 0, 4);
}
}
namespace gla {
constexpr int LD = 72;
constexpr int GS = 65;
constexpr int O_GT = 0, O_UG = 33792, O_WGT4 = 116736, O_B4 = O_WGT4 + 32768, O_KST = 50688, O_QG = 50688, O_KG = 59904, O_VTL = 69120, O_STL = 87552, O_AM = 105984, O_EGM = 115200, OF_LD = 132;
typedef float LAS* lfp; typedef bf16_t LAS* lbp;

struct Pre { u32x4 ug; unsigned short kk[8]; unsigned short vv[16]; };

__device__ __forceinline__ void prefetch(const char* ws, int h, size_t row0, int tid, Pre& P) {
    if (tid < 256) P.ug = *(const u32x4*)((const bf16_t*)(ws + WS_UKV) + (row0 + (tid >> 2)) * 256 + 160 + (tid & 3) * 8);
    { const int d = tid & 63, sg = tid >> 6; const bf16_t* kp = (const bf16_t*)(ws + WS_GK) + (row0 + sg * 8) * 256 + h * 64 + d;
#pragma unroll
      for (int j = 0; j < 8; ++j) P.kk[j] = kp[(size_t)j * 256]; }
    { const int e = tid & 127, sq = tid >> 7; const bf16_t* vp = (const bf16_t*)(ws + WS_GV) + (row0 + sq * 16) * 512 + h * 128 + e;
#pragma unroll
      for (int j = 0; j < 16; ++j) P.vv[j] = vp[(size_t)j * 512]; }
}
__device__ __forceinline__ void put_vt(const Pre& P, int tid, LAS unsigned char* lds) {
    lbp VTL = (lbp)(lds + O_VTL); const int e = tid & 127, sq = tid >> 7;
    u32x4 w0, w1;
    w0.x = P.vv[0] | ((unsigned)P.vv[1] << 16); w0.y = P.vv[2] | ((unsigned)P.vv[3] << 16); w0.z = P.vv[4] | ((unsigned)P.vv[5] << 16); w0.w = P.vv[6] | ((unsigned)P.vv[7] << 16);
    w1.x = P.vv[8] | ((unsigned)P.vv[9] << 16); w1.y = P.vv[10] | ((unsigned)P.vv[11] << 16); w1.z = P.vv[12] | ((unsigned)P.vv[13] << 16); w1.w = P.vv[14] | ((unsigned)P.vv[15] << 16);
    *(LAS u32x4*)(VTL + e * LD + sq * 16) = w0; *(LAS u32x4*)(VTL + e * LD + sq * 16 + 8) = w1;
}

__device__ __forceinline__ void load_gate_weights(const PTab& p, int l, LAS unsigned char* lds) {
    const int tid = ltid(); lfp W4 = (lfp)(lds + O_WGT4); lfp B4 = (lfp)(lds + O_B4);
    const float* wgf = p.w_gf(); const float* wgb = p.w_gb(); const float* bgf = p.b_gf(); const float* bgb = p.b_gb();
    for (int i = tid; i < 8192; i += 512) { const int h = i >> 11, dir = (i >> 10) & 1, r = (i >> 6) & 15, d = i & 63; W4[i] = (dir ? wgb : wgf)[((size_t)l * 16 + r) * 256 + h * 64 + d]; }
    { const int h = tid >> 7, dir = (tid >> 6) & 1, d = tid & 63; B4[tid] = (dir ? bgb : bgf)[l * 256 + h * 64 + d]; }
    __syncthreads();
}
__device__ __forceinline__ void gates(int h, const Pre& P, int tid, LAS unsigned char* lds) {
    lfp GT = (lfp)(lds + O_GT); lfp UG = (lfp)(lds + O_UG); lfp WGT = (lfp)(lds + O_WGT4) + h * 2048; lfp BS = (lfp)(lds + O_B4) + h * 128;
    if (tid < 256) { const int s = tid >> 2, q = tid & 3, dir = q >> 1, r0 = (q & 1) * 8; float f[8]; unpack8(P.ug, f);
#pragma unroll
        for (int j = 0; j < 8; ++j) UG[(dir * 64 + s) * 16 + r0 + j] = f[j]; }
    __syncthreads();
    { const int d = tid & 63, sg = tid >> 6;
#pragma unroll
      for (int dir = 0; dir < 2; ++dir) {
          float w[16];
#pragma unroll
          for (int r = 0; r < 16; ++r) w[r] = WGT[(dir * 16 + r) * 64 + d];
          const float bias = BS[dir * 64 + d];
#pragma unroll
          for (int j = 0; j < 8; ++j) { const int s = sg * 8 + j; float z = bias;
#pragma unroll
              for (int r4 = 0; r4 < 4; ++r4) { const f32x4 u = *(const LAS f32x4*)(UG + (dir * 64 + s) * 16 + r4 * 4); z += u[0] * w[4 * r4] + u[1] * w[4 * r4 + 1] + u[2] * w[4 * r4 + 2] + u[3] * w[4 * r4 + 3]; }
              const float ls = fminf(z, 0.f) - __logf(1.0f + __expf(-fabsf(z)));
              GT[(dir * 64 + d) * GS + s] = ls * (1.0f / 16.0f); } } }
    __syncthreads();
    { const int lane = tid & 63, w = tid >> 6;
#pragma unroll
      for (int i = 0; i < 16; ++i) { const int r = w * 16 + i; const float v0 = GT[r * GS + lane]; float v = v0;
          v += __builtin_bit_cast(float, __builtin_amdgcn_update_dpp(0, __builtin_bit_cast(int, v), 0x111, 0xf, 0xf, true));
          v += __builtin_bit_cast(float, __builtin_amdgcn_update_dpp(0, __builtin_bit_cast(int, v), 0x112, 0xf, 0xf, true));
          v += __builtin_bit_cast(float, __builtin_amdgcn_update_dpp(0, __builtin_bit_cast(int, v), 0x114, 0xf, 0xf, true));
          v += __builtin_bit_cast(float, __builtin_amdgcn_update_dpp(0, __builtin_bit_cast(int, v), 0x118, 0xf, 0xf, true));
          v += __builtin_bit_cast(float, __builtin_amdgcn_update_dpp(0, __builtin_bit_cast(int, v), 0x142, 0xa, 0xf, false));
          v += __builtin_bit_cast(float, __builtin_amdgcn_update_dpp(0, __builtin_bit_cast(int, v), 0x143, 0xc, 0xf, false));
          if (r >= 64) { const float tot = __builtin_bit_cast(float, __builtin_amdgcn_readlane(__builtin_bit_cast(int, v), 63)); v = tot - v + v0; }
          GT[r * GS + lane] = v; } }
    __syncthreads();
}

__device__ __forceinline__ void g1_compute(char* ws, int b, int h, int blk, const Pre& P, int tid, LAS unsigned char* lds) {
    const int lane = tid & 63, wid = tid >> 6, fr = lane & 15, fq = lane >> 4;
    gates(h, P, tid, lds);
    lfp GT = (lfp)(lds + O_GT); lbp KST = (lbp)(lds + O_KST); lbp VTL = (lbp)(lds + O_VTL);
    { const int d = tid & 63, sg = tid >> 6;
#pragma unroll
      for (int dir = 0; dir < 2; ++dir) { const float gl = GT[(dir * 64 + d) * GS + (dir ? 0 : 63)]; float o[8];
#pragma unroll
          for (int j = 0; j < 8; ++j) o[j] = bf2f(P.kk[j]) * __expf(gl - GT[(dir * 64 + d) * GS + sg * 8 + j]);
          u32x4 w; w.x = cvt_pk_bf16(o[0], o[1]); w.y = cvt_pk_bf16(o[2], o[3]); w.z = cvt_pk_bf16(o[4], o[5]); w.w = cvt_pk_bf16(o[6], o[7]);
          *(LAS u32x4*)(KST + (dir * 64 + d) * LD + sg * 8) = w; } }
    put_vt(P, tid, lds);
    { const int s8 = tid >> 3, dg = tid & 7; unsigned short* gg = (unsigned short*)(ws + WS_GG) + ((size_t)b * RPB + blk * 64 + s8) * 512 + h * 64 + dg * 8;
#pragma unroll
      for (int dir = 0; dir < 2; ++dir) { f32x4 a, c4;
#pragma unroll
          for (int j = 0; j < 4; ++j) { a[j] = GT[(dir * 64 + dg * 8 + j) * GS + s8]; c4[j] = GT[(dir * 64 + dg * 8 + 4 + j) * GS + s8]; }
          u32x4 w; w.x = pk_f16(a[0], a[1]); w.y = pk_f16(a[2], a[3]); w.z = pk_f16(c4[0], c4[1]); w.w = pk_f16(c4[2], c4[3]);
          *(u32x4*)(gg + dir * 256) = w; } }
    const size_t item = ((size_t)(b * 4 + h) * 2) * NCHUNK;
    if (tid < 128) { const int dir = tid >> 6, d = tid & 63; ((float*)(ws + WS_DEC))[(item + dir * NCHUNK + blk) * 64 + d] = __expf(GT[(dir * 64 + d) * GS + (dir ? 0 : 63)]); }
    __syncthreads();
#pragma unroll
    for (int dir = 0; dir < 2; ++dir) {
        bf16_t* kv = (bf16_t*)(ws + WS_KVS) + (item + dir * NCHUNK + blk) * 8192;
#pragma unroll
        for (int db = 0; db < 4; ++db) { f32x4 acc = {0.f, 0.f, 0.f, 0.f};
#pragma unroll
            for (int ks = 0; ks < 2; ++ks) { const bf16x8 a = *(const LAS bf16x8*)(KST + (dir * 64 + db * 16 + fr) * LD + ks * 32 + 8 * fq), bb = *(const LAS bf16x8*)(VTL + (wid * 16 + fr) * LD + ks * 32 + 8 * fq);
                acc = __builtin_amdgcn_mfma_f32_16x16x32_bf16(a, bb, acc, 0, 0, 0); }
            u32x2 w; w.x = cvt_pk_bf16(acc[0], acc[1]); w.y = cvt_pk_bf16(acc[2], acc[3]);
            *(u32x2*)(kv + (wid * 16 + fr) * 64 + db * 16 + 4 * fq) = w; } }
    __syncthreads();
}

__device__ __forceinline__ void g2_item(char* ws, int ch, int sl) {
    const int tid = ltid(), e = sl * 32 + (tid >> 4), d4 = (tid & 15) * 4, dir = ch & 1;
    bf16_t* KV = (bf16_t*)(ws + WS_KVS) + (size_t)ch * NCHUNK * 8192 + e * 64 + d4; const float* DEC = (const float*)(ws + WS_DEC) + (size_t)ch * NCHUNK * 64 + d4;
    f32x4 S = {0.f, 0.f, 0.f, 0.f};
#pragma unroll 4
    for (int cp = 0; cp < NCHUNK; ++cp) { const int blk = dir ? (cp < 4 ? 3 - cp : 71 - cp) : cp;
        u32x2* ptr = (u32x2*)(KV + (size_t)blk * 8192); const u32x2 kvw = *ptr; const f32x4 dec = *(const f32x4*)(DEC + blk * 64);
        u32x2 sw; sw.x = cvt_pk_bf16(S[0], S[1]); sw.y = cvt_pk_bf16(S[2], S[3]); *ptr = sw;
        S[0] = dec[0] * S[0] + bflo(kvw.x); S[1] = dec[1] * S[1] + bfhi(kvw.x); S[2] = dec[2] * S[2] + bflo(kvw.y); S[3] = dec[3] * S[3] + bfhi(kvw.y); }
}

constexpr int O3_QG = 0, O3_KG = 18432, O3_VTL = 36864, O3_STL = 55296, O3_AM = 92160, O3_OF = 0;
struct Pre3 { unsigned short vv[16]; u32x4 qw, kw, sw[2][2], og0, og1, gg[2]; };
__device__ __forceinline__ void g3_load(const char* ws, int b, int h, int blk, int tid, Pre3& R) {
    const size_t row0 = (size_t)b * RPB + blk * 64; const size_t item = ((size_t)(b * 4 + h) * 2) * NCHUNK; const int s8 = tid >> 3, dg = tid & 7;
    { const int e = tid & 127, sq = tid >> 7; const bf16_t* vp = (const bf16_t*)(ws + WS_GV) + (row0 + sq * 16) * 512 + h * 128 + e;
#pragma unroll
      for (int j = 0; j < 16; ++j) R.vv[j] = vp[(size_t)j * 512]; }
    R.qw = *(const u32x4*)((const bf16_t*)(ws + WS_GQ) + (row0 + s8) * 256 + h * 64 + dg * 8);
    R.kw = *(const u32x4*)((const bf16_t*)(ws + WS_GK) + (row0 + s8) * 256 + h * 64 + dg * 8);
#pragma unroll
    for (int dir = 0; dir < 2; ++dir) { const bf16_t* sp = (const bf16_t*)(ws + WS_KVS) + (item + dir * NCHUNK + blk) * 8192 + (tid >> 2) * 64 + (tid & 3) * 16; R.sw[dir][0] = *(const u32x4*)sp; R.sw[dir][1] = *(const u32x4*)(sp + 8);
        const unsigned short* gp = (const unsigned short*)(ws + WS_GG) + (row0 + s8) * 512 + dir * 256 + h * 64 + dg * 8; R.gg[dir] = *(const u32x4*)gp; }
    const bf16_t* ogp = (const bf16_t*)(ws + WS_GOG) + (row0 + s8) * 512 + h * 128 + dg * 16;
    R.og0 = *(const u32x4*)ogp; R.og1 = *(const u32x4*)(ogp + 8);
}
__device__ __forceinline__ void g3_compute(char* ws, const float* norm_g, int b, int h, int blk, const Pre3& R, int tid, LAS unsigned char* lds) {
    const int lane = tid & 63, wid = tid >> 6, fr = lane & 15, fq = lane >> 4, s8 = tid >> 3, dg = tid & 7;
    const size_t row0 = (size_t)b * RPB + blk * 64;
    lbp QG = (lbp)(lds + O3_QG); lbp KG = (lbp)(lds + O3_KG); lbp VTL = (lbp)(lds + O3_VTL); lbp STL = (lbp)(lds + O3_STL); lbp AM = (lbp)(lds + O3_AM);
    { const int e = tid & 127, sq = tid >> 7; u32x4 w0, w1;
      w0.x = R.vv[0] | ((unsigned)R.vv[1] << 16); w0.y = R.vv[2] | ((unsigned)R.vv[3] << 16); w0.z = R.vv[4] | ((unsigned)R.vv[5] << 16); w0.w = R.vv[6] | ((unsigned)R.vv[7] << 16);
      w1.x = R.vv[8] | ((unsigned)R.vv[9] << 16); w1.y = R.vv[10] | ((unsigned)R.vv[11] << 16); w1.z = R.vv[12] | ((unsigned)R.vv[13] << 16); w1.w = R.vv[14] | ((unsigned)R.vv[15] << 16);
      *(LAS u32x4*)(VTL + e * LD + sq * 16) = w0; *(LAS u32x4*)(VTL + e * LD + sq * 16 + 8) = w1; }
    { float qf[8], kf[8]; unpack8(R.qw, qf); unpack8(R.kw, kf);
#pragma unroll
      for (int dir = 0; dir < 2; ++dir) { float qo[8], ko[8];
          float gf[8]; un_f16(R.gg[dir].x, gf[0], gf[1]); un_f16(R.gg[dir].y, gf[2], gf[3]); un_f16(R.gg[dir].z, gf[4], gf[5]); un_f16(R.gg[dir].w, gf[6], gf[7]);
#pragma unroll
          for (int j = 0; j < 8; ++j) { const float g = gf[j]; qo[j] = qf[j] * __expf(g); ko[j] = kf[j] * __expf(-g); }
          u32x4 w; w.x = cvt_pk_bf16(qo[0], qo[1]); w.y = cvt_pk_bf16(qo[2], qo[3]); w.z = cvt_pk_bf16(qo[4], qo[5]); w.w = cvt_pk_bf16(qo[6], qo[7]); *(LAS u32x4*)(QG + (dir * 64 + s8) * LD + dg * 8) = w;
          w.x = cvt_pk_bf16(ko[0], ko[1]); w.y = cvt_pk_bf16(ko[2], ko[3]); w.z = cvt_pk_bf16(ko[4], ko[5]); w.w = cvt_pk_bf16(ko[6], ko[7]); *(LAS u32x4*)(KG + (dir * 64 + s8) * LD + dg * 8) = w;
          const int e = tid >> 2, dq = tid & 3;
          *(LAS u32x4*)(STL + (dir * 128 + e) * LD + dq * 16) = R.sw[dir][0]; *(LAS u32x4*)(STL + (dir * 128 + e) * LD + dq * 16 + 8) = R.sw[dir][1]; } }
    __syncthreads();
#pragma unroll
    for (int dir = 0; dir < 2; ++dir) { const int tb = wid >> 1;
#pragma unroll
        for (int q = 0; q < 2; ++q) { const int sb = (wid & 1) * 2 + q; f32x4 a4 = {0.f, 0.f, 0.f, 0.f};
            const bool live = dir ? (sb >= tb) : (sb <= tb);
            if (live) {
#pragma unroll
                for (int ks = 0; ks < 2; ++ks) { const bf16x8 a = *(const LAS bf16x8*)(KG + (dir * 64 + sb * 16 + fr) * LD + ks * 32 + 8 * fq), bb = *(const LAS bf16x8*)(QG + (dir * 64 + tb * 16 + fr) * LD + ks * 32 + 8 * fq);
                    a4 = __builtin_amdgcn_mfma_f32_16x16x32_bf16(a, bb, a4, 0, 0, 0); } }
            const int t = tb * 16 + fr, s0 = sb * 16 + 4 * fq;
#pragma unroll
            for (int j = 0; j < 4; ++j) { const int s = s0 + j; const bool keep = dir ? (s >= t) : (s <= t); if (!keep) a4[j] = 0.f; }
            u32x2 w; w.x = cvt_pk_bf16(a4[0], a4[1]); w.y = cvt_pk_bf16(a4[2], a4[3]); *(LAS u32x2*)(AM + (dir * 64 + t) * LD + s0) = w; } }
    __syncthreads();
    f32x4 acc[4];
#pragma unroll
    for (int i = 0; i < 4; ++i) acc[i] = (f32x4){0.f, 0.f, 0.f, 0.f};
#pragma unroll
    for (int dir = 0; dir < 2; ++dir)
#pragma unroll
        for (int tb = 0; tb < 4; ++tb) {
#pragma unroll
            for (int ks = 0; ks < 2; ++ks) { const bf16x8 a = *(const LAS bf16x8*)(VTL + (wid * 16 + fr) * LD + ks * 32 + 8 * fq), bb = *(const LAS bf16x8*)(AM + (dir * 64 + tb * 16 + fr) * LD + ks * 32 + 8 * fq);
                acc[tb] = __builtin_amdgcn_mfma_f32_16x16x32_bf16(a, bb, acc[tb], 0, 0, 0); }
#pragma unroll
            for (int ks = 0; ks < 2; ++ks) { const bf16x8 a = *(const LAS bf16x8*)(STL + (dir * 128 + wid * 16 + fr) * LD + ks * 32 + 8 * fq), bb = *(const LAS bf16x8*)(QG + (dir * 64 + tb * 16 + fr) * LD + ks * 32 + 8 * fq);
                acc[tb] = __builtin_amdgcn_mfma_f32_16x16x32_bf16(a, bb, acc[tb], 0, 0, 0); } }
    __syncthreads();
    lfp OF = (lfp)(lds + O3_OF);
#pragma unroll
    for (int tb = 0; tb < 4; ++tb) *(LAS f32x4*)(OF + (tb * 16 + fr) * OF_LD + wid * 16 + 4 * fq) = acc[tb];
    __syncthreads();
    { const int t = s8, part = dg; float o[16]; float ss = 0.f;
#pragma unroll
      for (int j = 0; j < 4; ++j) { const f32x4 v = *(const LAS f32x4*)(OF + t * OF_LD + part * 16 + j * 4); o[4 * j] = v[0]; o[4 * j + 1] = v[1]; o[4 * j + 2] = v[2]; o[4 * j + 3] = v[3]; ss += v[0] * v[0] + v[1] * v[1] + v[2] * v[2] + v[3] * v[3]; }
      ss += lane_xor<1>(ss, 0); ss += lane_xor<2>(ss, 0); ss += lane_xor<4>(ss, 0);
      const float rs = rsqrtf(ss * (1.0f / 128.0f) + EPS);
      const float* ng = norm_g + h * 128 + part * 16;
      unsigned char* dst = (unsigned char*)(ws + WS_OGLA) + (row0 + t) * 512 + h * 128 + part * 16;
#pragma unroll
      for (int hh = 0; hh < 2; ++hh) { float g[8]; unpack8(hh ? R.og1 : R.og0, g); float r[8];
#pragma unroll
          for (int j = 0; j < 8; ++j) r[j] = o[hh * 8 + j] * rs * ng[hh * 8 + j] * siluf_(g[j]);
          u32x2 w; w.x = cvt4_fp8s(r[0], r[1], r[2], r[3]); w.y = cvt4_fp8s(r[4], r[5], r[6], r[7]); *(u32x2*)(dst + hh * 8) = w; } }
    __syncthreads();
}

__device__ __forceinline__ void g1_phase(const PTab& p, int l, LAS unsigned char* lds, int G, int c) {
    char* ws = p.ws(); const int tid = ltid(); constexpr int NIT = NB * 4 * NCHUNK;
    load_gate_weights(p, l, lds);
    int it = c; if (it >= NIT) return;
    Pre cur; prefetch(ws, (it / NCHUNK) & 3, (size_t)(it / (4 * NCHUNK)) * RPB + (it % NCHUNK) * 64, tid, cur);
    for (;;) { const int nx = it + G; Pre nxt = cur;
        if (nx < NIT) prefetch(ws, (nx / NCHUNK) & 3, (size_t)(nx / (4 * NCHUNK)) * RPB + (nx % NCHUNK) * 64, tid, nxt);
        g1_compute(ws, it / (4 * NCHUNK), (it / NCHUNK) & 3, it % NCHUNK, cur, tid, lds);
        if (nx >= NIT) break; cur = nxt; it = nx; }
}
__device__ __forceinline__ void g3_phase(const PTab& p, int l, LAS unsigned char* lds, int G, int c) {
    char* ws = p.ws(); const int tid = ltid(); const float* ng = p.gla_norm_g() + l * 512;
    const int nblk = (l == DEPTH - 1) ? 64 : NCHUNK, blk0 = NCHUNK - nblk, NIT = NB * 4 * nblk;
    int it = c; if (it >= NIT) return;
    Pre3 cur; g3_load(ws, it / (4 * nblk), (it / nblk) & 3, blk0 + it % nblk, tid, cur);
    for (;;) { const int nx = it + G; Pre3 nxt = cur;
        if (nx < NIT) g3_load(ws, nx / (4 * nblk), (nx / nblk) & 3, blk0 + nx % nblk, tid, nxt);
        g3_compute(ws, ng, it / (4 * nblk), (it / nblk) & 3, blk0 + it % nblk, cur, tid, lds);
        if (nx >= NIT) break; cur = nxt; it = nx; }
}
}
namespace moe {
constexpr int A_LG = LDS_AUX + 1024, A_HIST = LDS_AUX + 5120, A_BASE = LDS_AUX + 5248, A_TB = LDS_AUX + 5376, A_CN = LDS_AUX + 5632, A_RANK = LDS_AUX + 6144;
constexpr int RWS = 1028;
__device__ __forceinline__ int n_act_rows(int l) { return (l < DEPTH - 1) ? T : NB * SEQ; }
__device__ __forceinline__ int act_row(int l, int r) { return (l < DEPTH - 1) ? r : (r >> 12) * RPB + CTX + (r & 4095); }

__device__ __forceinline__ void tables(char* ws, int l, LAS unsigned char* lds) {
    LAS int* tb = (LAS int*)(lds + A_TB); LAS int* cn = (LAS int*)(lds + A_CN); const int t = ltid();
    if (t < 32) { const int n = (int)__hip_atomic_load((unsigned*)(ws + WS_CTL + CTL_CNT) + l * 32 + t, __ATOMIC_RELAXED, __HIP_MEMORY_SCOPE_AGENT); cn[t] = n; cn[32 + t] = (n + 255) >> 8; }
    __syncthreads();
    if (t <= 32) { int run = 0; for (int e = 0; e < t; ++e) run += cn[32 + e]; tb[t] = run; }
    __syncthreads();
}

__device__ __forceinline__ void route_phase(const PTab& p, int l, LAS unsigned char* lds, int G, int c, int dry = 0) {
    const int tid = ltid(), lane = tid & 63, wid = tid >> 6; char* ws = p.ws();
    LAS float* RW = (LAS float*)lds;
    LAS float* LG = (LAS float*)(lds + A_LG) + wid * 32; LAS int* hist = (LAS int*)(lds + A_HIST); LAS int* base = (LAS int*)(lds + A_BASE); LAS int* rank = (LAS int*)(lds + A_RANK);
    { const float* rw = p.router_w() + (size_t)l * 1024 * 32;
      for (int i = tid; i < 32768; i += 512) { const int k = i >> 5, e = i & 31; RW[e * RWS + k] = rw[i]; } }
    if (tid < 32) hist[tid] = 0;
    __syncthreads();
    const int nact = n_act_rows(l), chunk = (nact + G - 1) / G, r0 = c * chunk, r1 = (r0 + chunk < nact) ? r0 + chunk : nact;
    const bf16_t* X = (const bf16_t*)(ws + WS_X); unsigned char* H8 = (unsigned char*)(ws + WS_H8);
    const float* M = (const float*)(ws + WS_MOD) + (size_t)l * 9 * 6144; const float* g2n = p.norm2_g() + l * D; const float* rb = p.router_b() + l * 32;
    for (int rb0 = r0 + wid; rb0 < r1; rb0 += 32) {
        f32x4 hv[4][4]; int rows[4]; bool ok[4];
#pragma unroll
        for (int q = 0; q < 4; ++q) { const int r = rb0 + 8 * q; ok[q] = r < r1; rows[q] = act_row(l, ok[q] ? r : rb0); const bf16_t* xr = X + (size_t)rows[q] * D;
#pragma unroll
            for (int i = 0; i < 4; ++i) { const u32x2 w = *(const u32x2*)(xr + i * 256 + lane * 4); hv[q][i] = (f32x4){bflo(w.x), bfhi(w.x), bflo(w.y), bfhi(w.y)}; } }
#pragma unroll
        for (int q = 0; q < 4; ++q) { const int row = rows[q], b = row / RPB, s = (row % RPB) < CTX ? 8 : b; const float* sh = M + s * 6144 + 3072; const float* sc = M + s * 6144 + 4096;
            float ss = 0.f;
#pragma unroll
            for (int i = 0; i < 4; ++i) ss += hv[q][i][0] * hv[q][i][0] + hv[q][i][1] * hv[q][i][1] + hv[q][i][2] * hv[q][i][2] + hv[q][i][3] * hv[q][i][3];
            ss = wave_sum(ss);
            const float rs = rsqrtf(ss * (1.0f / 1024.0f) + EPS);
#pragma unroll
            for (int i = 0; i < 4; ++i) { const int col = i * 256 + lane * 4; const f32x4 gg = *(const f32x4*)(g2n + col), sv = *(const f32x4*)(sh + col), cv = *(const f32x4*)(sc + col);
#pragma unroll
                for (int j = 0; j < 4; ++j) hv[q][i][j] = hv[q][i][j] * rs * gg[j] * (1.0f + cv[j]) + sv[j];
                if (!dry && ok[q]) *(unsigned*)(H8 + (size_t)row * D + col) = cvt4_fp8s(hv[q][i][0], hv[q][i][1], hv[q][i][2], hv[q][i][3]); } }
#pragma unroll 1
        for (int ec = 0; ec < 4; ++ec) {
            float a[4][8];
#pragma unroll
            for (int q = 0; q < 4; ++q)
#pragma unroll
                for (int e = 0; e < 8; ++e) a[q][e] = 0.f;
#pragma unroll
            for (int e = 0; e < 8; ++e)
#pragma unroll
                for (int i = 0; i < 4; ++i) { const f32x4 w = *(const LAS f32x4*)(RW + (ec * 8 + e) * RWS + i * 256 + lane * 4);
#pragma unroll
                    for (int q = 0; q < 4; ++q) a[q][e] += hv[q][i][0] * w[0] + hv[q][i][1] * w[1] + hv[q][i][2] * w[2] + hv[q][i][3] * w[3]; }
            const bool b5 = lane & 32, b4 = lane & 16, b3 = lane & 8;
#pragma unroll
            for (int q = 0; q < 4; ++q) {
#pragma unroll
                for (int i = 0; i < 4; ++i) { const float keep = b5 ? a[q][i + 4] : a[q][i], send = b5 ? a[q][i] : a[q][i + 4]; a[q][i] = keep + lane_xor<32>(send, lane); }
#pragma unroll
                for (int i = 0; i < 2; ++i) { const float keep = b4 ? a[q][i + 2] : a[q][i], send = b4 ? a[q][i] : a[q][i + 2]; a[q][i] = keep + lane_xor<16>(send, lane); }
                { const float keep = b3 ? a[q][1] : a[q][0], send = b3 ? a[q][0] : a[q][1]; a[q][0] = keep + lane_xor<8>(send, lane); }
                a[q][0] += lane_xor<4>(a[q][0], lane); a[q][0] += lane_xor<2>(a[q][0], lane); a[q][0] += lane_xor<1>(a[q][0], lane);
                const int e = ec * 8 + ((lane >> 5) & 1) * 4 + ((lane >> 4) & 1) * 2 + ((lane >> 3) & 1);
                if ((lane & 7) == 0) (LG + q * 256)[e] = a[q][0] + rb[e]; }
        }
        asm volatile("s_waitcnt lgkmcnt(0)" ::: "memory");
        {
            const int q = lane >> 4, sub = lane & 15;
            unsigned k0, k1;
            { const float l0 = (LG + q * 256)[sub], l1 = (LG + q * 256)[sub + 16];
              unsigned u0 = __float_as_uint(l0), u1 = __float_as_uint(l1);
              u0 = (u0 & 0x80000000u) ? ~u0 : (u0 | 0x80000000u); u1 = (u1 & 0x80000000u) ? ~u1 : (u1 | 0x80000000u);
              k0 = (u0 & ~31u) | (unsigned)(31 - sub); k1 = (u1 & ~31u) | (unsigned)(15 - sub); }
            float tv[4]; int ti[4];
#pragma unroll
            for (int k = 0; k < 4; ++k) { unsigned mx = k0 > k1 ? k0 : k1;
                { const unsigned o = (unsigned)__builtin_amdgcn_update_dpp(0, (int)mx, 0xB1, 0xf, 0xf, true); mx = o > mx ? o : mx; }
                { const unsigned o = (unsigned)__builtin_amdgcn_update_dpp(0, (int)mx, 0x4E, 0xf, 0xf, true); mx = o > mx ? o : mx; }
                { const unsigned o = (unsigned)__builtin_amdgcn_update_dpp(0, (int)mx, 0x141, 0xf, 0xf, true); mx = o > mx ? o : mx; }
                { const unsigned o = (unsigned)__builtin_amdgcn_update_dpp(0, (int)mx, 0x140, 0xf, 0xf, true); mx = o > mx ? o : mx; }
                k0 = (k0 == mx) ? 0u : k0; k1 = (k1 == mx) ? 0u : k1;
                ti[k] = 31 - (int)(mx & 31u); const unsigned u = mx & ~31u; tv[k] = __uint_as_float((u & 0x80000000u) ? (u & 0x7fffffffu) : ~u); }
            const float e1 = __expf(tv[1] - tv[0]), e2 = __expf(tv[2] - tv[0]), e3 = __expf(tv[3] - tv[0]), inv = 1.0f / (1.0f + e1 + e2 + e3);
            const int r = rb0 + 8 * q;
            if (sub < 4 && !dry && r < r1) { const int row = act_row(l, r); const int ek = sub == 0 ? ti[0] : sub == 1 ? ti[1] : sub == 2 ? ti[2] : ti[3]; const float gk = (sub == 0 ? 1.0f : sub == 1 ? e1 : sub == 2 ? e2 : e3) * inv;
                ((int*)(ws + WS_TOPI))[(size_t)row * 4 + sub] = ek; ((float*)(ws + WS_TOPG))[(size_t)row * 4 + sub] = gk;
                const int rk = atomicAdd((int*)(hist + ek), 1);
                rank[(r - r0) * 4 + sub] = rk | (ek << 24); }
        }
        asm volatile("s_waitcnt lgkmcnt(0)" ::: "memory");
    }
    __syncthreads();
    if (dry) return;
    if (tid < 32) base[tid] = (int)__hip_atomic_fetch_add((unsigned*)(ws + WS_CTL + CTL_CNT) + l * 32 + tid, (unsigned)hist[tid], __ATOMIC_RELAXED, __HIP_MEMORY_SCOPE_AGENT);
    __syncthreads();
    for (int i = tid; i < (r1 - r0) * 4; i += 512) { const int v = rank[i], e = v >> 24, rk = v & 0xffffff, row = act_row(l, r0 + (i >> 2)), pos = base[e] + rk;
        ((int*)(ws + WS_TOPP))[(size_t)row * 4 + (i & 3)] = pos; ((int*)(ws + WS_RT2))[(size_t)e * T + pos] = row; }
    __syncthreads();
}

__device__ __forceinline__ void permute_phase(const PTab& p, int l, LAS unsigned char* lds, int G, int c) {
    const int tid_ = ltid(), lane = tid_ & 63, wid = tid_ >> 6; char* ws = p.ws();
    tables(ws, l, lds);
    const LAS int* tb = (const LAS int*)(lds + A_TB); const LAS int* cn = (const LAS int*)(lds + A_CN);
    const bf16_t* H = (const bf16_t*)(ws + WS_H); bf16_t* HS = (bf16_t*)(ws + WS_HS);
    const int nact = n_act_rows(l);
    for (int r = c * 8 + wid; r < nact; r += G * 8) { const int row = act_row(l, r);
        const u32x4 a = *(const u32x4*)(H + (size_t)row * D + lane * 16), b = *(const u32x4*)(H + (size_t)row * D + lane * 16 + 8);
        const int* ti = (const int*)(ws + WS_TOPI) + (size_t)row * 4; const int* tp = (const int*)(ws + WS_TOPP) + (size_t)row * 4;
#pragma unroll
        for (int k = 0; k < 4; ++k) { const int e = ti[k], pos = tp[k]; bf16_t* d = HS + ((size_t)tb[e] * 256 + pos) * D + lane * 16; *(u32x4*)d = a; *(u32x4*)(d + 8) = b; } }
    for (int e = 0; e < NE; ++e) { const int n = cn[e], end = ((n + 255) >> 8) << 8;
        for (int pr = n + c * 8 + wid; pr < end; pr += G * 8) { bf16_t* d = HS + ((size_t)tb[e] * 256 + pr) * D + lane * 16; const u32x4 z = {0u, 0u, 0u, 0u}; *(u32x4*)d = z; *(u32x4*)(d + 8) = z; } }
}

__device__ __forceinline__ void combine_phase(const PTab& p, int l, LAS unsigned char* lds, int G, int c, int dry = 0) {
    const int tid_ = ltid(), lane = tid_ & 63, wid = tid_ >> 6; char* ws = p.ws();
    tables(ws, l, lds);
    const LAS int* tb = (const LAS int*)(lds + A_TB);
    bf16_t* X = (bf16_t*)(ws + WS_X); bf16_t* H = (bf16_t*)(ws + WS_H); const unsigned char* YM = (const unsigned char*)(ws + WS_YM);
    const float* M = (const float*)(ws + WS_MOD) + (size_t)l * 9 * 6144; const float* Mn = M + 9 * 6144;
    const int nact = n_act_rows(l); const float* n1g = p.norm1_g(); const float* fing = p.final_g(); float* outp = p.out();
    LAS float* g2s = (LAS float*)lds; LAS float* shs = g2s + 9 * 1024; LAS float* scs = shs + 9 * 1024; LAS float* gns = scs + 9 * 1024;
    for (int i = tid_; i < 9 * 256; i += 512) { const int s_ = i >> 8, q4 = (i & 255) * 4;
        *(LAS f32x4*)(g2s + s_ * 1024 + q4) = *(const f32x4*)(M + s_ * 6144 + 5120 + q4);
        if (l < DEPTH - 1) { *(LAS f32x4*)(shs + s_ * 1024 + q4) = *(const f32x4*)(Mn + s_ * 6144 + q4); *(LAS f32x4*)(scs + s_ * 1024 + q4) = *(const f32x4*)(Mn + s_ * 6144 + 1024 + q4); } }
    if (tid_ < 256) *(LAS f32x4*)(gns + tid_ * 4) = *(const f32x4*)(((l < DEPTH - 1) ? n1g + (l + 1) * D : fing) + tid_ * 4);
    __syncthreads();
    int r = c * 8 + wid; const int st = G * 8;
    typedef int i32x4 __attribute__((ext_vector_type(4)));
    i32x4 ti1 = {0, 0, 0, 0}, tp1 = {0, 0, 0, 0}; f32x4 tg0 = {0.f, 0.f, 0.f, 0.f}, tg1 = {0.f, 0.f, 0.f, 0.f};
    unsigned yw[4][4]; u32x2 xw[4];
#define CB_LOADT(rr, TI, TP, TG) do { if ((rr) < nact) { const int ro_ = act_row(l, (rr)); TI = *(const i32x4*)((const int*)(ws + WS_TOPI) + (size_t)ro_ * 4); TP = *(const i32x4*)((const int*)(ws + WS_TOPP) + (size_t)ro_ * 4); TG = *(const f32x4*)((const float*)(ws + WS_TOPG) + (size_t)ro_ * 4); } } while (0)
#define CB_LOADD(rr, TI, TP, YW, XW) do { if ((rr) < nact) { const int ro_ = act_row(l, (rr)); \
        _Pragma("unroll") for (int k = 0; k < 4; ++k) { const int e = TI[k], pos = TP[k]; const unsigned char* y = YM + ((size_t)tb[e] * 256 + pos) * D + lane * 4; \
            _Pragma("unroll") for (int i = 0; i < 4; ++i) YW[k][i] = *(const unsigned*)(y + i * 256); } \
        _Pragma("unroll") for (int i = 0; i < 4; ++i) XW[i] = *(const u32x2*)(X + (size_t)ro_ * D + i * 256 + lane * 4); } } while (0)
    { i32x4 ti0 = {0, 0, 0, 0}, tp0 = {0, 0, 0, 0};
      CB_LOADT(r, ti0, tp0, tg0); CB_LOADT(r + st, ti1, tp1, tg1);
      CB_LOADD(r, ti0, tp0, yw, xw); }
    for (; r < nact; r += st) { const int row = act_row(l, r), b = row / RPB, s = (row % RPB) < CTX ? 8 : b;
        i32x4 ti2 = {0, 0, 0, 0}, tp2 = {0, 0, 0, 0}; f32x4 tg2 = {0.f, 0.f, 0.f, 0.f}; unsigned ywn[4][4]; u32x2 xwn[4];
        CB_LOADT(r + 2 * st, ti2, tp2, tg2);
        CB_LOADD(r + st, ti1, tp1, ywn, xwn);
        f32x4 acc[4];
#pragma unroll
        for (int i = 0; i < 4; ++i) acc[i] = (f32x4){0.f, 0.f, 0.f, 0.f};
#pragma unroll
        for (int k = 0; k < 4; ++k) { const float gk = tg0[k] * (1.0f / YM_SCALE);
#pragma unroll
            for (int i = 0; i < 4; ++i) { float a0, a1, a2, a3; cvt_fp8x4(yw[k][i], a0, a1, a2, a3); acc[i][0] += gk * a0; acc[i][1] += gk * a1; acc[i][2] += gk * a2; acc[i][3] += gk * a3; } }
        u32x2 xwc[4];
#pragma unroll
        for (int i = 0; i < 4; ++i) xwc[i] = xw[i];
        tg0 = tg1; ti1 = ti2; tp1 = tp2; tg1 = tg2;
#pragma unroll
        for (int k = 0; k < 4; ++k)
#pragma unroll
            for (int i = 0; i < 4; ++i) yw[k][i] = ywn[k][i];
#pragma unroll
        for (int i = 0; i < 4; ++i) xw[i] = xwn[i];
        bf16_t* xrow = X + (size_t)row * D; const LAS float* g2 = g2s + s * 1024; f32x4 xv[4]; float ss = 0.f;
#pragma unroll
        for (int i = 0; i < 4; ++i) { const int col = i * 256 + lane * 4; { const u32x2 xw_ = xwc[i]; xv[i] = (f32x4){bflo(xw_.x), bfhi(xw_.x), bflo(xw_.y), bfhi(xw_.y)} + *(const LAS f32x4*)(g2 + col) * acc[i]; } if (!dry && l < DEPTH - 1) { u32x2 ow; ow.x = cvt_pk_bf16(xv[i][0], xv[i][1]); ow.y = cvt_pk_bf16(xv[i][2], xv[i][3]); *(u32x2*)(xrow + col) = ow; }
            ss += xv[i][0] * xv[i][0] + xv[i][1] * xv[i][1] + xv[i][2] * xv[i][2] + xv[i][3] * xv[i][3]; }
        ss = wave_sum(ss);
        const float rs = rsqrtf(ss * (1.0f / 1024.0f) + EPS);
        if (l < DEPTH - 1) { const LAS float* gn = gns; const LAS float* sh = shs + s * 1024; const LAS float* sc = scs + s * 1024;
#pragma unroll
            for (int i = 0; i < 4; ++i) { const int col = i * 256 + lane * 4; const f32x4 gg = *(const LAS f32x4*)(gn + col), sv = *(const LAS f32x4*)(sh + col), cv = *(const LAS f32x4*)(sc + col); float o[4];
#pragma unroll
                for (int j = 0; j < 4; ++j) o[j] = xv[i][j] * rs * gg[j] * (1.0f + cv[j]) + sv[j];
                u32x2 w; w.x = cvt_pk_bf16(o[0], o[1]); w.y = cvt_pk_bf16(o[2], o[3]); if (!dry) { *(u32x2*)(H + (size_t)row * D + col) = w; *(unsigned*)((unsigned char*)(ws + WS_HA8) + (size_t)row * D + col) = cvt4_fp8s(o[0], o[1], o[2], o[3]); } else asm volatile("" :: "v"(w)); } }
        else { float* orow = outp + (size_t)r * D;
#pragma unroll
            for (int i = 0; i < 4; ++i) { const int col = i * 256 + lane * 4; const f32x4 gg = *(const LAS f32x4*)(gns + col); { const f32x4 ov = xv[i] * rs * gg; if (!dry) *(f32x4*)(orow + col) = ov; else asm volatile("" :: "v"(ov)); } } }
    }
}
#undef CB_LOADT
#undef CB_LOADD
__device__ __forceinline__ void krope_job(char* ws, int G, int c) {
    const bf16_t* U = (const bf16_t*)(ws + WS_UKV); bf16_t* KR = (bf16_t*)(ws + WS_KR); const f32x2* rope = (const f32x2*)(ws + WS_ROPE);
    for (int i = c * 512 + ltid(); i < T * 16; i += G * 512) { const int row = i >> 4, pr = i & 15, axis = pr >> 3, f = pr & 7, tl = (row % RPB) - CTX;
        const float x1 = bf2f(U[(size_t)row * 256 + 128 + axis * 16 + f]), x2 = bf2f(U[(size_t)row * 256 + 128 + axis * 16 + 8 + f]); float o1 = x1, o2 = x2;
        if (tl >= 0) { const int pos = axis ? (tl & 63) : (tl >> 6); const f32x2 cs = rope[pos * 8 + f]; o1 = x1 * cs.x - x2 * cs.y; o2 = x2 * cs.x + x1 * cs.y; }
        *(unsigned*)(KR + (size_t)row * 32 + axis * 16 + 2 * f) = cvt_pk_bf16(o1, o2); }
}
}
constexpr int N_PHASES = 2 + 10 * DEPTH;
#ifndef MK_PER_PHASE
#define MK_PER_PHASE 0
#endif

__global__ void __launch_bounds__(512, 2) mega(Params p, int ph_lo, int ph_hi) {
    extern __shared__ __attribute__((aligned(16))) unsigned char smem_raw[];
    LAS unsigned char* lds0 = (LAS unsigned char*)smem_raw; LAS unsigned char* lds = lds0;
    const int G0 = (int)gridDim.x, c0 = (int)blockIdx.x;
    volatile LAS unsigned* st = (volatile LAS unsigned*)(lds + LDS_BYTES - 16);
    if (threadIdx.x == 0) { st[0] = 0u; st[1] = 0u; st[2] = 0u; st[3] = 0u;
        LAS unsigned long long* t = (LAS unsigned long long*)(lds + LDS_PTAB);
        t[0] = (unsigned long long)p.x; t[1] = (unsigned long long)p.c; t[2] = (unsigned long long)p.ctx; t[3] = (unsigned long long)p.c_ctx; t[4] = (unsigned long long)p.w_mod; t[5] = (unsigned long long)p.b_mod;
        t[6] = (unsigned long long)p.norm1_g; t[7] = (unsigned long long)p.w_in; t[8] = (unsigned long long)p.q_norm_g; t[9] = (unsigned long long)p.w_uq; t[10] = (unsigned long long)p.kv_norm_g; t[11] = (unsigned long long)p.w_ukv;
        t[12] = (unsigned long long)p.w_gf; t[13] = (unsigned long long)p.b_gf; t[14] = (unsigned long long)p.w_gb; t[15] = (unsigned long long)p.b_gb; t[16] = (unsigned long long)p.gla_norm_g; t[17] = (unsigned long long)p.w_br_mla;
        t[18] = (unsigned long long)p.w_br_fnet; t[19] = (unsigned long long)p.w_br_gla; t[20] = (unsigned long long)p.w_o; t[21] = (unsigned long long)p.norm2_g; t[22] = (unsigned long long)p.router_w; t[23] = (unsigned long long)p.router_b;
        t[24] = (unsigned long long)p.w_up; t[25] = (unsigned long long)p.b_up; t[26] = (unsigned long long)p.w_down; t[27] = (unsigned long long)p.b_down; t[28] = (unsigned long long)p.final_g; t[29] = (unsigned long long)p.out; t[30] = (unsigned long long)p.ws; }
    __syncthreads();
    const PTab pt{(const LAS unsigned long long*)(lds + LDS_PTAB)};
    XcdBarrier bar = xcd_barrier_post((unsigned*)(pt.ws() + WS_CTL), st);
#define WS_GET() const int G = lsgpr(G0), c = lsgpr(c0); LAS unsigned char* lds = lds_launder(lds0); const PTab pt{(const LAS unsigned long long*)(lds + LDS_PTAB)}; char* ws = pt.ws(); const char* wl = ws + WS_W + (size_t)l * WL_BYTES; (void)wl
#ifndef PH_REPEAT
#define PH_REPEAT 0
#endif
#define DRYV(rep_) (PH_REPEAT ? lsgpr((rep_) ? 1 : 0) : 0)
#ifndef PH_SKIPEPI
#define PH_SKIPEPI 0
#endif
#ifndef STAGGER_TICKS
#define STAGGER_TICKS 0
#endif
#define STAGGER(c) do { if (STAGGER_TICKS) { const unsigned long long t0_ = __builtin_amdgcn_s_memrealtime(); const unsigned long long d_ = (unsigned long long)(((c) >> 3) & 7) * STAGGER_TICKS; while (__builtin_amdgcn_s_memrealtime() - t0_ < d_) __builtin_amdgcn_s_sleep(8); } } while (0)
#ifndef PH_MASK
#define PH_MASK 0x1fff
#endif
#if MK_PER_PHASE || defined(DBG_STOP)
#define PH_ON(n) (ph_lo <= (n) && (n) < ph_hi)
#define PH_END(n) do { if ((n) + 1 < ph_hi) grid_sync(bar); } while (0)
#else
#define PH_ON(n) true
#ifdef DBL_BAR
#define PH_END(n) do { if ((n) + 1 < N_PHASES) { grid_sync(bar); grid_sync(bar); } } while (0)
#else
#define PH_END(n) do { if ((n) + 1 < N_PHASES) grid_sync(bar); } while (0)
#endif
#endif
#define PHC(k) ((PH_MASK >> (k)) & 1)
    if (PHC(0) && PH_ON(0)) { prologue_phase(pt, lds, G0, c0); __syncthreads(); if (PH_REPEAT & 1) { grid_sync(bar); prologue_phase(pt, lds, lsgpr(G0), lsgpr(c0)); __syncthreads(); } PH_END(0); }
    if (PHC(1) && PH_ON(1)) { norm1_phase(pt, 0, G0, c0); PH_END(1); }
#pragma unroll 1
    for (int l = 0; l < DEPTH; ++l) {
        const int pb = 2 + 10 * l;
        if (PHC(2) && PH_ON(pb + 0)) { { constexpr bool rep_ = false; (void)rep_; WS_GET(); { G1Sched8 S{ws + WS_HA8, wl + WL_WIN8, G, c}; G1EpiB E{ws}; gk::gemm_phase(lds, S, E); } { G1Sched S{ws + WS_H, wl + WL_WIN, G, (c + 96) % G}; G1EpiA E{ws}; gk::gemm_phase(lds, S, E); } }
            if ((PH_REPEAT >> 2) & 1) { grid_sync(bar); { constexpr bool rep_ = true; (void)rep_; WS_GET(); { G1Sched8 S{ws + WS_HA8, wl + WL_WIN8, G, c}; G1EpiB E{ws}; gk::gemm_phase(lds, S, E); } { G1Sched S{ws + WS_H, wl + WL_WIN, G, (c + 96) % G}; G1EpiA E{ws}; gk::gemm_phase(lds, S, E); } } }
            PH_END(pb + 0); }
        if (PHC(3) && PH_ON(pb + 1)) { { constexpr bool rep_ = false; (void)rep_; WS_GET();
            { P2Sched S{ws, wl, l, G, c}; P2Epi E{DftEpi{ws}, QEpi{ws}, KnEpi{ws}, VtEpi{ws}}; gk::gemm_phase(lds, S, E); }
            dft_stage_a(ws, G, c);
            moe::krope_job(ws, G, c);
            __syncthreads();
            gla::g1_phase(pt, l, lds, G, c);
            }
            if ((PH_REPEAT >> 3) & 1) { grid_sync(bar); { constexpr bool rep_ = true; (void)rep_; WS_GET();
            { P2Sched S{ws, wl, l, G, c}; P2Epi E{DftEpi{ws}, QEpi{ws}, KnEpi{ws}, VtEpi{ws}}; gk::gemm_phase(lds, S, E); }
            dft_stage_a(ws, G, c);
            moe::krope_job(ws, G, c);
            __syncthreads();
            gla::g1_phase(pt, l, lds, G, c);
            } }
            PH_END(pb + 1); }
        if (PHC(4) && PH_ON(pb + 2)) { { constexpr bool rep_ = false; (void)rep_; WS_GET();
            if (!rep_) for (int it = c; it < 256; it += G) gla::g2_item(ws, it >> 2, it & 3);
            { DftBSched S{ws, G, c}; DftEpi E{ws}; gk::gemm_phase(lds, S, E); }
            at::attn_phase(ws, lds, l, G, c);
            }
            if ((PH_REPEAT >> 4) & 1) { grid_sync(bar); { constexpr bool rep_ = true; (void)rep_; WS_GET();
            if (!rep_) for (int it = c; it < 256; it += G) gla::g2_item(ws, it >> 2, it & 3);
            { DftBSched S{ws, G, c}; DftEpi E{ws}; gk::gemm_phase(lds, S, E); }
            at::attn_phase(ws, lds, l, G, c);
            } }
            PH_END(pb + 2); }
        if (PHC(5) && PH_ON(pb + 3)) { { constexpr bool rep_ = false; (void)rep_; WS_GET();
            gla::g3_phase(pt, l, lds, G, c);
            }
            if ((PH_REPEAT >> 5) & 1) { grid_sync(bar); { constexpr bool rep_ = true; (void)rep_; WS_GET();
            gla::g3_phase(pt, l, lds, G, c);
            } }
            PH_END(pb + 3); }
        if (PHC(6) && PH_ON(pb + 4)) { { constexpr bool rep_ = false; (void)rep_; WS_GET(); MergeSched S{ws, wl, l, G, c}; MergeEpi E{ws, (PH_REPEAT ? lsgpr((rep_ && PH_SKIPEPI) ? 1 : 0) : 0)}; gk::gemm_phase(lds, S, E); }
            if ((PH_REPEAT >> 6) & 1) { grid_sync(bar); { constexpr bool rep_ = true; (void)rep_; WS_GET(); MergeSched S{ws, wl, l, G, c}; MergeEpi E{ws, (PH_REPEAT ? lsgpr((rep_ && PH_SKIPEPI) ? 1 : 0) : 0)}; gk::gemm_phase(lds, S, E); } }
            PH_END(pb + 4); }
        if (PHC(7) && PH_ON(pb + 5)) { { constexpr bool rep_ = false; (void)rep_; WS_GET(); WoSched S{ws, wl, l, G, c}; WoEpi E{ws, l, DRYV(rep_), pt.x(), pt.ctx()}; gk::gemm_phase(lds, S, E); }
            if ((PH_REPEAT >> 7) & 1) { grid_sync(bar); { constexpr bool rep_ = true; (void)rep_; WS_GET(); WoSched S{ws, wl, l, G, c}; WoEpi E{ws, l, DRYV(rep_), pt.x(), pt.ctx()}; gk::gemm_phase(lds, S, E); } }
            PH_END(pb + 5); }
        if (PHC(8) && PH_ON(pb + 6)) { { constexpr bool rep_ = false; (void)rep_; WS_GET(); moe::route_phase(pt, l, lds, G, c, DRYV(rep_)); }
            if ((PH_REPEAT >> 8) & 1) { grid_sync(bar); { constexpr bool rep_ = true; (void)rep_; WS_GET(); moe::route_phase(pt, l, lds, G, c, DRYV(rep_)); } }
            PH_END(pb + 6); }
        if (PHC(10) && PH_ON(pb + 7)) { { constexpr bool rep_ = false; (void)rep_; WS_GET(); moe::tables(ws, l, lds);
            MoeUpSched S{ws + WS_H8, (const int*)(ws + WS_RT2), wl + WL_WUP, (const LAS int*)(lds + moe::A_TB), (const LAS int*)(lds + moe::A_CN), G, c};
            UpEpi E{ws, pt.b_up() + (size_t)l * NE * 2048}; gk::gemm_phase(lds, S, E); }
            if ((PH_REPEAT >> 10) & 1) { grid_sync(bar); { constexpr bool rep_ = true; (void)rep_; WS_GET(); moe::tables(ws, l, lds);
            MoeUpSched S{ws + WS_H8, (const int*)(ws + WS_RT2), wl + WL_WUP, (const LAS int*)(lds + moe::A_TB), (const LAS int*)(lds + moe::A_CN), G, c};
            UpEpi E{ws, pt.b_up() + (size_t)l * NE * 2048}; gk::gemm_phase(lds, S, E); } }
            PH_END(pb + 7); }
        if (PHC(11) && PH_ON(pb + 8)) { { constexpr bool rep_ = false; (void)rep_; WS_GET(); moe::tables(ws, l, lds);
            MoeSched S{ws + WS_ACT, wl + WL_WDN, (const LAS int*)(lds + moe::A_TB), G, c};
            DownEpi E{ws, pt.b_down() + (size_t)l * NE * 1024}; gk::gemm_phase(lds, S, E); }
            if ((PH_REPEAT >> 11) & 1) { grid_sync(bar); { constexpr bool rep_ = true; (void)rep_; WS_GET(); moe::tables(ws, l, lds);
            MoeSched S{ws + WS_ACT, wl + WL_WDN, (const LAS int*)(lds + moe::A_TB), G, c};
            DownEpi E{ws, pt.b_down() + (size_t)l * NE * 1024}; gk::gemm_phase(lds, S, E); } }
            PH_END(pb + 8); }
        if (PHC(12) && PH_ON(pb + 9)) { { constexpr bool rep_ = false; (void)rep_; WS_GET(); moe::combine_phase(pt, l, lds, G, c, DRYV(rep_)); }
            if ((PH_REPEAT >> 12) & 1) { grid_sync(bar); { constexpr bool rep_ = true; (void)rep_; WS_GET(); moe::combine_phase(pt, l, lds, G, c, DRYV(rep_)); } }
            PH_END(pb + 9); }
    }
#undef PH_ON
#undef PH_END
}

#ifdef DBG_STOP
struct DbgEnt { size_t off; size_t n; int f32; };
__global__ void dbg_dump(const char* ws, float* out, int n) {
    const DbgEnt L[] = { DBG_LIST };
    for (size_t i = (size_t)blockIdx.x * blockDim.x + threadIdx.x; i < (size_t)n; i += (size_t)gridDim.x * blockDim.x) {
        float s = 0.f;
        for (int k = 0; k < (int)(sizeof(L) / sizeof(L[0])); ++k) { const size_t j = i % L[k].n; const float v = L[k].f32 ? ((const float*)(ws + L[k].off))[j] : bf2f(((const bf16_t*)(ws + L[k].off))[j]); s += v; }
        out[i] = s;
    }
}
#endif
extern "C" void kernel_launch(void* const* d_in, const int* in_sizes, int n_in, void* d_out, int out_size, void* d_ws, size_t ws_size, hipStream_t stream) {
    static int grid = 0;
    if (!grid) {
        if (n_in != 29 || ws_size < WS_END) { fprintf(stderr, "kernel_launch: unexpected inputs (%d) or workspace (%zu < %zu)\n", n_in, ws_size, (size_t)WS_END); grid = -1; return; }
        int dev = 0, cus = 0, per_cu = 0;
        hipGetDevice(&dev); hipDeviceGetAttribute(&cus, hipDeviceAttributeMultiprocessorCount, dev);
        if (hipFuncSetAttribute((const void*)mega, hipFuncAttributeMaxDynamicSharedMemorySize, LDS_BYTES) != hipSuccess) { fprintf(stderr, "kernel_launch: hipFuncSetAttribute failed\n"); grid = -1; return; }
        hipOccupancyMaxActiveBlocksPerMultiprocessor(&per_cu, (const void*)mega, 512, LDS_BYTES);
        if (per_cu < 1 || cus < 1) { fprintf(stderr, "kernel_launch: kernel is not resident (occupancy %d, CUs %d)\n", per_cu, cus); grid = -1; return; }
        grid = cus;
    }
    if (grid < 0) return;
    hipMemsetAsync((char*)d_ws + WS_CTL, 0, CTL_BYTES, stream);
    Params p{};
    const float** f = (const float**)&p;
    for (int i = 0; i < 29; ++i) f[i] = (const float*)d_in[i];
    p.out = (float*)d_out; p.ws = (char*)d_ws;
#ifdef DBG_STOP
    for (int ph = 0; ph < DBG_STOP; ++ph) hipLaunchKernelGGL(mega, dim3(grid), dim3(512), LDS_BYTES, stream, p, ph, ph + 1);
    hipLaunchKernelGGL(dbg_dump, dim3(2048), dim3(256), 0, stream, (const char*)d_ws, (float*)d_out, out_size);
#elif MK_PER_PHASE
    for (int ph = 0; ph < N_PHASES; ++ph) hipLaunchKernelGGL(mega, dim3(grid), dim3(512), LDS_BYTES, stream, p, ph, ph + 1);
#else
    hipLaunchKernelGGL(mega, dim3(grid), dim3(512), LDS_BYTES, stream, p, 0, N_PHASES);
#endif
}
```

```cpp
#include <hip/hip_runtime.h>
#include <cstdio>
#include <cstdint>

#define LAS __attribute__((address_space(3)))
typedef unsigned short bf16_t;
typedef short bf16x8 __attribute__((ext_vector_type(8)));
typedef short s16x4 __attribute__((ext_vector_type(4)));
typedef float f32x2 __attribute__((ext_vector_type(2)));
typedef float f32x4 __attribute__((ext_vector_type(4)));
typedef float f32x16 __attribute__((ext_vector_type(16)));
typedef unsigned u32x2 __attribute__((ext_vector_type(2)));
typedef unsigned u32x4 __attribute__((ext_vector_type(4)));

constexpr int D = 1024, NB = 8, SEQ = 4096, CTX = 256, DEPTH = 4;
constexpr int RPB = CTX + SEQ;
constexpr int T = NB * RPB;
constexpr int NMT = T / 256;
constexpr int NE = 32, TOPK = 4;
constexpr int NPAD = 147456;
constexpr int INW = 5568;
constexpr int G1N = 5632;
constexpr float EPS = 1e-6f;
constexpr float QSCALE = 0.10206207261596575f * 1.4426950408889634f;
constexpr int NCHUNK = 68;

constexpr int CO_Q = 0, CO_KV = 256, CO_FN = 416, CO_GQ = 928, CO_GK = 1184, CO_GV = 1440, CO_OG = 1952, CO_GF = 2464, CO_GB = 2480, CO_GATE = 2496;

constexpr size_t al256(size_t x) { return (x + 255) & ~(size_t)255; }
constexpr size_t WS_CTL   = 0;
constexpr size_t CTL_BYTES = 65536;
constexpr size_t CTL_CNT  = 16384;
constexpr size_t WS_X     = WS_CTL + CTL_BYTES;
constexpr size_t WS_H     = WS_X + (size_t)T * D * 4;
constexpr size_t WS_UQ    = WS_H + (size_t)T * D * 2;
constexpr size_t WS_UKV   = WS_UQ + (size_t)T * 256 * 2;
constexpr size_t WS_UFT   = WS_UKV + (size_t)T * 256 * 2;
constexpr size_t WS_GQ    = WS_UFT + (size_t)NB * 512 * RPB * 2;
constexpr size_t WS_GK    = WS_GQ + (size_t)T * 256 * 2;
constexpr size_t WS_GV    = WS_GK + (size_t)T * 256 * 2;
constexpr size_t WS_GOG   = WS_GV + (size_t)T * 512 * 2;
constexpr size_t WS_GATE  = WS_GOG + (size_t)T * 512 * 2;
constexpr size_t WS_SSQ   = WS_GATE + (size_t)T * 3072 * 2;
constexpr size_t WS_Q     = WS_SSQ + (size_t)T * 8 * 4;
constexpr size_t WS_KN    = WS_Q + (size_t)T * 768 * 2;
constexpr size_t WS_KR    = WS_KN + (size_t)T * 512 * 2;
constexpr size_t WS_VT    = WS_KR + (size_t)T * 32 * 2;
constexpr size_t WS_OMLA  = WS_VT + (size_t)NB * 8 * 64 * RPB * 2;
constexpr size_t WS_P     = WS_OMLA + (size_t)T * 512 * 2;
constexpr size_t WS_KVS   = WS_P + (size_t)T * D * 2;
constexpr size_t WS_DEC   = WS_KVS + (size_t)NB * 4 * 2 * NCHUNK * 128 * 64 * 2;
constexpr size_t WS_OGLA  = WS_DEC + (size_t)NB * 4 * 2 * NCHUNK * 64 * 4;
constexpr size_t WS_Y     = WS_OGLA + (size_t)T * 512 * 2;
constexpr size_t WS_TOPI  = WS_Y + (size_t)T * D * 2;
constexpr size_t WS_TOPG  = WS_TOPI + (size_t)T * 16;
constexpr size_t WS_TOPP  = WS_TOPG + (size_t)T * 16;
constexpr size_t WS_HS    = WS_TOPP + (size_t)T * 16;
constexpr size_t WS_ACT   = WS_HS + (size_t)NPAD * D * 2;
constexpr size_t WS_YM    = WS_ACT + (size_t)NPAD * D * 2;
constexpr size_t WS_GG    = WS_YM + (size_t)NPAD * D * 2;
constexpr size_t WS_RT2   = WS_GG + (size_t)T * 512 * 4;
constexpr size_t WS_H8    = WS_RT2 + (size_t)NE * T * 4;
constexpr size_t WS_HA8   = WS_H8 + (size_t)T * D;
constexpr size_t WS_MOD   = WS_HA8 + (size_t)T * D;
constexpr size_t WS_ROPE  = WS_MOD + (size_t)DEPTH * 9 * 6144 * 4;
constexpr size_t WS_DFTL  = al256(WS_ROPE + 4096);
constexpr size_t WS_DFTC  = WS_DFTL + (size_t)8192 * 4096 * 2;
constexpr size_t WS_DB    = WS_DFTC + (size_t)512 * 256 * 2;
constexpr size_t WS_TW    = WS_DB + (size_t)512 * 512 * 2;
constexpr size_t WS_W     = WS_TW + (size_t)16 * 256 * 8;
constexpr size_t WL_WIN = 0;
constexpr size_t WL_WUQ = WL_WIN + (size_t)G1N * 1024 * 2;
constexpr size_t WL_WUKV = WL_WUQ + (size_t)768 * 256 * 2;
constexpr size_t WL_WM = WL_WUKV + (size_t)1024 * 256 * 2;
constexpr size_t WL_WF = WL_WM + (size_t)1024 * 512 * 2;
constexpr size_t WL_WG = WL_WF + (size_t)1024 * 1024 * 2;
constexpr size_t WL_WO = WL_WG + (size_t)1024 * 512 * 2;
constexpr size_t WL_WUP = WL_WO + (size_t)1024 * 1024 * 2;
constexpr size_t WL_WDN = WL_WUP + (size_t)NE * 2048 * 1024;
constexpr size_t WL_WIN8 = WL_WDN + (size_t)NE * 1024 * 1024;
constexpr size_t WL_BYTES = WL_WIN8 + (size_t)G1N * 1024;
constexpr size_t WS_END = WS_W + (size_t)DEPTH * WL_BYTES;
static_assert(WS_END < ((size_t)4 << 30), "workspace map exceeds 4 GiB");
static_assert(WS_W % 256 == 0 && WL_BYTES % 256 == 0, "alignment");

constexpr int LDS_BYTES = 160 * 1024;
constexpr int LDS_AUX = 131072;

struct Params {
    const float *x, *c, *ctx, *c_ctx, *w_mod, *b_mod, *norm1_g, *w_in, *q_norm_g, *w_uq, *kv_norm_g, *w_ukv,
                *w_gf, *b_gf, *w_gb, *b_gb, *gla_norm_g, *w_br_mla, *w_br_fnet, *w_br_gla, *w_o, *norm2_g,
                *router_w, *router_b, *w_up, *b_up, *w_down, *b_down, *final_g;
    float* out; char* ws;
};

struct PTab {
    const LAS unsigned long long* t;
    __device__ __forceinline__ unsigned long long get(int i) const { const unsigned long long v = t[i]; const unsigned lo = __builtin_amdgcn_readfirstlane((unsigned)v), hi = __builtin_amdgcn_readfirstlane((unsigned)(v >> 32)); return ((unsigned long long)hi << 32) | lo; }
    __device__ __forceinline__ const float* x() const { return (const float*)(const __attribute__((address_space(1))) float*)get(0); }
    __device__ __forceinline__ const float* c() const { return (const float*)(const __attribute__((address_space(1))) float*)get(1); }
    __device__ __forceinline__ const float* ctx() const { return (const float*)(const __attribute__((address_space(1))) float*)get(2); }
    __device__ __forceinline__ const float* c_ctx() const { return (const float*)(const __attribute__((address_space(1))) float*)get(3); }
    __device__ __forceinline__ const float* w_mod() const { return (const float*)(const __attribute__((address_space(1))) float*)get(4); }
    __device__ __forceinline__ const float* b_mod() const { return (const float*)(const __attribute__((address_space(1))) float*)get(5); }
    __device__ __forceinline__ const float* norm1_g() const { return (const float*)(const __attribute__((address_space(1))) float*)get(6); }
    __device__ __forceinline__ const float* w_in() const { return (const float*)(const __attribute__((address_space(1))) float*)get(7); }
    __device__ __forceinline__ const float* q_norm_g() const { return (const float*)(const __attribute__((address_space(1))) float*)get(8); }
    __device__ __forceinline__ const float* w_uq() const { return (const float*)(const __attribute__((address_space(1))) float*)get(9); }
    __device__ __forceinline__ const float* kv_norm_g() const { return (const float*)(const __attribute__((address_space(1))) float*)get(10); }
    __device__ __forceinline__ const float* w_ukv() const { return (const float*)(const __attribute__((address_space(1))) float*)get(11); }
    __device__ __forceinline__ const float* w_gf() const { return (const float*)(const __attribute__((address_space(1))) float*)get(12); }
    __device__ __forceinline__ const float* b_gf() const { return (const float*)(const __attribute__((address_space(1))) float*)get(13); }
    __device__ __forceinline__ const float* w_gb() const { return (const float*)(const __attribute__((address_space(1))) float*)get(14); }
    __device__ __forceinline__ const float* b_gb() const { return (const float*)(const __attribute__((address_space(1))) float*)get(15); }
    __device__ __forceinline__ const float* gla_norm_g() const { return (const float*)(const __attribute__((address_space(1))) float*)get(16); }
    __device__ __forceinline__ const float* w_br_mla() const { return (const float*)(const __attribute__((address_space(1))) float*)get(17); }
    __device__ __forceinline__ const float* w_br_fnet() const { return (const float*)(const __attribute__((address_space(1))) float*)get(18); }
    __device__ __forceinline__ const float* w_br_gla() const { return (const float*)(const __attribute__((address_space(1))) float*)get(19); }
    __device__ __forceinline__ const float* w_o() const { return (const float*)(const __attribute__((address_space(1))) float*)get(20); }
    __device__ __forceinline__ const float* norm2_g() const { return (const float*)(const __attribute__((address_space(1))) float*)get(21); }
    __device__ __forceinline__ const float* router_w() const { return (const float*)(const __attribute__((address_space(1))) float*)get(22); }
    __device__ __forceinline__ const float* router_b() const { return (const float*)(const __attribute__((address_space(1))) float*)get(23); }
    __device__ __forceinline__ const float* w_up() const { return (const float*)(const __attribute__((address_space(1))) float*)get(24); }
    __device__ __forceinline__ const float* b_up() const { return (const float*)(const __attribute__((address_space(1))) float*)get(25); }
    __device__ __forceinline__ const float* w_down() const { return (const float*)(const __attribute__((address_space(1))) float*)get(26); }
    __device__ __forceinline__ const float* b_down() const { return (const float*)(const __attribute__((address_space(1))) float*)get(27); }
    __device__ __forceinline__ const float* final_g() const { return (const float*)(const __attribute__((address_space(1))) float*)get(28); }
    __device__ __forceinline__ float* out() const { return (float*)(__attribute__((address_space(1))) float*)get(29); }
    __device__ __forceinline__ char* ws() const { return (char*)(__attribute__((address_space(1))) char*)get(30); }
};
constexpr int LDS_PTAB = LDS_AUX + 24576;

__device__ __forceinline__ int ltid() { int t = (int)threadIdx.x; asm volatile("" : "+v"(t)); return t; }
__device__ __forceinline__ int lsgpr(int v) { asm volatile("" : "+s"(v)); return v; }
__device__ __forceinline__ LAS unsigned char* lds_launder(LAS unsigned char* p) { unsigned a = (unsigned)(unsigned long long)p; asm volatile("" : "+s"(a)); return (LAS unsigned char*)(unsigned long long)a; }

typedef __bf16 bf16x2_t __attribute__((ext_vector_type(2)));
template <int K> __device__ __forceinline__ float lane_xor(float v, int lane) {
    if constexpr (K == 32) { const auto rr = __builtin_amdgcn_permlane32_swap(__float_as_uint(v), __float_as_uint(v), false, false); return __uint_as_float((lane & 32) ? rr[0] : rr[1]); }
    else return __int_as_float(__builtin_amdgcn_ds_swizzle(__float_as_int(v), (K << 10) | 0x1f));
}
__device__ __forceinline__ float half_sum32(float v) { const auto rr = __builtin_amdgcn_permlane32_swap(__float_as_uint(v), __float_as_uint(v), false, false); return __uint_as_float(rr[0]) + __uint_as_float(rr[1]); }
__device__ __forceinline__ float half_max32(float v) { const auto rr = __builtin_amdgcn_permlane32_swap(__float_as_uint(v), __float_as_uint(v), false, false); return fmaxf(__uint_as_float(rr[0]), __uint_as_float(rr[1])); }
__device__ __forceinline__ float wave_sum(float v) { v += lane_xor<1>(v, 0); v += lane_xor<2>(v, 0); v += lane_xor<4>(v, 0); v += lane_xor<8>(v, 0); v += lane_xor<16>(v, 0); return half_sum32(v); }

__device__ __forceinline__ unsigned cvt_pk_bf16(float lo, float hi) { const f32x2 v = {lo, hi}; const bf16x2_t b = __builtin_convertvector(v, bf16x2_t); return __builtin_bit_cast(unsigned, b); }
__device__ __forceinline__ unsigned cvt4_fp8(float a, float b, float c, float d) { int w = 0; w = __builtin_amdgcn_cvt_pk_fp8_f32(a, b, w, false); w = __builtin_amdgcn_cvt_pk_fp8_f32(c, d, w, true); return (unsigned)w; }
__device__ __forceinline__ float sat8(float x) { x = __builtin_fmaxf(x, -448.0f); asm volatile("" : "+v"(x)); return __builtin_fminf(x, 448.0f); }
__device__ __forceinline__ unsigned cvt4_fp8s(float a, float b, float c, float d) { return cvt4_fp8(sat8(a), sat8(b), sat8(c), sat8(d)); }
constexpr float YM_SCALE = 16.0f;
constexpr float W8_SCALE = 128.0f;
constexpr int W8_E8M0 = 0x78787878, ONE_E8M0 = 0x7f7f7f7f;
__device__ __forceinline__ void cvt_fp8x4(unsigned w, float& a, float& b, float& c, float& d) { const f32x2 lo = __builtin_amdgcn_cvt_pk_f32_fp8((int)w, false), hi = __builtin_amdgcn_cvt_pk_f32_fp8((int)w, true); a = lo.x; b = lo.y; c = hi.x; d = hi.y; }
__device__ __forceinline__ bf16_t f2bf(float f) { return (bf16_t)(cvt_pk_bf16(f, 0.f) & 0xffffu); }
__device__ __forceinline__ float bf2f(bf16_t b) { return __uint_as_float(((unsigned)b) << 16); }
typedef _Float16 f16x2_t __attribute__((ext_vector_type(2)));
__device__ __forceinline__ unsigned pk_f16(float a, float b) { const f16x2_t v = {(_Float16)a, (_Float16)b}; return __builtin_bit_cast(unsigned, v); }
__device__ __forceinline__ void un_f16(unsigned w, float& a, float& b) { const f16x2_t v = __builtin_bit_cast(f16x2_t, w); a = (float)v[0]; b = (float)v[1]; }
__device__ __forceinline__ float bflo(unsigned w) { return __uint_as_float(w << 16); }
__device__ __forceinline__ float bfhi(unsigned w) { return __uint_as_float(w & 0xffff0000u); }
__device__ __forceinline__ float sigmoidf_(float x) { return __builtin_amdgcn_rcpf(1.0f + __expf(-x)); }
__device__ __forceinline__ float siluf_(float x) { return x * __builtin_amdgcn_rcpf(1.0f + __expf(-x)); }

#define XB_TMO      128
#define XB_XCNT(j)  (256  + 64 * (j))
#define XB_XSUB(j)  (1280 + 64 * (j))
#define XB_XGEN(j)  (2304 + 64 * (j))
#define XB_TOP      3328
#define XB_TOPGEN   3392
#define XCD_BAR_WORDS 3456
#define XB_SPIN_CAP (1u << 18)
__device__ __forceinline__ unsigned xb_ld(unsigned* p)              { return __hip_atomic_load(p, __ATOMIC_RELAXED, __HIP_MEMORY_SCOPE_AGENT); }
__device__ __forceinline__ unsigned xb_add(unsigned* p, unsigned v) { return __hip_atomic_fetch_add(p, v, __ATOMIC_RELAXED, __HIP_MEMORY_SCOPE_AGENT); }
__device__ __forceinline__ unsigned xb_xcc_id() { return (unsigned)__builtin_amdgcn_s_getreg((3 << 11) | 20) & 0xFu; }
#define XB_SPIN(cond, bar) do { unsigned _sp = 0; while (cond) { __builtin_amdgcn_s_sleep(1); \
    if ((++_sp & 255u) == 0u) { if (xb_ld(&(bar)[XB_TMO])) break; if (_sp > XB_SPIN_CAP) { atomicAdd(&(bar)[XB_TMO], 1u); break; } } } } while (0)
struct XcdBarrier { unsigned* bar; unsigned x; volatile LAS unsigned* st; };
__device__ __forceinline__ XcdBarrier xcd_barrier_post(unsigned* bar, volatile LAS unsigned* st) {
    XcdBarrier b; b.bar = bar; b.x = xb_xcc_id(); b.st = st;
    if (threadIdx.x == 0) (void)xb_add(&bar[XB_XCNT(b.x)], 1u);
    return b;
}
__device__ __forceinline__ void xcd_barrier_complete(unsigned* bar, unsigned x, unsigned& nloc, unsigned& nx) {
    const unsigned G = gridDim.x * gridDim.y * gridDim.z;
    unsigned sum, cnt, mine, sp = 0u;
    for (;;) {
        sum = 0u; cnt = 0u; mine = 0u;
#pragma unroll
        for (unsigned j = 0; j < 16; ++j) { const unsigned c = xb_ld(&bar[XB_XCNT(j)]); sum += c; cnt += (c > 0u) ? 1u : 0u; mine = (j == x) ? c : mine; }
        if (sum == G) break;
        __builtin_amdgcn_s_sleep(1);
        if ((++sp & 255u) == 0u) { if (xb_ld(&bar[XB_TMO])) break; if (sp > XB_SPIN_CAP) { atomicAdd(&bar[XB_TMO], 1u); break; } }
    }
    nloc = mine > 0u ? mine : 1u; nx = cnt > 0u ? cnt : 1u;
}
__device__ __forceinline__ void xcd_barrier(const XcdBarrier& b) {
    asm volatile("s_waitcnt vmcnt(0)" ::: "memory");
    __syncthreads();
    if (threadIdx.x == 0) {
        unsigned* bar = b.bar;
        __builtin_amdgcn_s_waitcnt(0);
        unsigned nloc = b.st[0], nx = b.st[1];
        if (nloc == 0u) { xcd_barrier_complete(bar, b.x, nloc, nx); b.st[0] = nloc; b.st[1] = nx; }
        const unsigned old = xb_add(&bar[XB_XSUB(b.x)], 1u);
        const unsigned gen = old / nloc;
        if (old + 1u == (gen + 1u) * nloc) {
            __builtin_amdgcn_fence(__ATOMIC_RELEASE, "agent");
            asm volatile("s_waitcnt vmcnt(0)" ::: "memory");
            const unsigned og = xb_add(&bar[XB_TOP], 1u);
            const unsigned tg = og / nx;
            if (og + 1u == (tg + 1u) * nx) xb_add(&bar[XB_TOPGEN], 1u);
            else XB_SPIN(xb_ld(&bar[XB_TOPGEN]) == tg, bar);
            __builtin_amdgcn_fence(__ATOMIC_ACQUIRE, "agent");
            xb_add(&bar[XB_XGEN(b.x)], 1u);
            asm volatile("s_waitcnt vmcnt(0)" ::: "memory");
        } else {
            XB_SPIN(xb_ld(&bar[XB_XGEN(b.x)]) == gen, bar);
            __builtin_amdgcn_fence(__ATOMIC_ACQUIRE, "agent");
            asm volatile("s_waitcnt vmcnt(0)" ::: "memory");
        }
    }
    __syncthreads();
}

__device__ __forceinline__ void grid_sync(const XcdBarrier& b) {
    XcdBarrier c = b; unsigned long long p = (unsigned long long)c.bar; unsigned x = c.x, st = (unsigned)(unsigned long long)c.st;
    asm volatile("" : "+s"(p), "+s"(x), "+s"(st));
    c.bar = (unsigned*)(__attribute__((address_space(1))) unsigned*)p; c.x = x; c.st = (volatile LAS unsigned*)(unsigned long long)st;
    xcd_barrier(c);
}
#ifndef GK_ALIGN_EPI
#define GK_ALIGN_EPI 1
#endif
typedef int i32x8 __attribute__((ext_vector_type(8)));
namespace gk {
constexpr int BM = 256, BK = 64, HALF = 128, HTB = HALF * BK * 2, STAGE_BYTES = 8 * HTB;
__device__ __forceinline__ int lds_byte(int r, int c) { const int st = (r >> 4) * 2 + (c >> 5), rr = r & 15, cc = c & 31, ob = rr * 64 + cc * 2; return st * 1024 + (ob ^ (((ob >> 9) & 1) << 5)); }
__device__ __forceinline__ void stage_rc(int b, int& R, int& C) { const int st = b / 1024, sb = b % 1024, swz = sb ^ (((sb >> 9) & 1) << 5); R = (st >> 1) * 16 + swz / 64; C = (st & 1) * 32 + (swz % 64) / 2; }
__device__ __forceinline__ int perm32(int rho) { const int n = rho >> 4, i = rho & 15; return 8 * (i >> 2) + 4 * n + (i & 3); }

struct Unit {
    const char* A; const char* B;
    unsigned lda2, ldb2;
    int nt;
    int pm;
    int info;
    __device__ __forceinline__ int pn() const { return info & 0xff; }
    __device__ __forceinline__ int aux() const { return (info >> 8) & 0xff; }
    __device__ __forceinline__ int kind() const { return (info >> 16) & 0xff; }
    __device__ __forceinline__ int keep() const { return (info >> 24) & 1; }
    __device__ __forceinline__ void set(int pm_, int pn_, int aux_, int kind_, int keep_) { pm = pm_; info = pn_ | (aux_ << 8) | (kind_ << 16) | (keep_ << 24); }
};
typedef f32x4 Acc[2][2][4][2];

template <bool F8> struct FragT { typedef bf16x8 A4[4][2]; typedef bf16x8 B2[2][2]; };
template <> struct FragT<true> { typedef i32x8 A4[4]; typedef i32x8 B2[2]; };
__device__ __forceinline__ void frag_ld(bf16x8 (&d)[2], const LAS unsigned char* p) { d[0] = *(const LAS bf16x8*)p; d[1] = *(const LAS bf16x8*)(p + 1024); }
__device__ __forceinline__ void frag_ld(i32x8& d, const LAS unsigned char* p) { const u32x4 lo = *(const LAS u32x4*)p, hi = *(const LAS u32x4*)(p + 1024);
    d = (i32x8){(int)lo.x, (int)lo.y, (int)lo.z, (int)lo.w, (int)hi.x, (int)hi.y, (int)hi.z, (int)hi.w}; }
__device__ __forceinline__ f32x4 frag_mma(const bf16x8 (&b)[2], const bf16x8 (&a)[2], f32x4 c, int) { c = __builtin_amdgcn_mfma_f32_16x16x32_bf16(b[0], a[0], c, 0, 0, 0); return __builtin_amdgcn_mfma_f32_16x16x32_bf16(b[1], a[1], c, 0, 0, 0); }
__device__ __forceinline__ f32x4 frag_mma(const i32x8& b, const i32x8& a, f32x4 c, int sc) { return __builtin_amdgcn_mfma_scale_f32_16x16x128_f8f6f4(b, a, c, 0, 0, 0, sc, 1, sc); }
template <class Sched> __device__ __forceinline__ const char* a_base(const Sched& S, const Unit& u) { if constexpr (Sched::GATHER) return S.gbase; else return u.A; }
template <class Epi, class Sched>
__device__ __forceinline__ void gemm_phase(LAS unsigned char* lds, const Sched& S, const Epi& E) {
    const int tid = ltid(), wid = __builtin_amdgcn_readfirstlane(tid >> 6), lane = tid & 63, wr = wid >> 2, wc = wid & 3, fr = lane & 15, fq = lane >> 4;
#define GK_OFFS(U, a0, a1, b0, b1) do { int tz_ = ltid(); int R0_, C0_, R1_, C1_; stage_rc(tz_ * 16, R0_, C0_); stage_rc(tz_ * 16 + 8192, R1_, C1_); \
        a0 = (unsigned)R0_ * (U).lda2 + (unsigned)C0_ * 2u; a1 = (unsigned)R1_ * (U).lda2 + (unsigned)C1_ * 2u; \
        b0 = (unsigned)((R0_ & ~31) + perm32(R0_ & 31)) * (U).ldb2 + (unsigned)C0_ * 2u; b1 = (unsigned)((R1_ & ~31) + perm32(R1_ & 31)) * (U).ldb2 + (unsigned)C1_ * 2u; } while (0)
#define GK_GLOAD(U, g0, g1, g2, g3) do { int tz_ = ltid(); int R0_, C0_, R1_, C1_; stage_rc(tz_ * 16, R0_, C0_); stage_rc(tz_ * 16 + 8192, R1_, C1_); const int* lst_ = (const int*)(U).A; const int cnt_ = (int)(U).lda2; \
        g0 = (R0_ < cnt_) ? lst_[R0_] : 0; g1 = (R1_ < cnt_) ? lst_[R1_] : 0; g2 = (R0_ + 128 < cnt_) ? lst_[R0_ + 128] : 0; g3 = (R1_ + 128 < cnt_) ? lst_[R1_ + 128] : 0; } while (0)
#define GK_GOFFS(U, g0, g1, g2, g3, a0, a1, ah0, ah1, b0, b1) do { int tz_ = ltid(); int R0_, C0_, R1_, C1_; stage_rc(tz_ * 16, R0_, C0_); stage_rc(tz_ * 16 + 8192, R1_, C1_); \
        a0 = (unsigned)(g0) * (unsigned)Sched::GPITCH + (unsigned)C0_ * 2u; a1 = (unsigned)(g1) * (unsigned)Sched::GPITCH + (unsigned)C1_ * 2u; ah0 = (unsigned)(g2) * (unsigned)Sched::GPITCH + (unsigned)C0_ * 2u; ah1 = (unsigned)(g3) * (unsigned)Sched::GPITCH + (unsigned)C1_ * 2u; \
        b0 = (unsigned)((R0_ & ~31) + perm32(R0_ & 31)) * (U).ldb2 + (unsigned)C0_ * 2u; b1 = (unsigned)((R1_ & ~31) + perm32(R1_ & 31)) * (U).ldb2 + (unsigned)C1_ * 2u; } while (0)
#define GK_STAGE_AH(bufoff, base, hstep) do { if constexpr (Sched::GATHER) GK_STAGE(bufoff, base, cah0, cah1); else GK_STAGE(bufoff, (base) + (hstep), ca0, ca1); } while (0)
#define GK_AB(U) a_base(S, (U))
    const unsigned ldsw = (unsigned)wid * 1024u;
    const int aoff = lds_byte(wr * 64 + fr, fq * 8), boff = lds_byte(wc * 32 + fr, fq * 8);
#define GK_SA(b, h) (((b) * 2 + (h)) * HTB)
#define GK_SB(b, h) ((4 + (b) * 2 + (h)) * HTB)
#define GK_STAGE(bufoff, gbase, v0, v1) do { \
        __builtin_amdgcn_global_load_lds((const unsigned*)((const char*)(gbase) + (v0)), (LAS unsigned*)(lds + (bufoff) + ldsw), 16, 0, 0); \
        __builtin_amdgcn_global_load_lds((const unsigned*)((const char*)(gbase) + (v1)), (LAS unsigned*)(lds + (bufoff) + ldsw + 8192), 16, 0, 0); } while (0)
#define GK_LDA(dst, b, h) do { _Pragma("unroll") for (int m = 0; m < 4; ++m) frag_ld(dst[m], lds + GK_SA(b, h) + aoff + m * 2048); } while (0)
#define GK_LDB(dst, b, h) do { _Pragma("unroll") for (int n = 0; n < 2; ++n) frag_ld(dst[n], lds + GK_SB(b, h) + boff + n * 2048); } while (0)
#define GK_MMA(ai, bj, At, Bt) do { __builtin_amdgcn_s_setprio(1); _Pragma("unroll") for (int m = 0; m < 4; ++m) _Pragma("unroll") for (int n = 0; n < 2; ++n) \
        acc[ai][bj][m][n] = frag_mma(Bt[n], At[m], acc[ai][bj][m][n], sc_w); __builtin_amdgcn_s_setprio(0); } while (0)
#define GK_WAIT_V(n) asm volatile("s_waitcnt vmcnt(" #n ")" ::: "memory")
#define GK_WAIT_L(n) asm volatile("s_waitcnt lgkmcnt(" #n ")" ::: "memory")
#define GK_BAR __builtin_amdgcn_s_barrier()
#define GK_SCHED __builtin_amdgcn_sched_barrier(0)
    Unit cur, nxt; int ui = 0;
    if (!S.next(0, cur)) return;
    int sc_w = (int)((ONE_E8M0 & 0xffffff00u) | (W8_E8M0 & 0xffu)); asm volatile("" : "+v"(sc_w));
    Acc acc;
#pragma unroll
    for (int a = 0; a < 2; ++a)
#pragma unroll
        for (int b = 0; b < 2; ++b)
#pragma unroll
            for (int m = 0; m < 4; ++m)
#pragma unroll
                for (int n = 0; n < 2; ++n) acc[a][b][m][n] = (f32x4){0.f, 0.f, 0.f, 0.f};
    typedef typename FragT<Sched::FP8>::A4 FragA; typedef typename FragT<Sched::FP8>::B2 FragB;
    FragA At; FragB B0, B1;
    unsigned ca0, ca1, cb0, cb1; [[maybe_unused]] unsigned cah0 = 0, cah1 = 0; [[maybe_unused]] int gi0 = 0, gi1 = 0, gi2 = 0, gi3 = 0;
    if constexpr (Sched::GATHER) { GK_GLOAD(cur, gi0, gi1, gi2, gi3); GK_GOFFS(cur, gi0, gi1, gi2, gi3, ca0, ca1, cah0, cah1, cb0, cb1); } else { GK_OFFS(cur, ca0, ca1, cb0, cb1); }
    {
        const char* cA = GK_AB(cur); const char* cB = cur.B; const size_t hA = (size_t)HALF * cur.lda2, hB = (size_t)HALF * cur.ldb2;
        GK_STAGE(GK_SB(0, 0), cB, cb0, cb1); GK_STAGE(GK_SB(0, 1), cB + hB, cb0, cb1); GK_STAGE(GK_SA(0, 0), cA, ca0, ca1); GK_STAGE_AH(GK_SA(0, 1), cA, hA);
        if (wr == 1) GK_BAR;
        GK_WAIT_V(2); GK_BAR;
        GK_STAGE(GK_SB(1, 0), cB + 128, cb0, cb1); GK_STAGE(GK_SA(1, 0), cA + 128, ca0, ca1); GK_STAGE(GK_SB(1, 1), cB + hB + 128, cb0, cb1);
        GK_WAIT_V(6); GK_BAR;
    }
    for (;;) {
        const bool has_next = S.next(ui + 1, nxt);
        if (!has_next) nxt = cur;
        if constexpr (Sched::GATHER) GK_GLOAD(nxt, gi0, gi1, gi2, gi3);
        const size_t hA = (size_t)HALF * cur.lda2, hB = (size_t)HALF * cur.ldb2, nhA = (size_t)HALF * nxt.lda2, nhB = (size_t)HALF * nxt.ldb2;
        const int nt = cur.nt;
        for (int t = 0; t < nt; t += 2) {
            const bool last = (t == nt - 2);
            const char* a1 = GK_AB(cur) + (size_t)(t + 1) * 128;
            const char* a2 = last ? GK_AB(nxt) : GK_AB(cur) + (size_t)(t + 2) * 128; const char* b2 = last ? nxt.B : cur.B + (size_t)(t + 2) * 128;
            const char* a3 = a2 + 128; const char* b3 = b2 + 128;
            const size_t h2A = last ? nhA : hA, h2B = last ? nhB : hB;
            GK_LDB(B0, 0, 0); GK_LDB(B1, 0, 1); GK_SCHED; GK_LDA(At, 0, 0); GK_STAGE_AH(GK_SA(1, 1), a1, hA);
            if (last) { if constexpr (Sched::GATHER) GK_GOFFS(nxt, gi0, gi1, gi2, gi3, ca0, ca1, cah0, cah1, cb0, cb1); else GK_OFFS(nxt, ca0, ca1, cb0, cb1); }
            GK_WAIT_V(8); GK_WAIT_L(0); GK_BAR; GK_MMA(0, 0, At, B0); GK_MMA(0, 1, At, B1); GK_BAR; GK_SCHED;
            GK_LDA(At, 0, 1); GK_STAGE(GK_SB(0, 0), b2, cb0, cb1); GK_STAGE(GK_SB(0, 1), b2 + h2B, cb0, cb1); GK_STAGE(GK_SA(0, 0), a2, ca0, ca1);
            GK_WAIT_V(8); GK_WAIT_L(0); GK_BAR; GK_MMA(1, 0, At, B0); GK_MMA(1, 1, At, B1); GK_BAR; GK_SCHED;
            GK_LDB(B0, 1, 0); GK_LDB(B1, 1, 1); GK_SCHED; GK_LDA(At, 1, 0); GK_STAGE_AH(GK_SA(0, 1), a2, h2A);
            GK_WAIT_V(8); GK_WAIT_L(0); GK_BAR; GK_MMA(0, 0, At, B0); GK_MMA(0, 1, At, B1); GK_BAR; GK_SCHED;
            GK_LDA(At, 1, 1); GK_STAGE(GK_SB(1, 0), b3, cb0, cb1); GK_STAGE(GK_SB(1, 1), b3 + h2B, cb0, cb1); GK_STAGE(GK_SA(1, 0), a3, ca0, ca1);
            GK_WAIT_V(8); GK_WAIT_L(0); GK_BAR; GK_MMA(1, 0, At, B0); GK_MMA(1, 1, At, B1); GK_BAR; GK_SCHED;
        }
        if (GK_ALIGN_EPI && wr == 0) GK_BAR;
        { const int tz_ = ltid(), wz_ = __builtin_amdgcn_readfirstlane(tz_ >> 6), lz_ = tz_ & 63;
          E(acc, cur, wz_ >> 2, wz_ & 3, lz_ & 15, lz_ >> 4); }
        if (!has_next) break;
        if (!cur.keep()) {
#pragma unroll
            for (int a = 0; a < 2; ++a)
#pragma unroll
                for (int b = 0; b < 2; ++b)
#pragma unroll
                    for (int m = 0; m < 4; ++m)
#pragma unroll
                        for (int n = 0; n < 2; ++n) acc[a][b][m][n] = (f32x4){0.f, 0.f, 0.f, 0.f};
        }
        cur = nxt; ++ui;
        if (GK_ALIGN_EPI && wr == 1) GK_BAR;
    }
    GK_WAIT_V(0);
    if (!GK_ALIGN_EPI && wr == 0) GK_BAR;
    GK_BAR;
#undef GK_OFFS
#undef GK_GLOAD
#undef GK_GOFFS
#undef GK_STAGE_AH
#undef GK_AB
#undef GK_SA
#undef GK_SB
#undef GK_STAGE
#undef GK_LDA
#undef GK_LDB
#undef GK_MMA
#undef GK_WAIT_V
#undef GK_WAIT_L
#undef GK_BAR
#undef GK_SCHED
}

__device__ __forceinline__ void tile_order(int L, int nM, int nN, int& pm, int& pn) {
    const int nwg = nM * nN; int wgid = L;
    { const int q = nwg / 8, r = nwg % 8, xcd = wgid % 8, off = wgid / 8; wgid = (xcd < r ? xcd * (q + 1) : r * (q + 1) + (xcd - r) * q) + off; }
    const int nig = 8 * nN, gid = wgid / nig, fm = gid * 8, gsz = (nM - fm) < 8 ? (nM - fm) : 8;
    pm = fm + ((wgid % nig) % gsz); pn = (wgid % nig) / gsz;
}
}
template <class ColF>
__device__ __forceinline__ void cvt_tr(const float* __restrict__ src, int ld_src, int Ksrc, bf16_t* __restrict__ dst, int Kdst, int N, const ColF& colf, const float* __restrict__ kscale,
                                       unsigned& ctr, int G, int c) {
    const int tid = ltid(), lane = tid & 63, wid = __builtin_amdgcn_readfirstlane(tid >> 6);
    const int nkt = Kdst / 256, nnt = N / 64, ntile = nkt * nnt;
    const int t0 = (int)(((unsigned)c + (unsigned)G - (ctr % (unsigned)G)) % (unsigned)G);
    for (int tt = t0; tt < ntile; tt += G) {
        const int kt = tt / nnt, nt_ = tt % nnt, n = nt_ * 64 + lane, kb = kt * 256 + wid * 32;
        float mul; const int sc = colf(n, mul);
        const float* sp = src + (size_t)kb * ld_src + (sc >= 0 ? sc : 0);
        float v[32];
#pragma unroll
        for (int j = 0; j < 32; ++j) v[j] = (kb + j < Ksrc) ? sp[(size_t)j * ld_src] : 0.f;
        if (sc < 0) mul = 0.f;
#pragma unroll
        for (int j = 0; j < 32; ++j) { float m2 = mul; if (kscale) m2 *= (kb + j < Ksrc) ? kscale[kb + j] : 0.f; v[j] *= m2; }
        bf16_t* dp = dst + (size_t)n * Kdst + kb;
#pragma unroll
        for (int q = 0; q < 4; ++q) { u32x4 w; w.x = cvt_pk_bf16(v[8 * q], v[8 * q + 1]); w.y = cvt_pk_bf16(v[8 * q + 2], v[8 * q + 3]); w.z = cvt_pk_bf16(v[8 * q + 4], v[8 * q + 5]); w.w = cvt_pk_bf16(v[8 * q + 6], v[8 * q + 7]);
            *(u32x4*)(dp + 8 * q) = w; }
    }
    ctr += (unsigned)ntile;
}

template <class ColF>
__device__ __forceinline__ void cvt_tr8(const float* __restrict__ src, int ld_src, unsigned char* __restrict__ dst, int Kdst, int N, const ColF& colf, float mul0, unsigned& ctr, int G, int c) {
    const int tid = ltid(), lane = tid & 63, wid = __builtin_amdgcn_readfirstlane(tid >> 6);
    const int nkt = Kdst / 256, nnt = N / 64, ntile = nkt * nnt;
    const int t0 = (int)(((unsigned)c + (unsigned)G - (ctr % (unsigned)G)) % (unsigned)G);
    for (int tt = t0; tt < ntile; tt += G) {
        const int kt = tt / nnt, nt_ = tt % nnt, n = nt_ * 64 + lane, kb = kt * 256 + wid * 32;
        float mul; const int sc = colf(n, mul); mul *= mul0; if (sc < 0) mul = 0.f;
        const float* sp = src + (size_t)kb * ld_src + (sc >= 0 ? sc : 0);
        float v[32];
#pragma unroll
        for (int j = 0; j < 32; ++j) v[j] = sp[(size_t)j * ld_src] * mul;
        unsigned char* dp = dst + (size_t)n * Kdst + kb;
#pragma unroll
        for (int q = 0; q < 2; ++q) { u32x4 w; w.x = cvt4_fp8s(v[16 * q], v[16 * q + 1], v[16 * q + 2], v[16 * q + 3]); w.y = cvt4_fp8s(v[16 * q + 4], v[16 * q + 5], v[16 * q + 6], v[16 * q + 7]);
            w.z = cvt4_fp8s(v[16 * q + 8], v[16 * q + 9], v[16 * q + 10], v[16 * q + 11]); w.w = cvt4_fp8s(v[16 * q + 12], v[16 * q + 13], v[16 * q + 14], v[16 * q + 15]);
            *(u32x4*)(dp + 16 * q) = w; }
    }
    ctr += (unsigned)ntile;
}

__device__ __forceinline__ int g1_col(int n, float& mul) {
    mul = 1.0f;
    if (n < 256) return CO_Q + n;
    if (n < 512) { const int r = n - 256; if (r < 160) return CO_KV + r; if (r < 176) return CO_GF + (r - 160); if (r < 192) return CO_GB + (r - 176); return -1; }
    if (n < 1024) return CO_FN + (n - 512);
    if (n < 1280) { mul = 0.125f; return CO_GQ + (n - 1024); }
    if (n < 1536) return CO_GK + (n - 1280);
    if (n < 2048) return CO_GV + (n - 1536);
    if (n < 2560) return CO_OG + (n - 2048);
    return CO_GATE + (n - 2560);
}
__device__ __forceinline__ int uq_col(int n, float& mul) {
    mul = 1.0f;
    if (n < 512) return (n >> 6) * 96 + (n & 63);
    const int r = n - 512, h = r >> 5, j = r & 31, axis = j >> 4, i = (j & 15) >> 1;
    return h * 96 + 64 + axis * 16 + i + 8 * (j & 1);
}
__device__ __forceinline__ int ukv_col(int n, float& mul) { mul = 1.0f; if (n < 512) return (n >> 6) * 128 + (n & 63); const int r = n - 512; return (r >> 6) * 128 + 64 + (r & 63); }
__device__ __forceinline__ int ident_col(int n, float& mul) { mul = 1.0f; return n; }
__device__ __forceinline__ int up_col(int n, float& mul) { mul = 1.0f; const int pn = n >> 8, r = n & 255; return r < 128 ? pn * 128 + r : 1024 + pn * 128 + (r - 128); }

struct G1ColF { __device__ int operator()(int n, float& m) const { return g1_col(n, m); } };
struct UqColF { __device__ int operator()(int n, float& m) const { return uq_col(n, m); } };
struct UkvColF { __device__ int operator()(int n, float& m) const { return ukv_col(n, m); } };
struct IdColF { __device__ int operator()(int n, float& m) const { return ident_col(n, m); } };
struct G1ColF8 { __device__ int operator()(int n, float& m) const { return g1_col(n + 1536, m); } };
struct UpColF { __device__ int operator()(int n, float& m) const { return up_col(n, m); } };

__device__ __forceinline__ void cvt_experts(const PTab& p, char* ws, int G, int c) {
    const int tid = ltid(), lane = tid & 63, wid = __builtin_amdgcn_readfirstlane(tid >> 6);
    constexpr int NUP = 128 * 32, NIT = NUP + 128 * 16;
    for (int it = c; it < NIT; it += G) {
        const float* sp; unsigned char* dp; int ld;
        if (it < NUP) { const int mat = it >> 5, n = (it & 31) * 64 + lane; float mul; const int sc = up_col(n, mul);
            sp = p.w_up() + ((size_t)mat * 1024 + wid * 128) * 2048 + sc; ld = 2048;
            dp = (unsigned char*)(ws + WS_W + (size_t)(mat >> 5) * WL_BYTES + WL_WUP) + (size_t)(mat & 31) * 2048 * 1024 + (size_t)n * 1024 + wid * 128; }
        else { const int i2 = it - NUP, mat = i2 >> 4, n = (i2 & 15) * 64 + lane;
            sp = p.w_down() + ((size_t)mat * 1024 + wid * 128) * 1024 + n; ld = 1024;
            dp = (unsigned char*)(ws + WS_W + (size_t)(mat >> 5) * WL_BYTES + WL_WDN) + (size_t)(mat & 31) * 1024 * 1024 + (size_t)n * 1024 + wid * 128; }
        float v[128];
#pragma unroll
        for (int j = 0; j < 128; ++j) v[j] = __builtin_nontemporal_load(sp + (size_t)j * ld);
#pragma unroll
        for (int q = 0; q < 8; ++q) { u32x4 w;
            w.x = cvt4_fp8s(v[16 * q] * W8_SCALE, v[16 * q + 1] * W8_SCALE, v[16 * q + 2] * W8_SCALE, v[16 * q + 3] * W8_SCALE);
            w.y = cvt4_fp8s(v[16 * q + 4] * W8_SCALE, v[16 * q + 5] * W8_SCALE, v[16 * q + 6] * W8_SCALE, v[16 * q + 7] * W8_SCALE);
            w.z = cvt4_fp8s(v[16 * q + 8] * W8_SCALE, v[16 * q + 9] * W8_SCALE, v[16 * q + 10] * W8_SCALE, v[16 * q + 11] * W8_SCALE);
            w.w = cvt4_fp8s(v[16 * q + 12] * W8_SCALE, v[16 * q + 13] * W8_SCALE, v[16 * q + 14] * W8_SCALE, v[16 * q + 15] * W8_SCALE);
            *(u32x4*)(dp + 16 * q) = w; }
    }
}

__device__ __forceinline__ void prologue_phase(const PTab& p, LAS unsigned char* lds, int G, int c) {
    const int tid = ltid();
    char* ws = p.ws();
    if (c == 0) {
        float* R = (float*)(ws + WS_ROPE);
        const int pos = tid >> 3, i = tid & 7;
        const float inv = powf(10000.0f, -(float)(2 * i) / 16.0f), ang = (float)pos * inv;
        R[tid * 2] = cosf(ang); R[tid * 2 + 1] = sinf(ang);
    }
    {
        bf16_t* DB = (bf16_t*)(ws + WS_DB);
        for (int i = c * 512 + tid; i < 512 * 512 / 8; i += G * 512) {
            const int r = i >> 6, q0 = (i & 63) * 8, k1 = r & 255; float v[8];
#pragma unroll
            for (int j = 0; j < 8; ++j) { const int q = q0 + j, t1 = q & 255; const int m = (k1 * t1) & 255; float s, co; sincospif((float)m * (1.0f / 128.0f), &s, &co);
                const float val = (r < 256) ? ((q < 256) ? co : s) : ((q < 256) ? s : -co); v[j] = val * (1.0f / 64.0f); }
            u32x4 w; w.x = cvt_pk_bf16(v[0], v[1]); w.y = cvt_pk_bf16(v[2], v[3]); w.z = cvt_pk_bf16(v[4], v[5]); w.w = cvt_pk_bf16(v[6], v[7]);
            *(u32x4*)(DB + (size_t)i * 8) = w;
        }
        float* TW = (float*)(ws + WS_TW);
        for (int i = c * 512 + tid; i < 16 * 256; i += G * 512) { const int k2 = i >> 8, t1 = i & 255; float s, co; sincospif((float)(k2 * t1) * (1.0f / 2048.0f), &s, &co); TW[2 * i] = co; TW[2 * i + 1] = s; }
        bf16_t* DC = (bf16_t*)(ws + WS_DFTC);
        for (int i = c * 512 + tid; i < 512 * 256 / 8; i += G * 512) {
            const int r = i >> 5, t0 = (i & 31) * 8, k = r & 255; float v[8];
#pragma unroll
            for (int j = 0; j < 8; ++j) { const int m = (k * (t0 + j)) & 255; float s, co; sincospif((float)m * (1.0f / 128.0f), &s, &co); v[j] = (r < 256 ? co : s) * (1.0f / 16.0f); }
            u32x4 w; w.x = cvt_pk_bf16(v[0], v[1]); w.y = cvt_pk_bf16(v[2], v[3]); w.z = cvt_pk_bf16(v[4], v[5]); w.w = cvt_pk_bf16(v[6], v[7]);
            *(u32x4*)(DC + (size_t)i * 8) = w;
        }
    }
#ifndef PRO_REP_D
#define PRO_REP_D 1
#endif
#ifndef PRO_REP_E
#define PRO_REP_E 1
#endif
    {
        for (int rep_ = 0; rep_ < PRO_REP_D; ++rep_) {
        LAS float* sl = (LAS float*)lds;
        LAS float* red = (LAS float*)(lds + 40960);
        { const float* cc = p.c(); const float* ccx = p.c_ctx();
          float cv_[18];
#pragma unroll
          for (int j = 0; j < 18; ++j) { const int i = tid + j * 512, s = i >> 10, k = i & 1023; cv_[j] = (s < 8) ? cc[s * 1024 + k] : ccx[k]; }
#pragma unroll
          for (int j = 0; j < 18; ++j) sl[tid + j * 512] = siluf_(cv_[j]); }
        __syncthreads();
        const float* wm = p.w_mod(); const float* bmod = p.b_mod();
        for (int job = c; job < DEPTH * 48; job += G) {
            const int l = job / 48, jl = tid & 127, kq = tid >> 7, j = (job % 48) * 128 + jl;
            const float* W = wm + (size_t)l * 1024 * 6144 + (size_t)(kq * 256) * 6144 + j;
            float a[9];
#pragma unroll
            for (int s = 0; s < 9; ++s) a[s] = 0.f;
            for (int k0 = 0; k0 < 256; k0 += 32) { float w[32];
#pragma unroll
                for (int q = 0; q < 32; ++q) w[q] = W[(size_t)(k0 + q) * 6144];
#pragma unroll
                for (int q4 = 0; q4 < 8; ++q4)
#pragma unroll
                    for (int s = 0; s < 9; ++s) { const f32x4 t = *(const LAS f32x4*)(sl + s * 1024 + kq * 256 + k0 + 4 * q4);
                        a[s] += t[0] * w[4 * q4] + t[1] * w[4 * q4 + 1] + t[2] * w[4 * q4 + 2] + t[3] * w[4 * q4 + 3]; } }
#pragma unroll
            for (int s = 0; s < 9; ++s) red[(kq * 9 + s) * 128 + jl] = a[s];
            __syncthreads();
            for (int i = tid; i < 9 * 128; i += 512) { const int s = i >> 7, jj = i & 127, col = (job % 48) * 128 + jj;
                ((float*)(ws + WS_MOD))[((size_t)l * 9 + s) * 6144 + col] = red[(0 * 9 + s) * 128 + jj] + red[(1 * 9 + s) * 128 + jj] + red[(2 * 9 + s) * 128 + jj] + red[(3 * 9 + s) * 128 + jj] + bmod[l * 6144 + col]; }
            __syncthreads();
        }
        }
    }
    {
        for (int rep_ = 0; rep_ < PRO_REP_E; ++rep_) {
        LAS float* TT = (LAS float*)lds;
        LAS float* tile = (LAS float*)(lds + 65536);
        const int kt = (c >> 4) & 15, jt = c & 15, part = kt >> 3;
        if (G % 256 == 0) {
            for (int i = tid; i < 128 * 128; i += 512) { const int m = i >> 7, cc = i & 127; float sn, co; sincospif((float)((m * cc) & 127) * (1.0f / 64.0f), &sn, &co); TT[i] = part ? sn : co; }
        }
        __syncthreads();
        for (int job = c; job < DEPTH * 256; job += G) {
            const int l = job >> 8;
            int kt_ = kt, jt_ = jt;
            if (G % 256 != 0) {
                kt_ = (job >> 4) & 15; jt_ = job & 15; const int pj = kt_ >> 3;
                __syncthreads();
                for (int i = tid; i < 128 * 128; i += 512) { const int m = i >> 7, cc = i & 127; float sn, co; sincospif((float)((m * cc) & 127) * (1.0f / 64.0f), &sn, &co); TT[i] = pj ? sn : co; }
                __syncthreads();
            }
            const int jl = tid & 63, kg = __builtin_amdgcn_readfirstlane(tid >> 6);
            const int kidx0 = kt_ * 64 + kg * 8, pj = kidx0 >> 9, g = (kidx0 >> 7) & 3, cc0 = kidx0 & 127;
            const float* W = p.w_br_fnet() + (size_t)l * 512 * 1024 + (size_t)(g * 128) * 1024 + jt_ * 64 + jl;
            float a[8];
#pragma unroll
            for (int q = 0; q < 8; ++q) a[q] = 0.f;
#pragma unroll
            for (int mh = 0; mh < 2; ++mh) {
                float w[64];
#pragma unroll
                for (int m = 0; m < 64; ++m) w[m] = W[(size_t)(mh * 64 + m) * 1024];
#pragma unroll
                for (int m = 0; m < 64; ++m) { const f32x4 t0 = *(const LAS f32x4*)(TT + (mh * 64 + m) * 128 + cc0), t1 = *(const LAS f32x4*)(TT + (mh * 64 + m) * 128 + cc0 + 4);
                    a[0] += w[m] * t0[0]; a[1] += w[m] * t0[1]; a[2] += w[m] * t0[2]; a[3] += w[m] * t0[3]; a[4] += w[m] * t1[0]; a[5] += w[m] * t1[1]; a[6] += w[m] * t1[2]; a[7] += w[m] * t1[3]; }
            }
            const float sc = (pj ? -1.0f : 1.0f) * 0.08838834764831845f;
#pragma unroll
            for (int q = 0; q < 8; ++q) tile[(kg * 8 + q) * 65 + jl] = a[q] * sc;
            __syncthreads();
            { unsigned char* dst = (unsigned char*)(ws + WS_W + (size_t)l * WL_BYTES + WL_WF);
              const int kp = tid & 15, nl0 = tid >> 4;
#pragma unroll
              for (int i = 0; i < 2; ++i) { const int nl = nl0 + 32 * i;
                  *(unsigned*)(dst + (size_t)(jt_ * 64 + nl) * 1024 + kt_ * 64 + 4 * kp) = cvt4_fp8s(tile[(4 * kp) * 65 + nl] * W8_SCALE, tile[(4 * kp + 1) * 65 + nl] * W8_SCALE, tile[(4 * kp + 2) * 65 + nl] * W8_SCALE, tile[(4 * kp + 3) * 65 + nl] * W8_SCALE); } }
            __syncthreads();
        }
        __syncthreads(); }
    }
    {
        unsigned ctr = 0;
        for (int l = 0; l < DEPTH; ++l) {
            char* wl = ws + WS_W + (size_t)l * WL_BYTES;
            cvt_tr(p.w_in() + (size_t)l * 1024 * INW, INW, 1024, (bf16_t*)(wl + WL_WIN), 1024, 1536, G1ColF(), nullptr, ctr, G, c);
            cvt_tr8(p.w_in() + (size_t)l * 1024 * INW, INW, (unsigned char*)(wl + WL_WIN8) + (size_t)1536 * 1024, 1024, G1N - 1536, G1ColF8(), W8_SCALE, ctr, G, c);
            cvt_tr(p.w_uq() + (size_t)l * 256 * 768, 768, 256, (bf16_t*)(wl + WL_WUQ), 256, 768, UqColF(), p.q_norm_g() + l * 256, ctr, G, c);
            cvt_tr(p.w_ukv() + (size_t)l * 128 * 1024, 1024, 128, (bf16_t*)(wl + WL_WUKV), 256, 1024, UkvColF(), p.kv_norm_g() + l * 128, ctr, G, c);
            cvt_tr8(p.w_br_mla() + (size_t)l * 512 * 1024, 1024, (unsigned char*)(wl + WL_WM), 512, 1024, IdColF(), W8_SCALE, ctr, G, c);
            cvt_tr8(p.w_br_gla() + (size_t)l * 512 * 1024, 1024, (unsigned char*)(wl + WL_WG), 512, 1024, IdColF(), W8_SCALE, ctr, G, c);
            cvt_tr8(p.w_o() + (size_t)l * 1024 * 1024, 1024, (unsigned char*)(wl + WL_WO), 1024, 1024, IdColF(), W8_SCALE, ctr, G, c);
        }
#ifndef PRO_REP_F
#define PRO_REP_F 1
#endif
        for (int rf_ = 0; rf_ < PRO_REP_F; ++rf_) cvt_experts(p, ws, G, c);
    }
}

__device__ __forceinline__ void norm_mod_row(const float* __restrict__ xrow, const float* __restrict__ g, const float* __restrict__ shift, const float* __restrict__ scale, bf16_t* __restrict__ hrow, unsigned char* __restrict__ h8row, int lane) {
    f32x4 v[4]; float ss = 0.f;
#pragma unroll
    for (int i = 0; i < 4; ++i) { v[i] = *(const f32x4*)(xrow + i * 256 + lane * 4); ss += v[i][0] * v[i][0] + v[i][1] * v[i][1] + v[i][2] * v[i][2] + v[i][3] * v[i][3]; }
    ss = wave_sum(ss);
    const float rs = rsqrtf(ss * (1.0f / 1024.0f) + EPS);
#pragma unroll
    for (int i = 0; i < 4; ++i) { const int col = i * 256 + lane * 4; const f32x4 gg = *(const f32x4*)(g + col), sh = *(const f32x4*)(shift + col), sc = *(const f32x4*)(scale + col);
        float o[4];
#pragma unroll
        for (int j = 0; j < 4; ++j) o[j] = v[i][j] * rs * gg[j] * (1.0f + sc[j]) + sh[j];
        u32x2 w; w.x = cvt_pk_bf16(o[0], o[1]); w.y = cvt_pk_bf16(o[2], o[3]); *(u32x2*)(hrow + col) = w; *(unsigned*)(h8row + col) = cvt4_fp8s(o[0], o[1], o[2], o[3]); }
}
__device__ __forceinline__ void norm1_phase(const PTab& p, int l, int G, int c) {
    const int tid_ = ltid(), wid = tid_ >> 6, lane = tid_ & 63; char* ws = p.ws();
    const float* px = p.x(); const float* pctx = p.ctx(); bf16_t* H = (bf16_t*)(ws + WS_H);
    const float* M = (const float*)(ws + WS_MOD) + (size_t)l * 9 * 6144; const float* n1g = p.norm1_g() + l * D;
    int row = c * 8 + wid; f32x4 v[4];
#define N1_XROW(rw_) (((rw_) % RPB) < CTX ? pctx + (size_t)(((rw_) / RPB) * CTX + ((rw_) % RPB)) * D : px + (size_t)(((rw_) / RPB) * SEQ + (((rw_) % RPB) - CTX)) * D)
    if (row < T) { const float* xr = N1_XROW(row);
#pragma unroll
        for (int i = 0; i < 4; ++i) v[i] = *(const f32x4*)(xr + i * 256 + lane * 4); }
    for (; row < T; row += G * 8) {
        const int b = row / RPB, r = row % RPB, s = r < CTX ? 8 : b; const float* shift = M + s * 6144; const float* scale = shift + 1024;
        f32x4 gg[4], sh[4], sc[4], vn[4];
#pragma unroll
        for (int i = 0; i < 4; ++i) { const int col = i * 256 + lane * 4; gg[i] = *(const f32x4*)(n1g + col); sh[i] = *(const f32x4*)(shift + col); sc[i] = *(const f32x4*)(scale + col); }
        { const int rn = row + G * 8; if (rn < T) { const float* xr = N1_XROW(rn);
#pragma unroll
            for (int i = 0; i < 4; ++i) vn[i] = *(const f32x4*)(xr + i * 256 + lane * 4); } }
        float ss = 0.f;
#pragma unroll
        for (int i = 0; i < 4; ++i) ss += v[i][0] * v[i][0] + v[i][1] * v[i][1] + v[i][2] * v[i][2] + v[i][3] * v[i][3];
        ss = wave_sum(ss);
        const float rs = rsqrtf(ss * (1.0f / 1024.0f) + EPS);
        bf16_t* hrow = H + (size_t)row * D; unsigned char* h8row = (unsigned char*)(ws + WS_HA8) + (size_t)row * D;
#pragma unroll
        for (int i = 0; i < 4; ++i) { const int col = i * 256 + lane * 4; float o[4];
#pragma unroll
            for (int j = 0; j < 4; ++j) o[j] = v[i][j] * rs * gg[i][j] * (1.0f + sc[i][j]) + sh[i][j];
            u32x2 w; w.x = cvt_pk_bf16(o[0], o[1]); w.y = cvt_pk_bf16(o[2], o[3]); *(u32x2*)(hrow + col) = w; *(unsigned*)(h8row + col) = cvt4_fp8s(o[0], o[1], o[2], o[3]); }
#pragma unroll
        for (int i = 0; i < 4; ++i) v[i] = vn[i];
    }
#undef N1_XROW
}

__device__ __forceinline__ void dft_stage_a(char* ws, int G, int c) {
    const int tid = ltid(), t1 = tid & 255, cc = tid >> 8;
    const bf16_t* UFT = (const bf16_t*)(ws + WS_UFT); bf16_t* HB = (bf16_t*)(ws + WS_DFTL); const f32x2* TW = (const f32x2*)(ws + WS_TW);
    constexpr float C16[9] = {1.0f, 0.9238795325f, 0.7071067812f, 0.3826834324f, 0.0f, -0.3826834324f, -0.7071067812f, -0.9238795325f, -1.0f};
    constexpr float S16[9] = {0.0f, 0.3826834324f, 0.7071067812f, 0.9238795325f, 1.0f, 0.9238795325f, 0.7071067812f, 0.3826834324f, 0.0f};
    f32x2 tw[16];
#pragma unroll
    for (int k2 = 0; k2 < 16; ++k2) tw[k2] = TW[k2 * 256 + t1];
    int it = c; if (it >= NB * 256) return;
    unsigned short ur[16];
    { const bf16_t* up = UFT + ((size_t)((it >> 8) * 512 + (it & 255) * 2 + cc)) * RPB + CTX + t1;
#pragma unroll
      for (int j = 0; j < 16; ++j) ur[j] = up[j * 256]; }
    for (;;) {
        const int nx = it + G; unsigned short un[16];
#pragma unroll
        for (int j = 0; j < 16; ++j) un[j] = ur[j];
        if (nx < NB * 256) { const bf16_t* up = UFT + ((size_t)((nx >> 8) * 512 + (nx & 255) * 2 + cc)) * RPB + CTX + t1;
#pragma unroll
            for (int j = 0; j < 16; ++j) un[j] = up[j * 256]; }
        const int b = it >> 8, ch = (it & 255) * 2 + cc;
        float u[16];
#pragma unroll
        for (int j = 0; j < 16; ++j) u[j] = bf2f(ur[j]);
        float sa[8], sb[8];
#pragma unroll
        for (int j = 1; j < 8; ++j) { sa[j] = u[j] + u[16 - j]; sb[j] = u[j] - u[16 - j]; }
        float re[9], im[9];
#pragma unroll
        for (int k2 = 0; k2 <= 8; ++k2) { float r = u[0] + ((k2 & 1) ? -u[8] : u[8]), m = 0.f;
#pragma unroll
            for (int j = 1; j < 8; ++j) { const int q = (k2 * j) & 15;
                const float cq = (q <= 8) ? C16[q] : C16[16 - q], sq = (q <= 8) ? S16[q] : -S16[16 - q];
                r += sa[j] * cq; m -= sb[j] * sq; }
            re[k2] = r; im[k2] = m; }
        bf16_t* hp = HB + ((size_t)b * 8192 + ch) * 512 + t1;
#pragma unroll
        for (int k2 = 0; k2 < 16; ++k2) { const float r = (k2 <= 8) ? re[k2] : re[16 - k2], m = (k2 <= 8) ? im[k2] : -im[16 - k2];
            const float r2 = r * tw[k2].x + m * tw[k2].y, i2 = m * tw[k2].x - r * tw[k2].y;
            hp[(size_t)k2 * 512 * 512] = f2bf(r2); hp[(size_t)k2 * 512 * 512 + 256] = f2bf(i2); }
        if (nx >= NB * 256) break;
#pragma unroll
        for (int j = 0; j < 16; ++j) ur[j] = un[j];
        it = nx;
    }
}
using gk::Unit; using gk::Acc;
__device__ __forceinline__ u32x4 pack8(const f32x4& a, const f32x4& b) { u32x4 w; w.x = cvt_pk_bf16(a[0], a[1]); w.y = cvt_pk_bf16(a[2], a[3]); w.z = cvt_pk_bf16(b[0], b[1]); w.w = cvt_pk_bf16(b[2], b[3]); return w; }
__device__ __forceinline__ u32x2 pack8f(const f32x4& a, const f32x4& b) { u32x2 w; w.x = cvt4_fp8(a[0], a[1], a[2], a[3]); w.y = cvt4_fp8(b[0], b[1], b[2], b[3]); return w; }
__device__ __forceinline__ u32x2 pack8fs(const f32x4& a, const f32x4& b) { u32x2 w; w.x = cvt4_fp8s(a[0], a[1], a[2], a[3]); w.y = cvt4_fp8s(b[0], b[1], b[2], b[3]); return w; }
__device__ __forceinline__ void unpack8(const u32x4& w, float (&f)[8]) { f[0] = bflo(w.x); f[1] = bfhi(w.x); f[2] = bflo(w.y); f[3] = bfhi(w.y); f[4] = bflo(w.z); f[5] = bfhi(w.z); f[6] = bflo(w.w); f[7] = bfhi(w.w); }
#define EROW(ai, m) (128 * (ai) + 64 * wr + 16 * (m) + fr)
#define ECOL(bj) (128 * (bj) + 32 * wc + 8 * fq)
#define EFENCE() asm volatile("" ::: "memory")
#ifndef EPI_GAP_N
#define EPI_GAP_N 0
#endif
#define EPI_GAP(ai, m) do { if ((ai) == 1 && (m) == 0 && EPI_GAP_N) { asm volatile("" ::: "memory"); __builtin_amdgcn_s_sleep(EPI_GAP_N); asm volatile("" ::: "memory"); } } while (0)
#ifndef EPI_NT
#define EPI_NT 0
#endif
#if EPI_NT
#define ST16(p, v) __builtin_nontemporal_store((v), (u32x4*)(p))
#else
#define ST16(p, v) (*(u32x4*)(p) = (v))
#endif

struct G1Sched {
    static constexpr bool GATHER = false, FP8 = false, COUNTED = false;
    const char* H; const char* W; int G, c;
    __device__ __forceinline__ bool next(int i, Unit& u) const {
        const int L = i * G + c; if (L >= NMT * 6) return false;
        int pm, pn; gk::tile_order(L, NMT, 6, pm, pn);
        u.nt = 16; u.lda2 = 2048u; u.ldb2 = 2048u;
        const char* a = H + (size_t)pm * 256 * 2048; const char* b = W + (size_t)pn * 256 * 2048;
        if (pn == 2 || pn == 3) { u.set(pm, pn, 0, 1, 0); u.A = b; u.B = a; } else { u.set(pm, pn, 0, 0, 0); u.A = a; u.B = b; }
        return true;
    }
};
struct G1Sched8 {
    static constexpr bool GATHER = false, FP8 = true, COUNTED = false;
    const char* H; const char* W; int G, c;
    __device__ __forceinline__ bool next(int i, Unit& u) const {
        const int L = i * G + c; if (L >= NMT * 16) return false;
        int pm, pn; gk::tile_order(L, NMT, 16, pm, pn); pn += 6;
        u.nt = 8; u.lda2 = 1024u; u.ldb2 = 1024u; u.set(pm, pn, 0, 0, 0);
        u.A = H + (size_t)pm * 256 * 1024; u.B = W + (size_t)pn * 256 * 1024; return true;
    }
};
struct G1EpiA {
    char* ws;
    __device__ __forceinline__ void operator()(Acc& acc, const Unit& u, int wr, int wc, int fr, int fq) const {
        const int pn = u.pn(), pm = u.pm;
        if (pn <= 1) {
            bf16_t* dst = (bf16_t*)(ws + (pn == 0 ? WS_UQ : WS_UKV)); float* ssq = (float*)(ws + WS_SSQ);
#pragma unroll
            for (int ai = 0; ai < 2; ++ai)
#pragma unroll
                for (int m = 0; m < 4; ++m) { const int row = pm * 256 + EROW(ai, m); bf16_t* rowp = dst + (size_t)row * 256; float s = 0.f;
#pragma unroll
                    for (int bj = 0; bj < 2; ++bj) { *(u32x4*)(rowp + ECOL(bj)) = pack8(acc[ai][bj][m][0], acc[ai][bj][m][1]);
                        if (pn == 1 && bj == 1) continue;
#pragma unroll
                        for (int n = 0; n < 2; ++n) { const f32x4 x = acc[ai][bj][m][n]; s += x[0] * x[0] + x[1] * x[1] + x[2] * x[2] + x[3] * x[3]; } }
                    s += lane_xor<16>(s, 0); s = half_sum32(s);
                    if (fq == 0) ssq[(size_t)row * 8 + pn * 4 + wc] = s; }
        } else if (pn >= 4) {
            size_t base; int ld, coff = 0;
            if (pn == 4) { base = WS_GQ; ld = 256; } else if (pn == 5) { base = WS_GK; ld = 256; } else if (pn < 8) { base = WS_GV; ld = 512; coff = (pn - 6) * 256; } else { base = WS_GOG; ld = 512; coff = (pn - 8) * 256; }
            bf16_t* dst = (bf16_t*)(ws + base);
#pragma unroll
            for (int ai = 0; ai < 2; ++ai)
#pragma unroll
                for (int m = 0; m < 4; ++m) { bf16_t* rowp = dst + (size_t)(pm * 256 + EROW(ai, m)) * ld + coff;
#pragma unroll
                    for (int bj = 0; bj < 2; ++bj) *(u32x4*)(rowp + ECOL(bj)) = pack8(acc[ai][bj][m][0], acc[ai][bj][m][1]); }
        } else {
            bf16_t* dst = (bf16_t*)(ws + WS_UFT); const int b = pm / 17, i0 = (pm % 17) * 256;
#pragma unroll
            for (int ai = 0; ai < 2; ++ai)
#pragma unroll
                for (int m = 0; m < 4; ++m) { const int ch = (pn - 2) * 256 + EROW(ai, m); bf16_t* rowp = dst + ((size_t)(b * 512 + ch)) * RPB + i0;
#pragma unroll
                    for (int bj = 0; bj < 2; ++bj) *(u32x4*)(rowp + ECOL(bj)) = pack8(acc[ai][bj][m][0], acc[ai][bj][m][1]); }
        }
    }
};
struct G1EpiB {
    char* ws;
    __device__ __forceinline__ void operator()(Acc& acc, const Unit& u, int wr, int wc, int fr, int fq) const {
        const int pn = u.pn(), pm = u.pm;
        unsigned char* g8 = (unsigned char*)(ws + WS_GATE); const int coff = (pn - 10) * 256;
#pragma unroll
        for (int ai = 0; ai < 2; ++ai)
#pragma unroll
            for (int m = 0; m < 4; ++m) { unsigned char* rowp = g8 + (size_t)(pm * 256 + EROW(ai, m)) * 3072 + coff;
#pragma unroll
                for (int bj = 0; bj < 2; ++bj) { f32x4 v0 = acc[ai][bj][m][0], v1 = acc[ai][bj][m][1];
#pragma unroll
                    for (int j = 0; j < 4; ++j) { v0[j] = fminf(__expf(-v0[j]), 448.0f); v1[j] = fminf(__expf(-v1[j]), 448.0f); }
                    u32x2 w8; w8.x = cvt4_fp8(v0[0], v0[1], v0[2], v0[3]); w8.y = cvt4_fp8(v1[0], v1[1], v1[2], v1[3]);
                    *(u32x2*)(rowp + ECOL(bj)) = w8; } }
    }
};
struct G1EpiAB { G1EpiA A; G1EpiB B;
    __device__ __forceinline__ void operator()(Acc& acc, const Unit& u, int wr, int wc, int fr, int fq) const { if (u.pn() >= 10) B(acc, u, wr, wc, fr, fq); else A(acc, u, wr, wc, fr, fq); } };

struct DftBSched {
    static constexpr bool GATHER = false, FP8 = false;
    char* ws; int G, c;
    __device__ __forceinline__ bool next(int i, Unit& u) const {
        const int L = i * G + c; if (L >= 512) return false;
        const int b = L >> 6, pm = (L >> 5) & 1, pn = L & 31;
        u.set(pm, pn, b, 10, 0); u.nt = 8; u.lda2 = 1024u; u.ldb2 = 1024u;
        u.A = ws + WS_DB + (size_t)pm * 256 * 1024; u.B = ws + WS_DFTL + ((size_t)b * 8192 + pn * 256) * 1024; return true;
    }
};
struct DftCSched {
    static constexpr bool GATHER = false, FP8 = false;
    char* ws; int G, c;
    __device__ __forceinline__ bool next(int i, Unit& u) const {
        const int L = i * G + c; if (L >= 32) return false;
        const int b = L >> 2, mt = (L >> 1) & 1, nn = L & 1;
        u.set(mt, nn, b, 11, 0); u.nt = 4; u.lda2 = 512u; u.ldb2 = (unsigned)RPB * 2u;
        u.A = ws + WS_DFTC + (size_t)mt * 256 * 512; u.B = ws + WS_UFT + ((size_t)(b * 512 + nn * 256) * RPB) * 2; return true;
    }
};
struct DftEpi {
    char* ws;
    __device__ __forceinline__ void operator()(Acc& acc, const Unit& u, int wr, int wc, int fr, int fq) const {
        unsigned char* P = (unsigned char*)(ws + WS_P); const int pm = u.pm, pn = u.pn(), b = u.aux();
#pragma unroll
        for (int ai = 0; ai < 2; ++ai)
#pragma unroll
            for (int bj = 0; bj < 2; ++bj)
#pragma unroll
                for (int m = 0; m < 4; ++m)
#pragma unroll
                    for (int j = 0; j < 4; ++j) { acc[ai][bj][m][0][j] = sat8(acc[ai][bj][m][0][j]); acc[ai][bj][m][1][j] = sat8(acc[ai][bj][m][1][j]); }
        if (u.kind() == 10) {
            const int k2 = pn >> 1, cb = (pn & 1) * 256;
#pragma unroll
            for (int ai = 0; ai < 2; ++ai)
#pragma unroll
                for (int m = 0; m < 4; ++m) { EPI_GAP(ai, m); unsigned char* rowp = P + (size_t)(b * RPB + CTX + 16 * EROW(ai, m) + k2) * 1024 + pm * 512 + cb;
#pragma unroll
                    for (int bj = 0; bj < 2; ++bj) *(u32x2*)(rowp + ECOL(bj)) = pack8f(acc[ai][bj][m][0], acc[ai][bj][m][1]); }
        } else {
#pragma unroll
            for (int ai = 0; ai < 2; ++ai)
#pragma unroll
                for (int m = 0; m < 4; ++m) { EPI_GAP(ai, m); unsigned char* rowp = P + (size_t)(b * RPB + EROW(ai, m)) * 1024 + pm * 512 + pn * 256;
#pragma unroll
                    for (int bj = 0; bj < 2; ++bj) *(u32x2*)(rowp + ECOL(bj)) = pack8f(acc[ai][bj][m][0], acc[ai][bj][m][1]); }
        }
    }
};
__device__ __forceinline__ float ssq_scale(const float* ssq, int row, int which, float inv_n) { const f32x4 s = *(const f32x4*)(ssq + (size_t)row * 8 + which * 4); return rsqrtf((s[0] + s[1] + s[2] + s[3]) * inv_n + EPS); }
struct QSched {
    static constexpr bool GATHER = false, FP8 = false;
    char* ws; const char* wl; int G, c;
    __device__ __forceinline__ bool next(int i, Unit& u) const {
        const int L = i * G + c; if (L >= NMT * 3) return false; const int pm = L / 3, pn = L % 3;
        u.set(pm, pn, 0, 12, 0); u.nt = 4; u.lda2 = 512u; u.ldb2 = 512u;
        u.A = ws + WS_UQ + (size_t)pm * 256 * 512; u.B = wl + WL_WUQ + (size_t)pn * 256 * 512; return true;
    }
};
struct QEpi {
    char* ws;
    __device__ __forceinline__ void operator()(Acc& acc, const Unit& u, int wr, int wc, int fr, int fq) const {
        const int pm = u.pm, pn = u.pn();
        const float* ssq = (const float*)(ws + WS_SSQ); bf16_t* Q = (bf16_t*)(ws + WS_Q); const f32x2* rope = (const f32x2*)(ws + WS_ROPE);
        float scq[2][4];
#pragma unroll
        for (int ai = 0; ai < 2; ++ai)
#pragma unroll
            for (int m = 0; m < 4; ++m) scq[ai][m] = ssq_scale(ssq, pm * 256 + EROW(ai, m), 0, 1.0f / 256.0f) * QSCALE;
#pragma unroll
        for (int ai = 0; ai < 2; ++ai) {
            f32x2 rp[1][4][4];
            if (pn == 2) { const int axis = fq >> 1, i0 = 4 * (fq & 1);
#pragma unroll
                for (int m = 0; m < 4; ++m) { const int tl = (pm * 256 + EROW(ai, m)) % RPB - CTX, pos = tl < 0 ? 0 : (axis ? (tl & 63) : (tl >> 6));
#pragma unroll
                    for (int q = 0; q < 4; ++q) rp[0][m][q] = rope[pos * 8 + i0 + q]; } }
#pragma unroll
            for (int m = 0; m < 4; ++m) { EPI_GAP(ai, m); const int row = pm * 256 + EROW(ai, m); const float sc = scq[ai][m];
                const int ib = row % RPB, tl = ib - CTX;
#pragma unroll
                for (int bj = 0; bj < 2; ++bj) { f32x4 v0 = acc[ai][bj][m][0] * sc, v1 = acc[ai][bj][m][1] * sc;
                    const int cc = ECOL(bj);
                    if (pn < 2) { const int col = pn * 256 + cc, h = col >> 6, d = col & 63; *(u32x4*)(Q + (size_t)row * 768 + h * 96 + d) = pack8(v0, v1); }
                    else { const int h = cc >> 5, axis = fq >> 1, i0 = 4 * (fq & 1);
                        if (tl >= 0) { const f32x2 r0 = rp[0][m][0], r1 = rp[0][m][1], r2 = rp[0][m][2], r3 = rp[0][m][3];
                            f32x4 o0, o1;
                            o0[0] = v0[0] * r0.x - v0[1] * r0.y; o0[1] = v0[1] * r0.x + v0[0] * r0.y; o0[2] = v0[2] * r1.x - v0[3] * r1.y; o0[3] = v0[3] * r1.x + v0[2] * r1.y;
                            o1[0] = v1[0] * r2.x - v1[1] * r2.y; o1[1] = v1[1] * r2.x + v1[0] * r2.y; o1[2] = v1[2] * r3.x - v1[3] * r3.y; o1[3] = v1[3] * r3.x + v1[2] * r3.y;
                            v0 = o0; v1 = o1; }
                        *(u32x4*)(Q + (size_t)row * 768 + h * 96 + 64 + 8 * fq) = pack8(v0, v1); } }
                EFENCE(); } }
    }
};
struct KnSched {
    static constexpr bool GATHER = false, FP8 = false;
    char* ws; const char* wl; int G, c;
    __device__ __forceinline__ bool next(int i, Unit& u) const {
        const int L = i * G + c; if (L >= NMT * 2) return false; const int pm = L >> 1, pn = L & 1;
        u.set(pm, pn, 0, 13, 0); u.nt = 4; u.lda2 = 512u; u.ldb2 = 512u;
        u.A = ws + WS_UKV + (size_t)pm * 256 * 512; u.B = wl + WL_WUKV + (size_t)pn * 256 * 512; return true;
    }
};
struct KnEpi {
    char* ws;
    __device__ __forceinline__ void operator()(Acc& acc, const Unit& u, int wr, int wc, int fr, int fq) const {
        const float* ssq = (const float*)(ws + WS_SSQ); bf16_t* KN = (bf16_t*)(ws + WS_KN); const int pm = u.pm, pn = u.pn();
        float sck[2][4];
#pragma unroll
        for (int ai = 0; ai < 2; ++ai)
#pragma unroll
            for (int m = 0; m < 4; ++m) sck[ai][m] = ssq_scale(ssq, pm * 256 + EROW(ai, m), 1, 1.0f / 128.0f);
#pragma unroll
        for (int ai = 0; ai < 2; ++ai)
#pragma unroll
            for (int m = 0; m < 4; ++m) { EPI_GAP(ai, m); const int row = pm * 256 + EROW(ai, m); const float sc = sck[ai][m];
#pragma unroll
                for (int bj = 0; bj < 2; ++bj) *(u32x4*)(KN + (size_t)row * 512 + pn * 256 + ECOL(bj)) = pack8(acc[ai][bj][m][0] * sc, acc[ai][bj][m][1] * sc); }
    }
};
struct VtSched {
    static constexpr bool GATHER = false, FP8 = false;
    char* ws; const char* wl; int G, c;
    __device__ __forceinline__ bool next(int i, Unit& u) const {
        const int L = i * G + c; if (L >= NMT * 2) return false; const int pm = L >> 1, pn = L & 1;
        u.set(pm, pn, 0, 14, 0); u.nt = 4; u.lda2 = 512u; u.ldb2 = 512u;
        u.A = wl + WL_WUKV + (size_t)(2 + pn) * 256 * 512; u.B = ws + WS_UKV + (size_t)pm * 256 * 512; return true;
    }
};
struct VtEpi {
    char* ws;
    __device__ __forceinline__ void operator()(Acc& acc, const Unit& u, int wr, int wc, int fr, int fq) const {
        const float* ssq = (const float*)(ws + WS_SSQ); bf16_t* VT = (bf16_t*)(ws + WS_VT); const int pm = u.pm, pn = u.pn(), b = pm / 17, i0 = (pm % 17) * 256;
#pragma unroll
        for (int bj = 0; bj < 2; ++bj) { float sc[8];
#pragma unroll
            for (int j = 0; j < 8; ++j) sc[j] = ssq_scale(ssq, pm * 256 + ECOL(bj) + j, 1, 1.0f / 128.0f);
#pragma unroll
            for (int ai = 0; ai < 2; ++ai)
#pragma unroll
                for (int m = 0; m < 4; ++m) { EPI_GAP(ai, m); const int vc = pn * 256 + EROW(ai, m);
                    f32x4 v0 = acc[ai][bj][m][0], v1 = acc[ai][bj][m][1];
#pragma unroll
                    for (int j = 0; j < 4; ++j) { v0[j] *= sc[j]; v1[j] *= sc[4 + j]; }
                    { bf16_t* gp_ = VT + ((size_t)(b * 512 + vc)) * RPB + i0 + 128 * bj + 32 * wc + 16 * (fq >> 1) + 4 * (fq & 1);
                      u32x2 w0_, w1_; w0_.x = cvt_pk_bf16(v0[0], v0[1]); w0_.y = cvt_pk_bf16(v0[2], v0[3]); w1_.x = cvt_pk_bf16(v1[0], v1[1]); w1_.y = cvt_pk_bf16(v1[2], v1[3]);
                      *(u32x2*)gp_ = w0_; *(u32x2*)(gp_ + 8) = w1_; } }
            EFENCE(); }
    }
};


struct P2Sched {
    static constexpr bool GATHER = false, FP8 = false, COUNTED = false;
    char* ws; const char* wl; int l, G, c;
    __device__ __forceinline__ void dft_unit(int L, Unit& u) const { const int b = L >> 2, mt = (L >> 1) & 1, nn = L & 1;
        u.set(mt, nn, b, 11, 0); u.lda2 = 512u; u.ldb2 = (unsigned)RPB * 2u;
        u.A = ws + WS_DFTC + (size_t)mt * 256 * 512; u.B = ws + WS_UFT + ((size_t)(b * 512 + nn * 256) * RPB) * 2; }
    __device__ __forceinline__ void q_unit(int pm, int pn, Unit& u) const { u.lda2 = 512u; u.ldb2 = 512u; u.set(pm, pn, 0, 12, 0);
        u.A = ws + WS_UQ + (size_t)pm * 256 * 512; u.B = wl + WL_WUQ + (size_t)pn * 256 * 512; }
    __device__ __forceinline__ void kv_unit(int pm, int pn, Unit& u) const { u.lda2 = 512u; u.ldb2 = 512u;
        const char* a = ws + WS_UKV + (size_t)pm * 256 * 512; const char* b = wl + WL_WUKV + (size_t)pn * 256 * 512;
        if (pn < 2) { u.set(pm, pn, 0, 13, 0); u.A = a; u.B = b; } else { u.set(pm, pn - 2, 0, 14, 0); u.A = b; u.B = a; } }
    __device__ __forceinline__ bool next(int i, Unit& u) const {
        u.nt = 4;
        if (G == 256) {
            const int x = c & 7, s = c >> 3, v = i * 32 + s;
            if (v < 17 * 7) { const int pm = 8 * (v / 7) + x, j = v % 7; if (j < 3) q_unit(pm, j, u); else kv_unit(pm, j - 3, u); return true; }
            if (l < DEPTH - 1 && i == 3 && s >= 23 && s < 27) { dft_unit((s - 23) * 8 + x, u); return true; }
            return false; }
        int L = i * G + c;
        if (l < DEPTH - 1) { if (L < 32) { dft_unit(L, u); return true; } L -= 32; }
        if (L < NMT * 3) { q_unit(L / 3, L % 3, u); return true; }
        L -= NMT * 3;
        if (L < NMT * 4) { kv_unit(L >> 2, L & 3, u); return true; }
        return false;
    }
};
struct P2Epi {
    DftEpi D; QEpi Q; KnEpi K; VtEpi V;
    __device__ __forceinline__ void operator()(Acc& acc, const Unit& u, int wr, int wc, int fr, int fq) const {
        const int kind = u.kind();
        if (kind == 11) D(acc, u, wr, wc, fr, fq); else if (kind == 12) Q(acc, u, wr, wc, fr, fq); else if (kind == 13) K(acc, u, wr, wc, fr, fq); else V(acc, u, wr, wc, fr, fq);
    }
};
__device__ __forceinline__ int act_tile(int l, int at) { return (l < DEPTH - 1) ? at : at + at / 16 + 1; }
__device__ __forceinline__ int n_act_tiles(int l) { return (l < DEPTH - 1) ? NMT : NMT - NB; }
struct MergeSched {
    static constexpr bool GATHER = false, FP8 = true;
    char* ws; const char* wl; int l, G, c;
    __device__ __forceinline__ bool next(int i, Unit& u) const {
        const int seg = i % 3; int at, pn;
        if (G == 256) { const int x = c & 7, u = (i / 3) * 32 + (c >> 3); at = 8 * (u >> 2) + x; pn = u & 3; if (at >= n_act_tiles(l)) return false; }
        else { const int it = (i / 3) * G + c; if (it >= n_act_tiles(l) * 4) return false; at = it >> 2; pn = it & 3; }
        const int pm = act_tile(l, at);
        u.set(pm, pn, seg, 20, seg < 2 ? 1 : 0);
        if (seg == 0) { u.A = ws + WS_OMLA + (size_t)pm * 256 * 512; u.B = wl + WL_WM + (size_t)pn * 256 * 512; u.lda2 = 512u; u.ldb2 = 512u; u.nt = 4; }
        else if (seg == 1) { u.A = ws + WS_P + (size_t)pm * 256 * 1024; u.B = wl + WL_WF + (size_t)pn * 256 * 1024; u.lda2 = 1024u; u.ldb2 = 1024u; u.nt = 8; }
        else { u.A = ws + WS_OGLA + (size_t)pm * 256 * 512; u.B = wl + WL_WG + (size_t)pn * 256 * 512; u.lda2 = 512u; u.ldb2 = 512u; u.nt = 4; }
        return true;
    }
};
struct MergeEpi {
    char* ws; int dry;
    __device__ __forceinline__ void operator()(Acc& acc, const Unit& u, int wr, int wc, int fr, int fq) const {
        if (dry) return;
        const unsigned char* GT = (const unsigned char*)(ws + WS_GATE); unsigned char* Y = (unsigned char*)(ws + WS_Y); const int seg = u.aux(), pn = u.pn();
        const int oa = (seg < 2) ? seg * 1024 : 2048, ob = (seg < 2) ? (seg + 1) * 1024 : 2048;
        u32x2 wa[4][2], wb[4][2];
        if (seg == 2) {
#pragma unroll
            for (int m = 0; m < 4; ++m)
#pragma unroll
                for (int bj = 0; bj < 2; ++bj) { wa[m][bj] = *(const u32x2*)(GT + (size_t)(u.pm * 256 + EROW(0, m)) * 3072 + pn * 256 + ECOL(bj) + 2048);
                    wb[m][bj] = *(const u32x2*)(GT + (size_t)(u.pm * 256 + EROW(1, m)) * 3072 + pn * 256 + ECOL(bj) + 2048); } }
#pragma unroll
        for (int ai = 0; ai < 2; ++ai) {
            if (seg < 2) {
#pragma unroll
                for (int m = 0; m < 4; ++m)
#pragma unroll
                    for (int bj = 0; bj < 2; ++bj) { const unsigned char* gp = GT + (size_t)(u.pm * 256 + EROW(ai, m)) * 3072 + pn * 256 + ECOL(bj);
                        wa[m][bj] = *(const u32x2*)(gp + oa); wb[m][bj] = *(const u32x2*)(gp + ob); } }
            else if (ai == 1) {
#pragma unroll
                for (int m = 0; m < 4; ++m)
#pragma unroll
                    for (int bj = 0; bj < 2; ++bj) wa[m][bj] = wb[m][bj]; }
#pragma unroll
            for (int m = 0; m < 4; ++m) { const int row = u.pm * 256 + EROW(ai, m);
#pragma unroll
                for (int bj = 0; bj < 2; ++bj) { const int col = pn * 256 + ECOL(bj);
                    float a[8], b[8];
                    cvt_fp8x4(wa[m][bj].x, a[0], a[1], a[2], a[3]); cvt_fp8x4(wa[m][bj].y, a[4], a[5], a[6], a[7]); cvt_fp8x4(wb[m][bj].x, b[0], b[1], b[2], b[3]); cvt_fp8x4(wb[m][bj].y, b[4], b[5], b[6], b[7]);
                    f32x4& v0 = acc[ai][bj][m][0]; f32x4& v1 = acc[ai][bj][m][1];
                    if (seg < 2) {
#pragma unroll
                        for (int j = 0; j < 8; ++j) { const float f = (1.0f + b[j]) * __builtin_amdgcn_rcpf(1.0f + a[j]); if (j < 4) v0[j] *= f; else v1[j - 4] *= f; } }
                    else {
#pragma unroll
                        for (int j = 0; j < 8; ++j) { const float f = __builtin_amdgcn_rcpf(1.0f + a[j]); if (j < 4) v0[j] *= f; else v1[j - 4] *= f; } }
                    if (seg == 2) *(u32x2*)(Y + (size_t)row * 1024 + col) = pack8fs(v0, v1); } }
            EFENCE(); }
    }
};

struct WoSched {
    static constexpr bool GATHER = false, FP8 = true;
    char* ws; const char* wl; int l, G, c;
    __device__ __forceinline__ bool next(int i, Unit& u) const {
        int at, pn;
        if (G == 256) { const int x = c & 7, u = i * 32 + (c >> 3); at = 8 * (u >> 2) + x; pn = u & 3; if (at >= n_act_tiles(l)) return false; }
        else { const int it = i * G + c; if (it >= n_act_tiles(l) * 4) return false; at = it >> 2; pn = it & 3; }
        const int pm = act_tile(l, at);
        u.set(pm, pn, 0, 30, 0); u.nt = 8; u.lda2 = 1024u; u.ldb2 = 1024u;
        u.A = ws + WS_Y + (size_t)pm * 256 * 1024; u.B = wl + WL_WO + (size_t)pn * 256 * 1024; return true;
    }
};
struct WoEpi {
    char* ws; int l; int dry;
    const float* x_in; const float* ctx_in;
    __device__ __forceinline__ void operator()(Acc& acc, const Unit& u, int wr, int wc, int fr, int fq) const {
        bf16_t* X = (bf16_t*)(ws + WS_X); const int pn = u.pn(), s = (u.pm % 17 == 0) ? 8 : u.pm / 17;
        const float* g1 = (const float*)(ws + WS_MOD) + ((size_t)l * 9 + s) * 6144 + 2048;
        f32x4 gv[2][2];
#pragma unroll
        for (int bj = 0; bj < 2; ++bj) { const int col = pn * 256 + ECOL(bj); gv[bj][0] = *(const f32x4*)(g1 + col); gv[bj][1] = *(const f32x4*)(g1 + col + 4); }
#pragma unroll
        for (int ai = 0; ai < 2; ++ai) {
            f32x4 xv[4][2][2];
            if (l == 0) { const int b = u.pm / 17, j = u.pm % 17; const float* Xr = (j == 0) ? ctx_in + (size_t)b * 256 * 1024 : x_in + ((size_t)b * 4096 + (size_t)(j - 1) * 256) * 1024;
#pragma unroll
                for (int m = 0; m < 4; ++m) { const float* rowp = Xr + (size_t)EROW(ai, m) * 1024 + pn * 256;
#pragma unroll
                    for (int bj = 0; bj < 2; ++bj) { xv[m][bj][0] = *(const f32x4*)(rowp + ECOL(bj)); xv[m][bj][1] = *(const f32x4*)(rowp + ECOL(bj) + 4); } } }
            else { u32x4 xw[4][2];
#pragma unroll
                for (int m = 0; m < 4; ++m) { const bf16_t* rowp = X + (size_t)(u.pm * 256 + EROW(ai, m)) * 1024 + pn * 256;
#pragma unroll
                    for (int bj = 0; bj < 2; ++bj) xw[m][bj] = *(const u32x4*)(rowp + ECOL(bj)); }
#pragma unroll
                for (int m = 0; m < 4; ++m)
#pragma unroll
                    for (int bj = 0; bj < 2; ++bj) { const u32x4 w = xw[m][bj]; xv[m][bj][0] = (f32x4){bflo(w.x), bfhi(w.x), bflo(w.y), bfhi(w.y)}; xv[m][bj][1] = (f32x4){bflo(w.z), bfhi(w.z), bflo(w.w), bfhi(w.w)}; } }
#pragma unroll
            for (int m = 0; m < 4; ++m) { bf16_t* rowp = X + (size_t)(u.pm * 256 + EROW(ai, m)) * 1024 + pn * 256;
#pragma unroll
                for (int bj = 0; bj < 2; ++bj) { bf16_t* q = rowp + ECOL(bj);
                    const f32x4 r0 = xv[m][bj][0] + gv[bj][0] * acc[ai][bj][m][0], r1 = xv[m][bj][1] + gv[bj][1] * acc[ai][bj][m][1];
                    if (!dry) *(u32x4*)q = pack8(r0, r1); else asm volatile("" :: "v"(r0), "v"(r1)); } }
            EFENCE(); }
    }
};

struct MoeSched {
    static constexpr bool GATHER = false, FP8 = true;
    const char* A; const char* W; const LAS int* tb; int G, c; static constexpr int npn = 4; static constexpr size_t wstride = (size_t)1024 * 1024;
    __device__ __forceinline__ bool next(int i, Unit& u) const {
        const int total = __builtin_amdgcn_readfirstlane(tb[32]); int tg, pn;
        if (G == 256) { const int x = c & 7, s = c >> 3; tg = (i * 8 + x) * 8 + (s >> 2); pn = s & 3; if (tg >= total) return false; }
        else { const int L = i * G + c; if (L >= total * npn) return false; tg = L / npn; pn = L % npn; }
        int e = 0;
#pragma unroll
        for (int k = 16; k >= 1; k >>= 1) { const int v = __builtin_amdgcn_readfirstlane(tb[e + k]); if (v <= tg) e += k; }
        u.set(tg, pn, e, 40, 0); u.nt = 8; u.lda2 = 1024u; u.ldb2 = 1024u;
        u.A = A + (size_t)tg * 256 * 1024; u.B = W + (size_t)e * wstride + (size_t)pn * 256 * 1024; return true;
    }
};
struct MoeUpSched {
    static constexpr bool GATHER = true, FP8 = true; static constexpr int GPITCH = 1024;
    const char* gbase; const int* rt2; const char* W; const LAS int* tb; const LAS int* cn; int G, c;
    __device__ __forceinline__ bool next(int i, Unit& u) const {
        const int total = __builtin_amdgcn_readfirstlane(tb[32]); int tg, pn;
        if (G == 256) {
            const int x = c & 7, s = c >> 3; tg = (i * 8 + x) * 4 + (s >> 3); pn = s & 7; if (tg >= total) return false; }
        else { const int L = i * G + c; if (L >= total * 8) return false; tg = L >> 3; pn = L & 7; }
        int e = 0;
#pragma unroll
        for (int k = 16; k >= 1; k >>= 1) { const int v = __builtin_amdgcn_readfirstlane(tb[e + k]); if (v <= tg) e += k; }
        const int j = tg - __builtin_amdgcn_readfirstlane(tb[e]), n = __builtin_amdgcn_readfirstlane(cn[e]) - j * 256;
        u.set(tg, pn, e, 40, 0); u.nt = 8; u.lda2 = (unsigned)(n < 256 ? n : 256); u.ldb2 = 1024u;
        u.A = (const char*)(rt2 + (size_t)e * T + j * 256); u.B = W + (size_t)e * 2048 * 1024 + (size_t)pn * 256 * 1024; return true;
    }
};
struct UpEpi {
    char* ws; const float* b_up;
    __device__ __forceinline__ void operator()(Acc& acc, const Unit& u, int wr, int wc, int fr, int fq) const {
        unsigned char* ACT = (unsigned char*)(ws + WS_ACT); const float* bu = b_up + (size_t)u.aux() * 2048;
        const int cg = u.pn() * 128 + 32 * wc + 8 * fq;
        const f32x4 bg0 = *(const f32x4*)(bu + cg), bg1 = *(const f32x4*)(bu + cg + 4), bl0 = *(const f32x4*)(bu + 1024 + cg), bl1 = *(const f32x4*)(bu + 1024 + cg + 4);
#pragma unroll
        for (int ai = 0; ai < 2; ++ai)
#pragma unroll
            for (int m = 0; m < 4; ++m) { EPI_GAP(ai, m); f32x4 o[2];
#pragma unroll
                for (int n = 0; n < 2; ++n)
#pragma unroll
                    for (int j = 0; j < 4; ++j) { float gl = acc[ai][0][m][n][j] + (n ? bg1[j] : bg0[j]), li = acc[ai][1][m][n][j] + (n ? bl1[j] : bl0[j]);
                        gl = fminf(gl, 7.0f); li = __builtin_amdgcn_fmed3f(li, -7.0f, 7.0f);
                        const float sg = gl * __builtin_amdgcn_rcpf(1.0f + __builtin_amdgcn_exp2f(gl * -2.4554669595930156f));
                        o[n][j] = __builtin_fmaf(sg, li, sg); }
                u32x2 w8; w8.x = cvt4_fp8(o[0][0], o[0][1], o[0][2], o[0][3]); w8.y = cvt4_fp8(o[1][0], o[1][1], o[1][2], o[1][3]);
                *(u32x2*)(ACT + (size_t)(u.pm * 256 + EROW(ai, m)) * 1024 + cg) = w8; }
    }
};
struct DownEpi {
    char* ws; const float* b_down;
    __device__ __forceinline__ void operator()(Acc& acc, const Unit& u, int wr, int wc, int fr, int fq) const {
        unsigned char* YM = (unsigned char*)(ws + WS_YM); const float* bd = b_down + (size_t)u.aux() * 1024; const int pn = u.pn();
#pragma unroll
        for (int bj = 0; bj < 2; ++bj) { const int col = pn * 256 + ECOL(bj); const f32x4 bv0 = *(const f32x4*)(bd + col), bv1 = *(const f32x4*)(bd + col + 4);
#pragma unroll
            for (int ai = 0; ai < 2; ++ai)
#pragma unroll
                for (int m = 0; m < 4; ++m) { const f32x4 y0 = (acc[ai][bj][m][0] + bv0) * YM_SCALE, y1 = (acc[ai][bj][m][1] + bv1) * YM_SCALE; u32x2 w; w.x = cvt4_fp8s(y0[0], y0[1], y0[2], y0[3]); w.y = cvt4_fp8s(y1[0], y1[1], y1[2], y1[3]);
                    *(u32x2*)(YM + (size_t)(u.pm * 256 + EROW(ai, m)) * 1024 + col) = w; }
            EFENCE(); }
    }
};
namespace at {
constexpr int NSLOT = 4, KSLOT = 12288, VSLOT = 8192, OFF_V = NSLOT * KSLOT, OFF_WS = OFF_V + NSLOT * VSLOT, OFF_OST = OFF_WS + 8 * 256, LDS_NEED = OFF_OST + 8 * 4096;
__device__ __forceinline__ int crow(int r, int hi) { return (r & 3) + 8 * (r >> 2) + 4 * hi; }

__device__ __forceinline__ void attn_unit(char* ws, LAS unsigned char* lds, int b, int h, int qrow0, int nkt) {
    const int tid = ltid(), lane = tid & 63, r32 = lane & 31, hi = lane >> 5, wid = __builtin_amdgcn_readfirstlane(tid >> 6);
    const bf16_t* Q = (const bf16_t*)(ws + WS_Q); unsigned char* O = (unsigned char*)(ws + WS_OMLA);
    const size_t rowb = (size_t)b * RPB;
    const char* src[3]; unsigned inc[3], dsto[3];
#pragma unroll
    for (int j = 0; j < 3; ++j) {
        int pc = wid + 8 * j; if (pc >= 20) pc -= 8;
        if (pc < 8) { src[j] = ws + WS_KN + ((rowb + lane) * 512 + h * 64 + pc * 8) * 2; inc[j] = 64u * 1024u; dsto[j] = (unsigned)pc * 1024u; }
        else if (pc < 12) { src[j] = ws + WS_KR + ((rowb + lane) * 32 + (pc - 8) * 8) * 2; inc[j] = 64u * 64u; dsto[j] = (unsigned)pc * 1024u; }
        else { const int v = pc - 12, d = 8 * v + (lane >> 3), cl = lane & 7, lc = cl ^ ((d >> 1) & 7);
            src[j] = ws + WS_VT + (((size_t)(b * 8 + h) * 64 + d) * RPB + lc * 8) * 2; inc[j] = 128u; dsto[j] = (unsigned)(OFF_V + v * 1024); }
    }
#define AT_ISSUE(t, slot) do { _Pragma("unroll") for (int j = 0; j < 3; ++j) { \
        const unsigned so = (dsto[j] >= (unsigned)OFF_V) ? (unsigned)(slot) * VSLOT : (unsigned)(slot) * KSLOT; \
        __builtin_amdgcn_global_load_lds((const unsigned*)(src[j] + (size_t)(t) * inc[j]), (LAS unsigned*)(lds + dsto[j] + so), 16, 0, 0); } } while (0)
    const bf16_t* Qp = Q + (rowb + qrow0 + wid * 32 + r32) * 768 + h * 96 + hi * 8;
    bf16x8 qr[6];
#pragma unroll
    for (int d0 = 0; d0 < 6; ++d0) qr[d0] = *(const bf16x8*)(Qp + d0 * 16);
    f32x16 o0, o1, ol; const f32x16 zero16 = {0.f, 0.f, 0.f, 0.f, 0.f, 0.f, 0.f, 0.f, 0.f, 0.f, 0.f, 0.f, 0.f, 0.f, 0.f, 0.f};
#pragma unroll
    for (int r = 0; r < 16; ++r) { o0[r] = 0.f; o1[r] = 0.f; ol[r] = 0.f; }
    float m_run = 0.f;
    const u32x4 onesw = {0x3F803F80u, 0x3F803F80u, 0x3F803F80u, 0x3F803F80u};
    LAS float* wsf = (LAS float*)(lds + OFF_WS + wid * 256);
#define AT_QK(PD0, PD1, slot) do { const LAS unsigned char* ks_ = lds + (slot) * KSLOT + hi * 1024 + r32 * 16; \
        _Pragma("unroll") for (int d0 = 0; d0 < 6; ++d0) { \
            const bf16x8 k0 = *(const LAS bf16x8*)(ks_ + d0 * 2048), k1 = *(const LAS bf16x8*)(ks_ + d0 * 2048 + 512); \
            if (d0 == 0) { PD0 = __builtin_amdgcn_mfma_f32_32x32x16_bf16(k0, qr[0], zero16, 0, 0, 0); PD1 = __builtin_amdgcn_mfma_f32_32x32x16_bf16(k1, qr[0], zero16, 0, 0, 0); } \
            else { PD0 = __builtin_amdgcn_mfma_f32_32x32x16_bf16(k0, qr[d0], PD0, 0, 0, 0); PD1 = __builtin_amdgcn_mfma_f32_32x32x16_bf16(k1, qr[d0], PD1, 0, 0, 0); } } } while (0)
#define MX3(a, b, c) __builtin_fmaxf(__builtin_fmaxf((a), (b)), (c))
#define AT_STEP(PC0, PC1, PN0, PN1, t) do { \
        if ((t) + 2 < nkt) { asm volatile("s_waitcnt vmcnt(3)" ::: "memory"); } else { asm volatile("s_waitcnt vmcnt(0)" ::: "memory"); } \
        asm volatile("s_waitcnt lgkmcnt(0)" ::: "memory"); \
        __builtin_amdgcn_s_barrier(); asm volatile("" ::: "memory"); \
        if ((t) + 3 < nkt) AT_ISSUE((t) + 3, ((t) + 3) & 3); \
        if ((t) + 1 < nkt) AT_QK(PN0, PN1, ((t) + 1) & 3); \
        float ra = MX3(PC0[0], PC0[1], PC1[0]), rb = MX3(PC0[2], PC0[3], PC1[1]); ra = MX3(ra, PC1[2], PC1[3]); \
        _Pragma("unroll") for (int r = 4; r < 16; r += 4) { ra = MX3(ra, PC0[r], PC0[r + 1]); rb = MX3(rb, PC0[r + 2], PC0[r + 3]); ra = MX3(ra, PC1[r], PC1[r + 1]); rb = MX3(rb, PC1[r + 2], PC1[r + 3]); } \
        const float rm = half_max32(fmaxf(ra, rb));                            \
        const bool trig = ((t) == 0) ? __any(fabsf(rm) > 30.0f) : __any(rm - m_run > 30.0f); \
        if (trig) {                                                            \
            const float m_new = ((t) == 0) ? rm : fmaxf(m_run, rm), alpha = ((t) == 0) ? 1.0f : __builtin_amdgcn_exp2f(m_run - m_new); \
            m_run = m_new; \
            if (hi == 0) wsf[r32] = alpha; \
            asm volatile("s_waitcnt lgkmcnt(0)" ::: "memory"); \
            _Pragma("unroll") for (int r = 0; r < 16; ++r) { const float a_ = wsf[crow(r, hi)]; o0[r] *= a_; o1[r] *= a_; ol[r] *= a_; } \
            asm volatile("s_waitcnt lgkmcnt(0)" ::: "memory"); } \
        if (__any(m_run != 0.f)) { _Pragma("unroll") for (int r = 0; r < 16; ++r) { PC0[r] -= m_run; PC1[r] -= m_run; } }      \
        _Pragma("unroll") for (int r = 0; r < 16; ++r) { PC0[r] = __builtin_amdgcn_exp2f(PC0[r]); PC1[r] = __builtin_amdgcn_exp2f(PC1[r]); } \
        u32x4 pw[4]; \
        _Pragma("unroll") for (int k = 0; k < 4; ++k) { const int b0 = (k & 1) * 8; \
            if (k < 2) { pw[k].x = cvt_pk_bf16(PC0[b0], PC0[b0 + 1]); pw[k].y = cvt_pk_bf16(PC0[b0 + 2], PC0[b0 + 3]); pw[k].z = cvt_pk_bf16(PC0[b0 + 4], PC0[b0 + 5]); pw[k].w = cvt_pk_bf16(PC0[b0 + 6], PC0[b0 + 7]); } \
            else { pw[k].x = cvt_pk_bf16(PC1[b0], PC1[b0 + 1]); pw[k].y = cvt_pk_bf16(PC1[b0 + 2], PC1[b0 + 3]); pw[k].z = cvt_pk_bf16(PC1[b0 + 4], PC1[b0 + 5]); pw[k].w = cvt_pk_bf16(PC1[b0 + 6], PC1[b0 + 7]); } } \
        _Pragma("unroll") for (int d0 = 0; d0 < 2; ++d0) { \
            const int d = 32 * d0 + r32, swz = (d >> 1) & 7; \
            const LAS unsigned char* vrow = lds + OFF_V + ((t) & 3) * VSLOT + d * 128; \
            _Pragma("unroll") for (int k = 0; k < 4; ++k) { \
                const u32x4 vw = *(const LAS u32x4*)(vrow + (((2 * k + hi) ^ swz) * 16));     \
                if (d0 == 0) o0 = __builtin_amdgcn_mfma_f32_32x32x16_bf16(__builtin_bit_cast(bf16x8, pw[k]), __builtin_bit_cast(bf16x8, vw), o0, 0, 0, 0); \
                else         o1 = __builtin_amdgcn_mfma_f32_32x32x16_bf16(__builtin_bit_cast(bf16x8, pw[k]), __builtin_bit_cast(bf16x8, vw), o1, 0, 0, 0); } } \
        _Pragma("unroll") for (int k = 0; k < 4; ++k) ol = __builtin_amdgcn_mfma_f32_32x32x16_bf16(__builtin_bit_cast(bf16x8, pw[k]), __builtin_bit_cast(bf16x8, onesw), ol, 0, 0, 0); \
    } while (0)
    AT_ISSUE(0, 0); AT_ISSUE(1, 1); AT_ISSUE(2, 2);
    asm volatile("s_waitcnt vmcnt(6)" ::: "memory");
    __builtin_amdgcn_s_barrier(); asm volatile("" ::: "memory");
    f32x16 pA0, pA1, pB0, pB1;
    AT_QK(pA0, pA1, 0);
    for (int t = 0; t < nkt; t += 2) {
        AT_STEP(pA0, pA1, pB0, pB1, t);
        AT_STEP(pB0, pB1, pA0, pA1, t + 1);
    }
#undef AT_STEP
#undef AT_QK
#undef MX3
    asm volatile("s_waitcnt lgkmcnt(0)" ::: "memory");
    __builtin_amdgcn_s_barrier(); asm volatile("" ::: "memory");
    LAS bf16_t* stg = (LAS bf16_t*)(lds + OFF_OST + wid * 4096);
#pragma unroll
    for (int r = 0; r < 16; ++r) { const int q = crow(r, hi); const float rl = __builtin_amdgcn_rcpf(ol[r]);
        stg[q * 64 + r32] = f2bf(o0[r] * rl); stg[q * 64 + 32 + r32] = f2bf(o1[r] * rl); }
    asm volatile("s_waitcnt lgkmcnt(0)" ::: "memory");
    unsigned char* Ow = O + (rowb + qrow0 + wid * 32) * 512 + h * 64;
#pragma unroll
    for (int i = 0; i < 2; ++i) { const int row = i * 16 + (lane >> 2), ch = lane & 3; const u32x4 v0 = *(const LAS u32x4*)(stg + row * 64 + ch * 16), v1 = *(const LAS u32x4*)(stg + row * 64 + ch * 16 + 8);
        u32x4 w; w.x = cvt4_fp8s(bflo(v0.x), bfhi(v0.x), bflo(v0.y), bfhi(v0.y)); w.y = cvt4_fp8s(bflo(v0.z), bfhi(v0.z), bflo(v0.w), bfhi(v0.w));
        w.z = cvt4_fp8s(bflo(v1.x), bfhi(v1.x), bflo(v1.y), bfhi(v1.y)); w.w = cvt4_fp8s(bflo(v1.z), bfhi(v1.z), bflo(v1.w), bfhi(v1.w));
        *(u32x4*)(Ow + (size_t)row * 512 + ch * 16) = w; }
    asm volatile("s_waitcnt lgkmcnt(0)" ::: "memory");
#undef AT_ISSUE
}

__device__ __forceinline__ void attn_phase(char* ws, LAS unsigned char* lds, int l, int G, int c) {
    for (int i = 0; ; ++i) {
        int bh, qb;
        if (G == 256) { if (i >= 4) break; const int x = c & 7, s = c >> 3; bh = 16 * i + 2 * x + (s >> 4); qb = s & 15; }
        else { const int L = i * G + c; if (L >= 1024) break; bh = L >> 4; qb = L & 15; }
        attn_unit(ws, lds, bh >> 3, bh & 7, CTX + qb * 256, NCHUNK);
    }
    if (l < DEPTH - 1) for (int u = c; u < 64; u += G) attn_unit(ws, lds, u >> 3, u & 7, 0, 4);
}
}
namespace gla {
constexpr int LD = 72;
constexpr int GS = 65;
constexpr int O_GT = 0, O_UG = 33792, O_WGT4 = 116736, O_B4 = O_WGT4 + 32768, O_KST = 50688, O_QG = 50688, O_KG = 59904, O_VTL = 69120, O_STL = 87552, O_AM = 105984, O_EGM = 115200, OF_LD = 132;
typedef float LAS* lfp; typedef bf16_t LAS* lbp;

struct Pre { u32x4 ug; unsigned short kk[8]; unsigned short vv[16]; };

__device__ __forceinline__ void prefetch(const char* ws, int h, size_t row0, int tid, Pre& P) {
    if (tid < 256) P.ug = *(const u32x4*)((const bf16_t*)(ws + WS_UKV) + (row0 + (tid >> 2)) * 256 + 160 + (tid & 3) * 8);
    { const int d = tid & 63, sg = tid >> 6; const bf16_t* kp = (const bf16_t*)(ws + WS_GK) + (row0 + sg * 8) * 256 + h * 64 + d;
#pragma unroll
      for (int j = 0; j < 8; ++j) P.kk[j] = kp[(size_t)j * 256]; }
    { const int e = tid & 127, sq = tid >> 7; const bf16_t* vp = (const bf16_t*)(ws + WS_GV) + (row0 + sq * 16) * 512 + h * 128 + e;
#pragma unroll
      for (int j = 0; j < 16; ++j) P.vv[j] = vp[(size_t)j * 512]; }
}
__device__ __forceinline__ void put_vt(const Pre& P, int tid, LAS unsigned char* lds) {
    lbp VTL = (lbp)(lds + O_VTL); const int e = tid & 127, sq = tid >> 7;
    u32x4 w0, w1;
    w0.x = P.vv[0] | ((unsigned)P.vv[1] << 16); w0.y = P.vv[2] | ((unsigned)P.vv[3] << 16); w0.z = P.vv[4] | ((unsigned)P.vv[5] << 16); w0.w = P.vv[6] | ((unsigned)P.vv[7] << 16);
    w1.x = P.vv[8] | ((unsigned)P.vv[9] << 16); w1.y = P.vv[10] | ((unsigned)P.vv[11] << 16); w1.z = P.vv[12] | ((unsigned)P.vv[13] << 16); w1.w = P.vv[14] | ((unsigned)P.vv[15] << 16);
    *(LAS u32x4*)(VTL + e * LD + sq * 16) = w0; *(LAS u32x4*)(VTL + e * LD + sq * 16 + 8) = w1;
}

__device__ __forceinline__ void load_gate_weights(const PTab& p, int l, LAS unsigned char* lds) {
    const int tid = ltid(); lfp W4 = (lfp)(lds + O_WGT4); lfp B4 = (lfp)(lds + O_B4);
    const float* wgf = p.w_gf(); const float* wgb = p.w_gb(); const float* bgf = p.b_gf(); const float* bgb = p.b_gb();
    { float w_[16];
#pragma unroll
      for (int j = 0; j < 16; ++j) { const int i = tid + j * 512, h = i >> 11, dir = (i >> 10) & 1, r = (i >> 6) & 15, d = i & 63; w_[j] = (dir ? wgb : wgf)[((size_t)l * 16 + r) * 256 + h * 64 + d]; }
#pragma unroll
      for (int j = 0; j < 16; ++j) W4[tid + j * 512] = w_[j]; }
    { const int h = tid >> 7, dir = (tid >> 6) & 1, d = tid & 63; B4[tid] = (dir ? bgb : bgf)[l * 256 + h * 64 + d]; }
    __syncthreads();
}
__device__ __forceinline__ void gates(int h, const Pre& P, int tid, LAS unsigned char* lds) {
    lfp GT = (lfp)(lds + O_GT); lfp UG = (lfp)(lds + O_UG); lfp WGT = (lfp)(lds + O_WGT4) + h * 2048; lfp BS = (lfp)(lds + O_B4) + h * 128;
    if (tid < 256) { const int s = tid >> 2, q = tid & 3, dir = q >> 1, r0 = (q & 1) * 8; float f[8]; unpack8(P.ug, f);
#pragma unroll
        for (int j = 0; j < 8; ++j) UG[(dir * 64 + s) * 16 + r0 + j] = f[j]; }
    __syncthreads();
    { const int d = tid & 63, sg = tid >> 6;
#pragma unroll
      for (int dir = 0; dir < 2; ++dir) {
          float w[16];
#pragma unroll
          for (int r = 0; r < 16; ++r) w[r] = WGT[(dir * 16 + r) * 64 + d];
          const float bias = BS[dir * 64 + d];
#pragma unroll
          for (int j = 0; j < 8; ++j) { const int s = sg * 8 + j; float z = bias;
#pragma unroll
              for (int r4 = 0; r4 < 4; ++r4) { const f32x4 u = *(const LAS f32x4*)(UG + (dir * 64 + s) * 16 + r4 * 4); z += u[0] * w[4 * r4] + u[1] * w[4 * r4 + 1] + u[2] * w[4 * r4 + 2] + u[3] * w[4 * r4 + 3]; }
              const float ls = fminf(z, 0.f) - __logf(1.0f + __expf(-fabsf(z)));
              GT[(dir * 64 + d) * GS + s] = ls * (1.0f / 16.0f); } } }
    __syncthreads();
    { const int lane = tid & 63, w = tid >> 6;
#pragma unroll
      for (int i = 0; i < 16; ++i) { const int r = w * 16 + i; const float v0 = GT[r * GS + lane]; float v = v0;
          v += __builtin_bit_cast(float, __builtin_amdgcn_update_dpp(0, __builtin_bit_cast(int, v), 0x111, 0xf, 0xf, true));
          v += __builtin_bit_cast(float, __builtin_amdgcn_update_dpp(0, __builtin_bit_cast(int, v), 0x112, 0xf, 0xf, true));
          v += __builtin_bit_cast(float, __builtin_amdgcn_update_dpp(0, __builtin_bit_cast(int, v), 0x114, 0xf, 0xf, true));
          v += __builtin_bit_cast(float, __builtin_amdgcn_update_dpp(0, __builtin_bit_cast(int, v), 0x118, 0xf, 0xf, true));
          v += __builtin_bit_cast(float, __builtin_amdgcn_update_dpp(0, __builtin_bit_cast(int, v), 0x142, 0xa, 0xf, false));
          v += __builtin_bit_cast(float, __builtin_amdgcn_update_dpp(0, __builtin_bit_cast(int, v), 0x143, 0xc, 0xf, false));
          if (r >= 64) { const float tot = __builtin_bit_cast(float, __builtin_amdgcn_readlane(__builtin_bit_cast(int, v), 63)); v = tot - v + v0; }
          GT[r * GS + lane] = v; } }
    __syncthreads();
}

__device__ __forceinline__ void g1_compute(char* ws, int b, int h, int blk, const Pre& P, int tid, LAS unsigned char* lds) {
    const int lane = tid & 63, wid = tid >> 6, fr = lane & 15, fq = lane >> 4;
    gates(h, P, tid, lds);
    lfp GT = (lfp)(lds + O_GT); lbp KST = (lbp)(lds + O_KST); lbp VTL = (lbp)(lds + O_VTL);
    { const int d = tid & 63, sg = tid >> 6;
#pragma unroll
      for (int dir = 0; dir < 2; ++dir) { const float gl = GT[(dir * 64 + d) * GS + (dir ? 0 : 63)]; float o[8];
#pragma unroll
          for (int j = 0; j < 8; ++j) o[j] = bf2f(P.kk[j]) * __expf(gl - GT[(dir * 64 + d) * GS + sg * 8 + j]);
          u32x4 w; w.x = cvt_pk_bf16(o[0], o[1]); w.y = cvt_pk_bf16(o[2], o[3]); w.z = cvt_pk_bf16(o[4], o[5]); w.w = cvt_pk_bf16(o[6], o[7]);
          *(LAS u32x4*)(KST + (dir * 64 + d) * LD + sg * 8) = w; } }
    put_vt(P, tid, lds);
    { const int s8 = tid >> 3, dg = tid & 7; unsigned short* gg = (unsigned short*)(ws + WS_GG) + ((size_t)b * RPB + blk * 64 + s8) * 512 + h * 64 + dg * 8;
#pragma unroll
      for (int dir = 0; dir < 2; ++dir) { f32x4 a, c4;
#pragma unroll
          for (int j = 0; j < 4; ++j) { a[j] = GT[(dir * 64 + dg * 8 + j) * GS + s8]; c4[j] = GT[(dir * 64 + dg * 8 + 4 + j) * GS + s8]; }
          u32x4 w; w.x = pk_f16(a[0], a[1]); w.y = pk_f16(a[2], a[3]); w.z = pk_f16(c4[0], c4[1]); w.w = pk_f16(c4[2], c4[3]);
          *(u32x4*)(gg + dir * 256) = w; } }
    const size_t item = ((size_t)(b * 4 + h) * 2) * NCHUNK;
    if (tid < 128) { const int dir = tid >> 6, d = tid & 63; ((float*)(ws + WS_DEC))[(item + dir * NCHUNK + blk) * 64 + d] = __expf(GT[(dir * 64 + d) * GS + (dir ? 0 : 63)]); }
    __syncthreads();
#pragma unroll
    for (int dir = 0; dir < 2; ++dir) {
        bf16_t* kv = (bf16_t*)(ws + WS_KVS) + (item + dir * NCHUNK + blk) * 8192;
#pragma unroll
        for (int db = 0; db < 4; ++db) { f32x4 acc = {0.f, 0.f, 0.f, 0.f};
#pragma unroll
            for (int ks = 0; ks < 2; ++ks) { const bf16x8 a = *(const LAS bf16x8*)(KST + (dir * 64 + db * 16 + fr) * LD + ks * 32 + 8 * fq), bb = *(const LAS bf16x8*)(VTL + (wid * 16 + fr) * LD + ks * 32 + 8 * fq);
                acc = __builtin_amdgcn_mfma_f32_16x16x32_bf16(a, bb, acc, 0, 0, 0); }
            u32x2 w; w.x = cvt_pk_bf16(acc[0], acc[1]); w.y = cvt_pk_bf16(acc[2], acc[3]);
            *(u32x2*)(kv + (wid * 16 + fr) * 64 + db * 16 + 4 * fq) = w; } }
    __syncthreads();
}

__device__ __forceinline__ void g2_item(char* ws, int ch, int sl) {
    const int tid = ltid(), e = sl * 32 + (tid >> 4), d4 = (tid & 15) * 4, dir = ch & 1;
    bf16_t* KV = (bf16_t*)(ws + WS_KVS) + (size_t)ch * NCHUNK * 8192 + e * 64 + d4; const float* DEC = (const float*)(ws + WS_DEC) + (size_t)ch * NCHUNK * 64 + d4;
    f32x4 S = {0.f, 0.f, 0.f, 0.f};
#pragma unroll 4
    for (int cp = 0; cp < NCHUNK; ++cp) { const int blk = dir ? (cp < 4 ? 3 - cp : 71 - cp) : cp;
        u32x2* ptr = (u32x2*)(KV + (size_t)blk * 8192); const u32x2 kvw = *ptr; const f32x4 dec = *(const f32x4*)(DEC + blk * 64);
        u32x2 sw; sw.x = cvt_pk_bf16(S[0], S[1]); sw.y = cvt_pk_bf16(S[2], S[3]); *ptr = sw;
        S[0] = dec[0] * S[0] + bflo(kvw.x); S[1] = dec[1] * S[1] + bfhi(kvw.x); S[2] = dec[2] * S[2] + bflo(kvw.y); S[3] = dec[3] * S[3] + bfhi(kvw.y); }
}

constexpr int O3_QG = 0, O3_KG = 18432, O3_VTL = 36864, O3_STL = 55296, O3_AM = 92160, O3_OF = 0;
struct Pre3 { unsigned short vv[16]; u32x4 qw, kw, sw[2][2], og0, og1, gg[2]; };
__device__ __forceinline__ void g3_load(const char* ws, int b, int h, int blk, int tid, Pre3& R) {
    const size_t row0 = (size_t)b * RPB + blk * 64; const size_t item = ((size_t)(b * 4 + h) * 2) * NCHUNK; const int s8 = tid >> 3, dg = tid & 7;
    { const int e = tid & 127, sq = tid >> 7; const bf16_t* vp = (const bf16_t*)(ws + WS_GV) + (row0 + sq * 16) * 512 + h * 128 + e;
#pragma unroll
      for (int j = 0; j < 16; ++j) R.vv[j] = vp[(size_t)j * 512]; }
    R.qw = *(const u32x4*)((const bf16_t*)(ws + WS_GQ) + (row0 + s8) * 256 + h * 64 + dg * 8);
    R.kw = *(const u32x4*)((const bf16_t*)(ws + WS_GK) + (row0 + s8) * 256 + h * 64 + dg * 8);
#pragma unroll
    for (int dir = 0; dir < 2; ++dir) { const bf16_t* sp = (const bf16_t*)(ws + WS_KVS) + (item + dir * NCHUNK + blk) * 8192 + (tid >> 2) * 64 + (tid & 3) * 16; R.sw[dir][0] = *(const u32x4*)sp; R.sw[dir][1] = *(const u32x4*)(sp + 8);
        const unsigned short* gp = (const unsigned short*)(ws + WS_GG) + (row0 + s8) * 512 + dir * 256 + h * 64 + dg * 8; R.gg[dir] = *(const u32x4*)gp; }
    const bf16_t* ogp = (const bf16_t*)(ws + WS_GOG) + (row0 + s8) * 512 + h * 128 + dg * 16;
    R.og0 = *(const u32x4*)ogp; R.og1 = *(const u32x4*)(ogp + 8);
}
__device__ __forceinline__ void g3_compute(char* ws, const LAS float* norm_g, int b, int h, int blk, const Pre3& R, int tid, LAS unsigned char* lds) {
    const int lane = tid & 63, wid = tid >> 6, fr = lane & 15, fq = lane >> 4, s8 = tid >> 3, dg = tid & 7;
    const size_t row0 = (size_t)b * RPB + blk * 64;
    lbp QG = (lbp)(lds + O3_QG); lbp KG = (lbp)(lds + O3_KG); lbp VTL = (lbp)(lds + O3_VTL); lbp STL = (lbp)(lds + O3_STL); lbp AM = (lbp)(lds + O3_AM);
    { const int e = tid & 127, sq = tid >> 7; u32x4 w0, w1;
      w0.x = R.vv[0] | ((unsigned)R.vv[1] << 16); w0.y = R.vv[2] | ((unsigned)R.vv[3] << 16); w0.z = R.vv[4] | ((unsigned)R.vv[5] << 16); w0.w = R.vv[6] | ((unsigned)R.vv[7] << 16);
      w1.x = R.vv[8] | ((unsigned)R.vv[9] << 16); w1.y = R.vv[10] | ((unsigned)R.vv[11] << 16); w1.z = R.vv[12] | ((unsigned)R.vv[13] << 16); w1.w = R.vv[14] | ((unsigned)R.vv[15] << 16);
      *(LAS u32x4*)(VTL + e * LD + sq * 16) = w0; *(LAS u32x4*)(VTL + e * LD + sq * 16 + 8) = w1; }
    { float qf[8], kf[8]; unpack8(R.qw, qf); unpack8(R.kw, kf);
#pragma unroll
      for (int dir = 0; dir < 2; ++dir) { float qo[8], ko[8];
          float gf[8]; un_f16(R.gg[dir].x, gf[0], gf[1]); un_f16(R.gg[dir].y, gf[2], gf[3]); un_f16(R.gg[dir].z, gf[4], gf[5]); un_f16(R.gg[dir].w, gf[6], gf[7]);
#pragma unroll
          for (int j = 0; j < 8; ++j) { const float g = gf[j]; qo[j] = qf[j] * __expf(g); ko[j] = kf[j] * __expf(-g); }
          u32x4 w; w.x = cvt_pk_bf16(qo[0], qo[1]); w.y = cvt_pk_bf16(qo[2], qo[3]); w.z = cvt_pk_bf16(qo[4], qo[5]); w.w = cvt_pk_bf16(qo[6], qo[7]); *(LAS u32x4*)(QG + (dir * 64 + s8) * LD + dg * 8) = w;
          w.x = cvt_pk_bf16(ko[0], ko[1]); w.y = cvt_pk_bf16(ko[2], ko[3]); w.z = cvt_pk_bf16(ko[4], ko[5]); w.w = cvt_pk_bf16(ko[6], ko[7]); *(LAS u32x4*)(KG + (dir * 64 + s8) * LD + dg * 8) = w;
          const int e = tid >> 2, dq = tid & 3;
          *(LAS u32x4*)(STL + (dir * 128 + e) * LD + dq * 16) = R.sw[dir][0]; *(LAS u32x4*)(STL + (dir * 128 + e) * LD + dq * 16 + 8) = R.sw[dir][1]; } }
    __syncthreads();
#pragma unroll
    for (int dir = 0; dir < 2; ++dir) { const int tb = wid >> 1;
#pragma unroll
        for (int q = 0; q < 2; ++q) { const int sb = (wid & 1) * 2 + q; f32x4 a4 = {0.f, 0.f, 0.f, 0.f};
            const bool live = dir ? (sb >= tb) : (sb <= tb);
            if (live) {
#pragma unroll
                for (int ks = 0; ks < 2; ++ks) { const bf16x8 a = *(const LAS bf16x8*)(KG + (dir * 64 + sb * 16 + fr) * LD + ks * 32 + 8 * fq), bb = *(const LAS bf16x8*)(QG + (dir * 64 + tb * 16 + fr) * LD + ks * 32 + 8 * fq);
                    a4 = __builtin_amdgcn_mfma_f32_16x16x32_bf16(a, bb, a4, 0, 0, 0); } }
            const int t = tb * 16 + fr, s0 = sb * 16 + 4 * fq;
#pragma unroll
            for (int j = 0; j < 4; ++j) { const int s = s0 + j; const bool keep = dir ? (s >= t) : (s <= t); if (!keep) a4[j] = 0.f; }
            u32x2 w; w.x = cvt_pk_bf16(a4[0], a4[1]); w.y = cvt_pk_bf16(a4[2], a4[3]); *(LAS u32x2*)(AM + (dir * 64 + t) * LD + s0) = w; } }
    __syncthreads();
    f32x4 acc[4];
#pragma unroll
    for (int i = 0; i < 4; ++i) acc[i] = (f32x4){0.f, 0.f, 0.f, 0.f};
#pragma unroll
    for (int dir = 0; dir < 2; ++dir)
#pragma unroll
        for (int tb = 0; tb < 4; ++tb) {
#pragma unroll
            for (int ks = 0; ks < 2; ++ks) { const bf16x8 a = *(const LAS bf16x8*)(VTL + (wid * 16 + fr) * LD + ks * 32 + 8 * fq), bb = *(const LAS bf16x8*)(AM + (dir * 64 + tb * 16 + fr) * LD + ks * 32 + 8 * fq);
                acc[tb] = __builtin_amdgcn_mfma_f32_16x16x32_bf16(a, bb, acc[tb], 0, 0, 0); }
#pragma unroll
            for (int ks = 0; ks < 2; ++ks) { const bf16x8 a = *(const LAS bf16x8*)(STL + (dir * 128 + wid * 16 + fr) * LD + ks * 32 + 8 * fq), bb = *(const LAS bf16x8*)(QG + (dir * 64 + tb * 16 + fr) * LD + ks * 32 + 8 * fq);
                acc[tb] = __builtin_amdgcn_mfma_f32_16x16x32_bf16(a, bb, acc[tb], 0, 0, 0); } }
    __syncthreads();
    lfp OF = (lfp)(lds + O3_OF);
#pragma unroll
    for (int tb = 0; tb < 4; ++tb) *(LAS f32x4*)(OF + (tb * 16 + fr) * OF_LD + wid * 16 + 4 * fq) = acc[tb];
    __syncthreads();
    { const int t = s8, part = dg; float o[16]; float ss = 0.f;
#pragma unroll
      for (int j = 0; j < 4; ++j) { const f32x4 v = *(const LAS f32x4*)(OF + t * OF_LD + part * 16 + j * 4); o[4 * j] = v[0]; o[4 * j + 1] = v[1]; o[4 * j + 2] = v[2]; o[4 * j + 3] = v[3]; ss += v[0] * v[0] + v[1] * v[1] + v[2] * v[2] + v[3] * v[3]; }
      ss += lane_xor<1>(ss, 0); ss += lane_xor<2>(ss, 0); ss += lane_xor<4>(ss, 0);
      const float rs = rsqrtf(ss * (1.0f / 128.0f) + EPS);
      const LAS float* ng = norm_g + h * 128 + part * 16;
      unsigned char* dst = (unsigned char*)(ws + WS_OGLA) + (row0 + t) * 512 + h * 128 + part * 16;
#pragma unroll
      for (int hh = 0; hh < 2; ++hh) { float g[8]; unpack8(hh ? R.og1 : R.og0, g); float r[8];
#pragma unroll
          for (int j = 0; j < 8; ++j) r[j] = o[hh * 8 + j] * rs * ng[hh * 8 + j] * siluf_(g[j]);
          u32x2 w; w.x = cvt4_fp8s(r[0], r[1], r[2], r[3]); w.y = cvt4_fp8s(r[4], r[5], r[6], r[7]); *(u32x2*)(dst + hh * 8) = w; } }
    __syncthreads();
}

__device__ __forceinline__ void g1_phase(const PTab& p, int l, LAS unsigned char* lds, int G, int c) {
    char* ws = p.ws(); const int tid = ltid(); constexpr int NIT = NB * 4 * NCHUNK;
    load_gate_weights(p, l, lds);
    int it = c; if (it >= NIT) return;
    Pre cur; prefetch(ws, (it / NCHUNK) & 3, (size_t)(it / (4 * NCHUNK)) * RPB + (it % NCHUNK) * 64, tid, cur);
    for (;;) { const int nx = it + G; Pre nxt = cur;
        if (nx < NIT) prefetch(ws, (nx / NCHUNK) & 3, (size_t)(nx / (4 * NCHUNK)) * RPB + (nx % NCHUNK) * 64, tid, nxt);
        g1_compute(ws, it / (4 * NCHUNK), (it / NCHUNK) & 3, it % NCHUNK, cur, tid, lds);
        if (nx >= NIT) break; cur = nxt; it = nx; }
}
__device__ __forceinline__ void g3_phase(const PTab& p, int l, LAS unsigned char* lds, int G, int c) {
    char* ws = p.ws(); const int tid = ltid(); LAS float* ng = (LAS float*)(lds + LDS_AUX + 8192);
    if (tid < 128) *(LAS f32x4*)(ng + tid * 4) = *(const f32x4*)(p.gla_norm_g() + l * 512 + tid * 4);
    __syncthreads();
    const int nblk = (l == DEPTH - 1) ? 64 : NCHUNK, blk0 = NCHUNK - nblk, NIT = NB * 4 * nblk;
    int it = c; if (it >= NIT) return;
    Pre3 cur; g3_load(ws, it / (4 * nblk), (it / nblk) & 3, blk0 + it % nblk, tid, cur);
    for (;;) { const int nx = it + G; Pre3 nxt = cur;
        if (nx < NIT) g3_load(ws, nx / (4 * nblk), (nx / nblk) & 3, blk0 + nx % nblk, tid, nxt);
        g3_compute(ws, ng, it / (4 * nblk), (it / nblk) & 3, blk0 + it % nblk, cur, tid, lds);
        if (nx >= NIT) break; cur = nxt; it = nx; }
}
}
namespace moe {
constexpr int A_LG = LDS_AUX + 1024, A_HIST = LDS_AUX + 5120, A_BASE = LDS_AUX + 5248, A_TB = LDS_AUX + 5376, A_CN = LDS_AUX + 5632, A_RANK = LDS_AUX + 6144;
constexpr int RWS = 1028;
__device__ __forceinline__ int n_act_rows(int l) { return (l < DEPTH - 1) ? T : NB * SEQ; }
__device__ __forceinline__ int act_row(int l, int r) { return (l < DEPTH - 1) ? r : (r >> 12) * RPB + CTX + (r & 4095); }

__device__ __forceinline__ void tables(char* ws, int l, LAS unsigned char* lds) {
    LAS int* tb = (LAS int*)(lds + A_TB); LAS int* cn = (LAS int*)(lds + A_CN); const int t = ltid();
    if (t < 32) { const int n = (int)__hip_atomic_load((unsigned*)(ws + WS_CTL + CTL_CNT) + l * 32 + t, __ATOMIC_RELAXED, __HIP_MEMORY_SCOPE_AGENT); cn[t] = n; cn[32 + t] = (n + 255) >> 8; }
    __syncthreads();
    if (t <= 32) { int run = 0; for (int e = 0; e < t; ++e) run += cn[32 + e]; tb[t] = run; }
    __syncthreads();
}

__device__ __forceinline__ void route_phase(const PTab& p, int l, LAS unsigned char* lds, int G, int c, int dry = 0) {
    const int tid = ltid(), lane = tid & 63, wid = tid >> 6; char* ws = p.ws();
    LAS float* RW = (LAS float*)lds;
    LAS float* LG = (LAS float*)(lds + A_LG) + wid * 32; LAS int* hist = (LAS int*)(lds + A_HIST); LAS int* base = (LAS int*)(lds + A_BASE); LAS int* rank = (LAS int*)(lds + A_RANK);
    { const float* rw = p.router_w() + (size_t)l * 1024 * 32;
#pragma unroll 1
      for (int i0 = tid; i0 < 32768; i0 += 512 * 16) { float w_[16];
#pragma unroll
          for (int j = 0; j < 16; ++j) w_[j] = rw[i0 + j * 512];
#pragma unroll
          for (int j = 0; j < 16; ++j) { const int i = i0 + j * 512, k = i >> 5, e = i & 31; RW[e * RWS + k] = w_[j]; } } }
    if (tid < 32) hist[tid] = 0;
    __syncthreads();
    const int nact = n_act_rows(l), chunk = (nact + G - 1) / G, r0 = c * chunk, r1 = (r0 + chunk < nact) ? r0 + chunk : nact;
    const bf16_t* X = (const bf16_t*)(ws + WS_X); unsigned char* H8 = (unsigned char*)(ws + WS_H8);
    const float* M = (const float*)(ws + WS_MOD) + (size_t)l * 9 * 6144; const float* g2n = p.norm2_g() + l * D; const float* rb = p.router_b() + l * 32;
    for (int rb0 = r0 + wid; rb0 < r1; rb0 += 32) {
        f32x4 hv[4][4]; int rows[4]; bool ok[4];
#pragma unroll
        for (int q = 0; q < 4; ++q) { const int r = rb0 + 8 * q; ok[q] = r < r1; rows[q] = act_row(l, ok[q] ? r : rb0); const bf16_t* xr = X + (size_t)rows[q] * D;
#pragma unroll
            for (int i = 0; i < 4; ++i) { const u32x2 w = *(const u32x2*)(xr + i * 256 + lane * 4); hv[q][i] = (f32x4){bflo(w.x), bfhi(w.x), bflo(w.y), bfhi(w.y)}; } }
#pragma unroll
        for (int q = 0; q < 4; ++q) { const int row = rows[q], b = row / RPB, s = (row % RPB) < CTX ? 8 : b; const float* sh = M + s * 6144 + 3072; const float* sc = M + s * 6144 + 4096;
            float ss = 0.f;
#pragma unroll
            for (int i = 0; i < 4; ++i) ss += hv[q][i][0] * hv[q][i][0] + hv[q][i][1] * hv[q][i][1] + hv[q][i][2] * hv[q][i][2] + hv[q][i][3] * hv[q][i][3];
            ss = wave_sum(ss);
            const float rs = rsqrtf(ss * (1.0f / 1024.0f) + EPS);
#pragma unroll
            for (int i = 0; i < 4; ++i) { const int col = i * 256 + lane * 4; const f32x4 gg = *(const f32x4*)(g2n + col), sv = *(const f32x4*)(sh + col), cv = *(const f32x4*)(sc + col);
#pragma unroll
                for (int j = 0; j < 4; ++j) hv[q][i][j] = hv[q][i][j] * rs * gg[j] * (1.0f + cv[j]) + sv[j];
                if (!dry && ok[q]) *(unsigned*)(H8 + (size_t)row * D + col) = cvt4_fp8s(hv[q][i][0], hv[q][i][1], hv[q][i][2], hv[q][i][3]); } }
#pragma unroll 1
        for (int ec = 0; ec < 4; ++ec) {
            float a[4][8];
#pragma unroll
            for (int q = 0; q < 4; ++q)
#pragma unroll
                for (int e = 0; e < 8; ++e) a[q][e] = 0.f;
#pragma unroll
            for (int e = 0; e < 8; ++e)
#pragma unroll
                for (int i = 0; i < 4; ++i) { const f32x4 w = *(const LAS f32x4*)(RW + (ec * 8 + e) * RWS + i * 256 + lane * 4);
#pragma unroll
                    for (int q = 0; q < 4; ++q) a[q][e] += hv[q][i][0] * w[0] + hv[q][i][1] * w[1] + hv[q][i][2] * w[2] + hv[q][i][3] * w[3]; }
            const bool b5 = lane & 32, b4 = lane & 16, b3 = lane & 8;
#pragma unroll
            for (int q = 0; q < 4; ++q) {
#pragma unroll
                for (int i = 0; i < 4; ++i) { const float keep = b5 ? a[q][i + 4] : a[q][i], send = b5 ? a[q][i] : a[q][i + 4]; a[q][i] = keep + lane_xor<32>(send, lane); }
#pragma unroll
                for (int i = 0; i < 2; ++i) { const float keep = b4 ? a[q][i + 2] : a[q][i], send = b4 ? a[q][i] : a[q][i + 2]; a[q][i] = keep + lane_xor<16>(send, lane); }
                { const float keep = b3 ? a[q][1] : a[q][0], send = b3 ? a[q][0] : a[q][1]; a[q][0] = keep + lane_xor<8>(send, lane); }
                a[q][0] += lane_xor<4>(a[q][0], lane); a[q][0] += lane_xor<2>(a[q][0], lane); a[q][0] += lane_xor<1>(a[q][0], lane);
                const int e = ec * 8 + ((lane >> 5) & 1) * 4 + ((lane >> 4) & 1) * 2 + ((lane >> 3) & 1);
                if ((lane & 7) == 0) (LG + q * 256)[e] = a[q][0] + rb[e]; }
        }
        asm volatile("s_waitcnt lgkmcnt(0)" ::: "memory");
        {
            const int q = lane >> 4, sub = lane & 15;
            unsigned k0, k1;
            { const float l0 = (LG + q * 256)[sub], l1 = (LG + q * 256)[sub + 16];
              unsigned u0 = __float_as_uint(l0), u1 = __float_as_uint(l1);
              u0 = (u0 & 0x80000000u) ? ~u0 : (u0 | 0x80000000u); u1 = (u1 & 0x80000000u) ? ~u1 : (u1 | 0x80000000u);
              k0 = (u0 & ~31u) | (unsigned)(31 - sub); k1 = (u1 & ~31u) | (unsigned)(15 - sub); }
            float tv[4]; int ti[4];
#pragma unroll
            for (int k = 0; k < 4; ++k) { unsigned mx = k0 > k1 ? k0 : k1;
                { const unsigned o = (unsigned)__builtin_amdgcn_update_dpp(0, (int)mx, 0xB1, 0xf, 0xf, true); mx = o > mx ? o : mx; }
                { const unsigned o = (unsigned)__builtin_amdgcn_update_dpp(0, (int)mx, 0x4E, 0xf, 0xf, true); mx = o > mx ? o : mx; }
                { const unsigned o = (unsigned)__builtin_amdgcn_update_dpp(0, (int)mx, 0x141, 0xf, 0xf, true); mx = o > mx ? o : mx; }
                { const unsigned o = (unsigned)__builtin_amdgcn_update_dpp(0, (int)mx, 0x140, 0xf, 0xf, true); mx = o > mx ? o : mx; }
                k0 = (k0 == mx) ? 0u : k0; k1 = (k1 == mx) ? 0u : k1;
                ti[k] = 31 - (int)(mx & 31u); const unsigned u = mx & ~31u; tv[k] = __uint_as_float((u & 0x80000000u) ? (u & 0x7fffffffu) : ~u); }
            const float e1 = __expf(tv[1] - tv[0]), e2 = __expf(tv[2] - tv[0]), e3 = __expf(tv[3] - tv[0]), inv = 1.0f / (1.0f + e1 + e2 + e3);
            const int r = rb0 + 8 * q;
            if (sub < 4 && !dry && r < r1) { const int row = act_row(l, r); const int ek = sub == 0 ? ti[0] : sub == 1 ? ti[1] : sub == 2 ? ti[2] : ti[3]; const float gk = (sub == 0 ? 1.0f : sub == 1 ? e1 : sub == 2 ? e2 : e3) * inv;
                ((int*)(ws + WS_TOPI))[(size_t)row * 4 + sub] = ek; ((float*)(ws + WS_TOPG))[(size_t)row * 4 + sub] = gk;
                const int rk = atomicAdd((int*)(hist + ek), 1);
                rank[(r - r0) * 4 + sub] = rk | (ek << 24); }
        }
        asm volatile("s_waitcnt lgkmcnt(0)" ::: "memory");
    }
    __syncthreads();
    if (dry) return;
    if (tid < 32) base[tid] = (int)__hip_atomic_fetch_add((unsigned*)(ws + WS_CTL + CTL_CNT) + l * 32 + tid, (unsigned)hist[tid], __ATOMIC_RELAXED, __HIP_MEMORY_SCOPE_AGENT);
    __syncthreads();
    for (int i = tid; i < (r1 - r0) * 4; i += 512) { const int v = rank[i], e = v >> 24, rk = v & 0xffffff, row = act_row(l, r0 + (i >> 2)), pos = base[e] + rk;
        ((int*)(ws + WS_TOPP))[(size_t)row * 4 + (i & 3)] = pos; ((int*)(ws + WS_RT2))[(size_t)e * T + pos] = row; }
    __syncthreads();
}

__device__ __forceinline__ void permute_phase(const PTab& p, int l, LAS unsigned char* lds, int G, int c) {
    const int tid_ = ltid(), lane = tid_ & 63, wid = tid_ >> 6; char* ws = p.ws();
    tables(ws, l, lds);
    const LAS int* tb = (const LAS int*)(lds + A_TB); const LAS int* cn = (const LAS int*)(lds + A_CN);
    const bf16_t* H = (const bf16_t*)(ws + WS_H); bf16_t* HS = (bf16_t*)(ws + WS_HS);
    const int nact = n_act_rows(l);
    for (int r = c * 8 + wid; r < nact; r += G * 8) { const int row = act_row(l, r);
        const u32x4 a = *(const u32x4*)(H + (size_t)row * D + lane * 16), b = *(const u32x4*)(H + (size_t)row * D + lane * 16 + 8);
        const int* ti = (const int*)(ws + WS_TOPI) + (size_t)row * 4; const int* tp = (const int*)(ws + WS_TOPP) + (size_t)row * 4;
#pragma unroll
        for (int k = 0; k < 4; ++k) { const int e = ti[k], pos = tp[k]; bf16_t* d = HS + ((size_t)tb[e] * 256 + pos) * D + lane * 16; *(u32x4*)d = a; *(u32x4*)(d + 8) = b; } }
    for (int e = 0; e < NE; ++e) { const int n = cn[e], end = ((n + 255) >> 8) << 8;
        for (int pr = n + c * 8 + wid; pr < end; pr += G * 8) { bf16_t* d = HS + ((size_t)tb[e] * 256 + pr) * D + lane * 16; const u32x4 z = {0u, 0u, 0u, 0u}; *(u32x4*)d = z; *(u32x4*)(d + 8) = z; } }
}

__device__ __forceinline__ void combine_phase(const PTab& p, int l, LAS unsigned char* lds, int G, int c, int dry = 0) {
    const int tid_ = ltid(), lane = tid_ & 63, wid = tid_ >> 6; char* ws = p.ws();
    tables(ws, l, lds);
    const LAS int* tb = (const LAS int*)(lds + A_TB);
    bf16_t* X = (bf16_t*)(ws + WS_X); bf16_t* H = (bf16_t*)(ws + WS_H); const unsigned char* YM = (const unsigned char*)(ws + WS_YM);
    const float* M = (const float*)(ws + WS_MOD) + (size_t)l * 9 * 6144; const float* Mn = M + 9 * 6144;
    const int nact = n_act_rows(l); const float* n1g = p.norm1_g(); const float* fing = p.final_g(); float* outp = p.out();
    LAS float* g2s = (LAS float*)lds; LAS float* shs = g2s + 9 * 1024; LAS float* scs = shs + 9 * 1024; LAS float* gns = scs + 9 * 1024;
#pragma unroll
    for (int i = tid_; i < 9 * 256; i += 512) { const int s_ = i >> 8, q4 = (i & 255) * 4;
        *(LAS f32x4*)(g2s + s_ * 1024 + q4) = *(const f32x4*)(M + s_ * 6144 + 5120 + q4);
        if (l < DEPTH - 1) { *(LAS f32x4*)(shs + s_ * 1024 + q4) = *(const f32x4*)(Mn + s_ * 6144 + q4); *(LAS f32x4*)(scs + s_ * 1024 + q4) = *(const f32x4*)(Mn + s_ * 6144 + 1024 + q4); } }
    if (tid_ < 256) *(LAS f32x4*)(gns + tid_ * 4) = *(const f32x4*)(((l < DEPTH - 1) ? n1g + (l + 1) * D : fing) + tid_ * 4);
    __syncthreads();
    int r = c * 8 + wid; const int st = G * 8;
    typedef int i32x4 __attribute__((ext_vector_type(4)));
    i32x4 ti1 = {0, 0, 0, 0}, tp1 = {0, 0, 0, 0}; f32x4 tg0 = {0.f, 0.f, 0.f, 0.f}, tg1 = {0.f, 0.f, 0.f, 0.f};
    unsigned yw[4][4]; u32x2 xw[4];
#define CB_LOADT(rr, TI, TP, TG) do { if ((rr) < nact) { const int ro_ = act_row(l, (rr)); TI = *(const i32x4*)((const int*)(ws + WS_TOPI) + (size_t)ro_ * 4); TP = *(const i32x4*)((const int*)(ws + WS_TOPP) + (size_t)ro_ * 4); TG = *(const f32x4*)((const float*)(ws + WS_TOPG) + (size_t)ro_ * 4); } } while (0)
#define CB_LOADD(rr, TI, TP, YW, XW) do { if ((rr) < nact) { const int ro_ = act_row(l, (rr)); \
        _Pragma("unroll") for (int k = 0; k < 4; ++k) { const int e = TI[k], pos = TP[k]; const unsigned char* y = YM + ((size_t)tb[e] * 256 + pos) * D + lane * 4; \
            _Pragma("unroll") for (int i = 0; i < 4; ++i) YW[k][i] = *(const unsigned*)(y + i * 256); } \
        _Pragma("unroll") for (int i = 0; i < 4; ++i) XW[i] = *(const u32x2*)(X + (size_t)ro_ * D + i * 256 + lane * 4); } } while (0)
    { i32x4 ti0 = {0, 0, 0, 0}, tp0 = {0, 0, 0, 0};
      CB_LOADT(r, ti0, tp0, tg0); CB_LOADT(r + st, ti1, tp1, tg1);
      CB_LOADD(r, ti0, tp0, yw, xw); }
    for (; r < nact; r += st) { const int row = act_row(l, r), b = row / RPB, s = (row % RPB) < CTX ? 8 : b;
        i32x4 ti2 = {0, 0, 0, 0}, tp2 = {0, 0, 0, 0}; f32x4 tg2 = {0.f, 0.f, 0.f, 0.f}; unsigned ywn[4][4]; u32x2 xwn[4];
        CB_LOADT(r + 2 * st, ti2, tp2, tg2);
        CB_LOADD(r + st, ti1, tp1, ywn, xwn);
        f32x4 acc[4];
#pragma unroll
        for (int i = 0; i < 4; ++i) acc[i] = (f32x4){0.f, 0.f, 0.f, 0.f};
#pragma unroll
        for (int k = 0; k < 4; ++k) { const float gk = tg0[k] * (1.0f / YM_SCALE);
#pragma unroll
            for (int i = 0; i < 4; ++i) { float a0, a1, a2, a3; cvt_fp8x4(yw[k][i], a0, a1, a2, a3); acc[i][0] += gk * a0; acc[i][1] += gk * a1; acc[i][2] += gk * a2; acc[i][3] += gk * a3; } }
        u32x2 xwc[4];
#pragma unroll
        for (int i = 0; i < 4; ++i) xwc[i] = xw[i];
        tg0 = tg1; ti1 = ti2; tp1 = tp2; tg1 = tg2;
#pragma unroll
        for (int k = 0; k < 4; ++k)
#pragma unroll
            for (int i = 0; i < 4; ++i) yw[k][i] = ywn[k][i];
#pragma unroll
        for (int i = 0; i < 4; ++i) xw[i] = xwn[i];
        bf16_t* xrow = X + (size_t)row * D; const LAS float* g2 = g2s + s * 1024; f32x4 xv[4]; float ss = 0.f;
#pragma unroll
        for (int i = 0; i < 4; ++i) { const int col = i * 256 + lane * 4; { const u32x2 xw_ = xwc[i]; xv[i] = (f32x4){bflo(xw_.x), bfhi(xw_.x), bflo(xw_.y), bfhi(xw_.y)} + *(const LAS f32x4*)(g2 + col) * acc[i]; } if (!dry && l < DEPTH - 1) { u32x2 ow; ow.x = cvt_pk_bf16(xv[i][0], xv[i][1]); ow.y = cvt_pk_bf16(xv[i][2], xv[i][3]); *(u32x2*)(xrow + col) = ow; }
            ss += xv[i][0] * xv[i][0] + xv[i][1] * xv[i][1] + xv[i][2] * xv[i][2] + xv[i][3] * xv[i][3]; }
        ss = wave_sum(ss);
        const float rs = rsqrtf(ss * (1.0f / 1024.0f) + EPS);
        if (l < DEPTH - 1) { const LAS float* gn = gns; const LAS float* sh = shs + s * 1024; const LAS float* sc = scs + s * 1024;
#pragma unroll
            for (int i = 0; i < 4; ++i) { const int col = i * 256 + lane * 4; const f32x4 gg = *(const LAS f32x4*)(gn + col), sv = *(const LAS f32x4*)(sh + col), cv = *(const LAS f32x4*)(sc + col); float o[4];
#pragma unroll
                for (int j = 0; j < 4; ++j) o[j] = xv[i][j] * rs * gg[j] * (1.0f + cv[j]) + sv[j];
                u32x2 w; w.x = cvt_pk_bf16(o[0], o[1]); w.y = cvt_pk_bf16(o[2], o[3]); if (!dry) { *(u32x2*)(H + (size_t)row * D + col) = w; *(unsigned*)((unsigned char*)(ws + WS_HA8) + (size_t)row * D + col) = cvt4_fp8s(o[0], o[1], o[2], o[3]); } else asm volatile("" :: "v"(w)); } }
        else { float* orow = outp + (size_t)r * D;
#pragma unroll
            for (int i = 0; i < 4; ++i) { const int col = i * 256 + lane * 4; const f32x4 gg = *(const LAS f32x4*)(gns + col); { const f32x4 ov = xv[i] * rs * gg; if (!dry) *(f32x4*)(orow + col) = ov; else asm volatile("" :: "v"(ov)); } } }
    }
}
#undef CB_LOADT
#undef CB_LOADD
__device__ __forceinline__ void krope_job(char* ws, int G, int c) {
    const bf16_t* U = (const bf16_t*)(ws + WS_UKV); bf16_t* KR = (bf16_t*)(ws + WS_KR); const f32x2* rope = (const f32x2*)(ws + WS_ROPE);
    for (int i = c * 512 + ltid(); i < T * 16; i += G * 512) { const int row = i >> 4, pr = i & 15, axis = pr >> 3, f = pr & 7, tl = (row % RPB) - CTX;
        const float x1 = bf2f(U[(size_t)row * 256 + 128 + axis * 16 + f]), x2 = bf2f(U[(size_t)row * 256 + 128 + axis * 16 + 8 + f]); float o1 = x1, o2 = x2;
        if (tl >= 0) { const int pos = axis ? (tl & 63) : (tl >> 6); const f32x2 cs = rope[pos * 8 + f]; o1 = x1 * cs.x - x2 * cs.y; o2 = x2 * cs.x + x1 * cs.y; }
        *(unsigned*)(KR + (size_t)row * 32 + axis * 16 + 2 * f) = cvt_pk_bf16(o1, o2); }
}
}
constexpr int N_PHASES = 2 + 10 * DEPTH;
#ifndef MK_PER_PHASE
#define MK_PER_PHASE 0
#endif

__global__ void __launch_bounds__(512, 2) mega(Params p, int ph_lo, int ph_hi) {
    extern __shared__ __attribute__((aligned(16))) unsigned char smem_raw[];
    LAS unsigned char* lds0 = (LAS unsigned char*)smem_raw; LAS unsigned char* lds = lds0;
    const int G0 = (int)gridDim.x, c0 = (int)blockIdx.x;
    volatile LAS unsigned* st = (volatile LAS unsigned*)(lds + LDS_BYTES - 16);
    if (threadIdx.x == 0) { st[0] = 0u; st[1] = 0u; st[2] = 0u; st[3] = 0u;
        LAS unsigned long long* t = (LAS unsigned long long*)(lds + LDS_PTAB);
        t[0] = (unsigned long long)p.x; t[1] = (unsigned long long)p.c; t[2] = (unsigned long long)p.ctx; t[3] = (unsigned long long)p.c_ctx; t[4] = (unsigned long long)p.w_mod; t[5] = (unsigned long long)p.b_mod;
        t[6] = (unsigned long long)p.norm1_g; t[7] = (unsigned long long)p.w_in; t[8] = (unsigned long long)p.q_norm_g; t[9] = (unsigned long long)p.w_uq; t[10] = (unsigned long long)p.kv_norm_g; t[11] = (unsigned long long)p.w_ukv;
        t[12] = (unsigned long long)p.w_gf; t[13] = (unsigned long long)p.b_gf; t[14] = (unsigned long long)p.w_gb; t[15] = (unsigned long long)p.b_gb; t[16] = (unsigned long long)p.gla_norm_g; t[17] = (unsigned long long)p.w_br_mla;
        t[18] = (unsigned long long)p.w_br_fnet; t[19] = (unsigned long long)p.w_br_gla; t[20] = (unsigned long long)p.w_o; t[21] = (unsigned long long)p.norm2_g; t[22] = (unsigned long long)p.router_w; t[23] = (unsigned long long)p.router_b;
        t[24] = (unsigned long long)p.w_up; t[25] = (unsigned long long)p.b_up; t[26] = (unsigned long long)p.w_down; t[27] = (unsigned long long)p.b_down; t[28] = (unsigned long long)p.final_g; t[29] = (unsigned long long)p.out; t[30] = (unsigned long long)p.ws; }
    __syncthreads();
    const PTab pt{(const LAS unsigned long long*)(lds + LDS_PTAB)};
    XcdBarrier bar = xcd_barrier_post((unsigned*)(pt.ws() + WS_CTL), st);
#define WS_GET() const int G = lsgpr(G0), c = lsgpr(c0); LAS unsigned char* lds = lds_launder(lds0); const PTab pt{(const LAS unsigned long long*)(lds + LDS_PTAB)}; char* ws = pt.ws(); const char* wl = ws + WS_W + (size_t)l * WL_BYTES; (void)wl
#ifndef PH_REPEAT
#define PH_REPEAT 0
#endif
#define DRYV(rep_) (PH_REPEAT ? lsgpr((rep_) ? 1 : 0) : 0)
#ifndef PH_SKIPEPI
#define PH_SKIPEPI 0
#endif
#ifndef STAGGER_TICKS
#define STAGGER_TICKS 0
#endif
#define STAGGER(c) do { if (STAGGER_TICKS) { const unsigned long long t0_ = __builtin_amdgcn_s_memrealtime(); const unsigned long long d_ = (unsigned long long)(((c) >> 3) & 7) * STAGGER_TICKS; while (__builtin_amdgcn_s_memrealtime() - t0_ < d_) __builtin_amdgcn_s_sleep(8); } } while (0)
#ifndef PH_MASK
#define PH_MASK 0x1fff
#endif
#if MK_PER_PHASE || defined(DBG_STOP)
#define PH_ON(n) (ph_lo <= (n) && (n) < ph_hi)
#define PH_END(n) do { if ((n) + 1 < ph_hi) grid_sync(bar); } while (0)
#else
#define PH_ON(n) true
#ifdef DBL_BAR
#define PH_END(n) do { if ((n) + 1 < N_PHASES) { grid_sync(bar); grid_sync(bar); } } while (0)
#else
#define PH_END(n) do { if ((n) + 1 < N_PHASES) grid_sync(bar); } while (0)
#endif
#endif
#define PHC(k) ((PH_MASK >> (k)) & 1)
    if (PHC(0) && PH_ON(0)) { prologue_phase(pt, lds, G0, c0); __syncthreads(); if (PH_REPEAT & 1) { grid_sync(bar); prologue_phase(pt, lds, lsgpr(G0), lsgpr(c0)); __syncthreads(); } PH_END(0); }
    if (PHC(1) && PH_ON(1)) { norm1_phase(pt, 0, G0, c0); PH_END(1); }
#pragma unroll 1
    for (int l = 0; l < DEPTH; ++l) {
        const int pb = 2 + 10 * l;
        if (PHC(2) && PH_ON(pb + 0)) { { constexpr bool rep_ = false; (void)rep_; WS_GET(); { G1Sched8 S{ws + WS_HA8, wl + WL_WIN8, G, c}; G1EpiAB E{G1EpiA{ws}, G1EpiB{ws}}; gk::gemm_phase(lds, S, E); } { G1Sched S{ws + WS_H, wl + WL_WIN, G, (c + 128) % G}; G1EpiA E{ws}; gk::gemm_phase(lds, S, E); } }
            if ((PH_REPEAT >> 2) & 1) { grid_sync(bar); { constexpr bool rep_ = true; (void)rep_; WS_GET(); { G1Sched8 S{ws + WS_HA8, wl + WL_WIN8, G, c}; G1EpiAB E{G1EpiA{ws}, G1EpiB{ws}}; gk::gemm_phase(lds, S, E); } { G1Sched S{ws + WS_H, wl + WL_WIN, G, (c + 128) % G}; G1EpiA E{ws}; gk::gemm_phase(lds, S, E); } } }
            PH_END(pb + 0); }
        if (PHC(3) && PH_ON(pb + 1)) { { constexpr bool rep_ = false; (void)rep_; WS_GET();
            { P2Sched S{ws, wl, l, G, c}; P2Epi E{DftEpi{ws}, QEpi{ws}, KnEpi{ws}, VtEpi{ws}}; gk::gemm_phase(lds, S, E); }
            dft_stage_a(ws, G, c);
            moe::krope_job(ws, G, c);
            __syncthreads();
            gla::g1_phase(pt, l, lds, G, c);
            }
            if ((PH_REPEAT >> 3) & 1) { grid_sync(bar); { constexpr bool rep_ = true; (void)rep_; WS_GET();
            { P2Sched S{ws, wl, l, G, c}; P2Epi E{DftEpi{ws}, QEpi{ws}, KnEpi{ws}, VtEpi{ws}}; gk::gemm_phase(lds, S, E); }
            dft_stage_a(ws, G, c);
            moe::krope_job(ws, G, c);
            __syncthreads();
            gla::g1_phase(pt, l, lds, G, c);
            } }
            PH_END(pb + 1); }
        if (PHC(4) && PH_ON(pb + 2)) { { constexpr bool rep_ = false; (void)rep_; WS_GET();
            if (!rep_) for (int it = c; it < 256; it += G) gla::g2_item(ws, it >> 2, it & 3);
            { DftBSched S{ws, G, c}; DftEpi E{ws}; gk::gemm_phase(lds, S, E); }
            at::attn_phase(ws, lds, l, G, c);
            }
            if ((PH_REPEAT >> 4) & 1) { grid_sync(bar); { constexpr bool rep_ = true; (void)rep_; WS_GET();
            if (!rep_) for (int it = c; it < 256; it += G) gla::g2_item(ws, it >> 2, it & 3);
            { DftBSched S{ws, G, c}; DftEpi E{ws}; gk::gemm_phase(lds, S, E); }
            at::attn_phase(ws, lds, l, G, c);
            } }
            PH_END(pb + 2); }
        if (PHC(5) && PH_ON(pb + 3)) { { constexpr bool rep_ = false; (void)rep_; WS_GET();
            gla::g3_phase(pt, l, lds, G, c);
            }
            if ((PH_REPEAT >> 5) & 1) { grid_sync(bar); { constexpr bool rep_ = true; (void)rep_; WS_GET();
            gla::g3_phase(pt, l, lds, G, c);
            } }
            PH_END(pb + 3); }
        if (PHC(6) && PH_ON(pb + 4)) { { constexpr bool rep_ = false; (void)rep_; WS_GET(); MergeSched S{ws, wl, l, G, c}; MergeEpi E{ws, (PH_REPEAT ? lsgpr((rep_ && PH_SKIPEPI) ? 1 : 0) : 0)}; gk::gemm_phase(lds, S, E); }
            if ((PH_REPEAT >> 6) & 1) { grid_sync(bar); { constexpr bool rep_ = true; (void)rep_; WS_GET(); MergeSched S{ws, wl, l, G, c}; MergeEpi E{ws, (PH_REPEAT ? lsgpr((rep_ && PH_SKIPEPI) ? 1 : 0) : 0)}; gk::gemm_phase(lds, S, E); } }
            PH_END(pb + 4); }
        if (PHC(7) && PH_ON(pb + 5)) { { constexpr bool rep_ = false; (void)rep_; WS_GET(); WoSched S{ws, wl, l, G, c}; WoEpi E{ws, l, DRYV(rep_), pt.x(), pt.ctx()}; gk::gemm_phase(lds, S, E); }
            if ((PH_REPEAT >> 7) & 1) { grid_sync(bar); { constexpr bool rep_ = true; (void)rep_; WS_GET(); WoSched S{ws, wl, l, G, c}; WoEpi E{ws, l, DRYV(rep_), pt.x(), pt.ctx()}; gk::gemm_phase(lds, S, E); } }
            PH_END(pb + 5); }
        if (PHC(8) && PH_ON(pb + 6)) { { constexpr bool rep_ = false; (void)rep_; WS_GET(); moe::route_phase(pt, l, lds, G, c, DRYV(rep_)); }
            if ((PH_REPEAT >> 8) & 1) { grid_sync(bar); { constexpr bool rep_ = true; (void)rep_; WS_GET(); moe::route_phase(pt, l, lds, G, c, DRYV(rep_)); } }
            PH_END(pb + 6); }
        if (PHC(10) && PH_ON(pb + 7)) { { constexpr bool rep_ = false; (void)rep_; WS_GET(); moe::tables(ws, l, lds);
            MoeUpSched S{ws + WS_H8, (const int*)(ws + WS_RT2), wl + WL_WUP, (const LAS int*)(lds + moe::A_TB), (const LAS int*)(lds + moe::A_CN), G, c};
            UpEpi E{ws, pt.b_up() + (size_t)l * NE * 2048}; gk::gemm_phase(lds, S, E); }
            if ((PH_REPEAT >> 10) & 1) { grid_sync(bar); { constexpr bool rep_ = true; (void)rep_; WS_GET(); moe::tables(ws, l, lds);
            MoeUpSched S{ws + WS_H8, (const int*)(ws + WS_RT2), wl + WL_WUP, (const LAS int*)(lds + moe::A_TB), (const LAS int*)(lds + moe::A_CN), G, c};
            UpEpi E{ws, pt.b_up() + (size_t)l * NE * 2048}; gk::gemm_phase(lds, S, E); } }
            PH_END(pb + 7); }
        if (PHC(11) && PH_ON(pb + 8)) { { constexpr bool rep_ = false; (void)rep_; WS_GET(); moe::tables(ws, l, lds);
            MoeSched S{ws + WS_ACT, wl + WL_WDN, (const LAS int*)(lds + moe::A_TB), G, c};
            DownEpi E{ws, pt.b_down() + (size_t)l * NE * 1024}; gk::gemm_phase(lds, S, E); }
            if ((PH_REPEAT >> 11) & 1) { grid_sync(bar); { constexpr bool rep_ = true; (void)rep_; WS_GET(); moe::tables(ws, l, lds);
            MoeSched S{ws + WS_ACT, wl + WL_WDN, (const LAS int*)(lds + moe::A_TB), G, c};
            DownEpi E{ws, pt.b_down() + (size_t)l * NE * 1024}; gk::gemm_phase(lds, S, E); } }
            PH_END(pb + 8); }
        if (PHC(12) && PH_ON(pb + 9)) { { constexpr bool rep_ = false; (void)rep_; WS_GET(); moe::combine_phase(pt, l, lds, G, c, DRYV(rep_)); }
            if ((PH_REPEAT >> 12) & 1) { grid_sync(bar); { constexpr bool rep_ = true; (void)rep_; WS_GET(); moe::combine_phase(pt, l, lds, G, c, DRYV(rep_)); } }
            PH_END(pb + 9); }
    }
#undef PH_ON
#undef PH_END
}

#ifdef DBG_STOP
struct DbgEnt { size_t off; size_t n; int f32; };
__global__ void dbg_dump(const char* ws, float* out, int n) {
    const DbgEnt L[] = { DBG_LIST };
    for (size_t i = (size_t)blockIdx.x * blockDim.x + threadIdx.x; i < (size_t)n; i += (size_t)gridDim.x * blockDim.x) {
        float s = 0.f;
        for (int k = 0; k < (int)(sizeof(L) / sizeof(L[0])); ++k) { const size_t j = i % L[k].n; const float v = L[k].f32 ? ((const float*)(ws + L[k].off))[j] : bf2f(((const bf16_t*)(ws + L[k].off))[j]); s += v; }
        out[i] = s;
    }
}
#endif
extern "C" void kernel_launch(void* const* d_in, const int* in_sizes, int n_in, void* d_out, int out_size, void* d_ws, size_t ws_size, hipStream_t stream) {
    static int grid = 0;
    if (!grid) {
        if (n_in != 29 || ws_size < WS_END) { fprintf(stderr, "kernel_launch: unexpected inputs (%d) or workspace (%zu < %zu)\n", n_in, ws_size, (size_t)WS_END); grid = -1; return; }
        int dev = 0, cus = 0, per_cu = 0;
        hipGetDevice(&dev); hipDeviceGetAttribute(&cus, hipDeviceAttributeMultiprocessorCount, dev);
        if (hipFuncSetAttribute((const void*)mega, hipFuncAttributeMaxDynamicSharedMemorySize, LDS_BYTES) != hipSuccess) { fprintf(stderr, "kernel_launch: hipFuncSetAttribute failed\n"); grid = -1; return; }
        hipOccupancyMaxActiveBlocksPerMultiprocessor(&per_cu, (const void*)mega, 512, LDS_BYTES);
        if (per_cu < 1 || cus < 1) { fprintf(stderr, "kernel_launch: kernel is not resident (occupancy %d, CUs %d)\n", per_cu, cus); grid = -1; return; }
        grid = cus;
    }
    if (grid < 0) return;
    hipMemsetAsync((char*)d_ws + WS_CTL, 0, CTL_BYTES, stream);
    Params p{};
    const float** f = (const float**)&p;
    for (int i = 0; i < 29; ++i) f[i] = (const float*)d_in[i];
    p.out = (float*)d_out; p.ws = (char*)d_ws;
#ifdef DBG_STOP
    for (int ph = 0; ph < DBG_STOP; ++ph) hipLaunchKernelGGL(mega, dim3(grid), dim3(512), LDS_BYTES, stream, p, ph, ph + 1);
    hipLaunchKernelGGL(dbg_dump, dim3(2048), dim3(256), 0, stream, (const char*)d_ws, (float*)d_out, out_size);
#elif MK_PER_PHASE
    for (int ph = 0; ph < N_PHASES; ++ph) hipLaunchKernelGGL(mega, dim3(grid), dim3(512), LDS_BYTES, stream, p, ph, ph + 1);
#else
    hipLaunchKernelGGL(mega, dim3(grid), dim3(512), LDS_BYTES, stream, p, 0, N_PHASES);
#endif
}
```
